# Optimizing an MI355X kernel written in HIP

```python
import jax, jax.numpy as jnp
from jax import lax
import numpy as np

D_MODEL = 2048
BATCH = 4
SEQ = 2048
DEPTH = 2

GRID_W = 64
CTX_LEN = 256

D_A = 1024
RWKV_HEAD = 64
H_A = D_A // RWKV_HEAD
W_LORA = 64
A_LORA = 64
G_LORA = 128
LNX_EPS = 64e-5
D_B = 1024
HEAD_DIM = 128
H_Q = D_B // HEAD_DIM
H_KV = 2
Q_PER_KV = H_Q // H_KV
ROPE_AXIS_DIM = HEAD_DIM // 2
ROPE_THETA = 10000.0
Q_BLOCK = 128
RWKV_SPLITS = [D_A, 2 * D_A, 3 * D_A, 3 * D_A + W_LORA, 3 * D_A + W_LORA + A_LORA]
A_COLS = 3 * D_A + W_LORA + A_LORA + G_LORA
B_COLS = D_B + 2 * H_KV * HEAD_DIM
IN_COLS = A_COLS + B_COLS
D_MIX = D_A + D_B
FOURIER_GROUPS = 8
FOURIER_GROUP_DIM = D_MODEL // FOURIER_GROUPS
N_EXPERTS = 16
N_EXPERT_GROUPS = 4
EXPERTS_PER_GROUP = N_EXPERTS // N_EXPERT_GROUPS
TOP_K = 2
D_EXPERT = 512
N_EVEN = (DEPTH + 1) // 2
N_ODD = DEPTH // 2
NORM_EPS = 1e-6

kernel_name = 'hybrid_rwkv7_gqa_fnet_moe_dit'


def rms_norm(x, gain, eps=NORM_EPS):
    xf = x.astype(jnp.float32)
    y = xf * lax.rsqrt(jnp.mean(xf * xf, axis=-1, keepdims=True) + eps)
    return (y * gain.astype(jnp.float32)).astype(x.dtype)


def centred_shift(p, mu_prev, mu_next):
    zero = jnp.zeros_like(p[:, :1])
    prev = jnp.concatenate([zero, p[:, :-1]], axis=1)
    nxt = jnp.concatenate([p[:, 1:], zero], axis=1)
    return p + mu_prev * (prev - p) + mu_next * (nxt - p)


def axial_rope(n):
    rows = n // GRID_W
    row = jnp.repeat(jnp.arange(rows), GRID_W).astype(jnp.float32)
    col = jnp.tile(jnp.arange(GRID_W), rows).astype(jnp.float32)
    inv = ROPE_THETA ** (-jnp.arange(0, ROPE_AXIS_DIM, 2, dtype=jnp.float32) / ROPE_AXIS_DIM)
    ang = jnp.concatenate([row[:, None] * inv, col[:, None] * inv], axis=-1)
    return jnp.cos(ang), jnp.sin(ang)


def apply_rope(x, cos, sin):
    xf = x.astype(jnp.float32).reshape(x.shape[:-1] + (HEAD_DIM // 2, 2))
    x0, x1 = xf[..., 0], xf[..., 1]
    bshape = cos.shape[:1] + (1,) * (x.ndim - 3) + cos.shape[1:]
    c, s = cos.reshape(bshape), sin.reshape(bshape)
    out = jnp.stack([x0 * c - x1 * s, x0 * s + x1 * c], axis=-1)
    return out.reshape(x.shape).astype(x.dtype)


def wkv7_scan(s0, r, w, k, v, a, b, reverse):
    def step(s, inp):
        r_t, w_t, k_t, v_t, a_t, b_t = inp
        sa = jnp.einsum('bhij,bhj->bhi', s, a_t)
        s = s * w_t[:, :, None, :] + sa[..., None] * b_t[:, :, None, :] + v_t[..., None] * k_t[:, :, None, :]
        return s, jnp.einsum('bhij,bhj->bhi', s, r_t)
    xs = tuple(jnp.moveaxis(t, 1, 0) for t in (r, w, k, v, a, b))
    s_fin, ys = lax.scan(step, s0, xs, reverse=reverse)
    return s_fin, jnp.moveaxis(ys, 0, 1)


def rwkv7_streams(pa, w0, w2, a0, a2, g2, k_k, k_a):
    bsz, t = pa.shape[:2]
    heads = lambda z: z.astype(jnp.float32).reshape(bsz, t, H_A, RWKV_HEAD)
    r, k, v, xw, xa, xg = jnp.split(pa, RWKV_SPLITS, axis=-1)
    g = jax.nn.sigmoid(xg) @ g2
    kk = heads(k * k_k)
    kk = kk * lax.rsqrt(jnp.sum(kk * kk, axis=-1, keepdims=True) + 1e-12)
    dirs = []
    for d in range(2):
        w_log = -jax.nn.softplus(-(w0[d] + jnp.tanh(xw) @ w2[d])) - 0.5
        decay = jnp.exp(-jnp.exp(w_log.astype(jnp.float32)))
        a = jax.nn.sigmoid(a0[d] + xa @ a2[d])
        k_d = k * (1 + (a - 1) * k_a)
        dirs.append((heads(decay), heads(k_d), heads(a)))
    return heads(r), heads(v), kk, g, dirs


def rwkv7_finish(y, r, v, k_dirs, g, ln_g, ln_b, r_k):
    bsz, t = y.shape[:2]
    mu = jnp.mean(y, axis=-1, keepdims=True)
    var = jnp.mean(jnp.square(y - mu), axis=-1, keepdims=True)
    yn = ((y - mu) * lax.rsqrt(var + LNX_EPS)).reshape(bsz, t, D_A) * ln_g + ln_b
    kb = k_dirs[0] + k_dirs[1]
    bonus = (jnp.sum(r * kb * r_k, axis=-1, keepdims=True) * v).reshape(bsz, t, D_A)
    return ((yn + bonus) * g).astype(g.dtype)


def even_mixer(h_ctx, h_lat, w_in, mu_prev, mu_next, w0, w2, a0, a2, g2, k_k, k_a, r_k, ln_g, ln_b,
               q_gain, k_gain, w_out, cos, sin, ctx_out):
    p_ctx = h_ctx @ w_in
    p_lat = h_lat @ w_in
    pa_c = centred_shift(p_ctx[..., :A_COLS], mu_prev, mu_next)
    pa_l = centred_shift(p_lat[..., :A_COLS], mu_prev, mu_next)
    pb_c, pb_l = p_ctx[..., A_COLS:], p_lat[..., A_COLS:]

    rc, vc, kkc, gc, dc = rwkv7_streams(pa_c, w0, w2, a0, a2, g2, k_k, k_a)
    rl, vl, kkl, gl, dl = rwkv7_streams(pa_l, w0, w2, a0, a2, g2, k_k, k_a)
    s0 = jnp.zeros((h_lat.shape[0], H_A, RWKV_HEAD, RWKV_HEAD), jnp.float32)
    ys_c, ys_l = [], []
    for d, rev in enumerate((False, True)):
        dec_c, k_c, a_c = dc[d]
        dec_l, k_l, a_l = dl[d]
        s_c, y_c = wkv7_scan(s0, rc, dec_c, k_c, vc, -kkc, kkc * a_c, rev)
        _, y_l = wkv7_scan(s_c, rl, dec_l, k_l, vl, -kkl, kkl * a_l, rev)
        ys_c.append(y_c)
        ys_l.append(y_l)
    ya_l = rwkv7_finish(ys_l[0] + ys_l[1], rl, vl, [dl[0][1], dl[1][1]], gl, ln_g, ln_b, r_k)

    def qkv(pb):
        bsz, t = pb.shape[:2]
        q, k, v = jnp.split(pb, [D_B, D_B + H_KV * HEAD_DIM], axis=-1)
        q = rms_norm(q.reshape(bsz, t, H_KV, Q_PER_KV, HEAD_DIM), q_gain)
        k = rms_norm(k.reshape(bsz, t, H_KV, HEAD_DIM), k_gain)
        return q, k, v.reshape(bsz, t, H_KV, HEAD_DIM)
    qc, kc, vc_b = qkv(pb_c)
    ql, kl, vl_b = qkv(pb_l)
    ql = apply_rope(ql, cos, sin)
    kl = apply_rope(kl, cos, sin)
    k_all = jnp.concatenate([kc, kl], axis=1)
    v_all = jnp.concatenate([vc_b, vl_b], axis=1)
    scale = HEAD_DIM ** -0.5

    def attend(qb, keys, vals):
        s = jnp.einsum('bqkgd,bskd->bkgqs', qb, keys, preferred_element_type=jnp.float32) * scale
        p = jax.nn.softmax(s, axis=-1)
        return jnp.einsum('bkgqs,bskd->bqkgd', p.astype(vals.dtype), vals)

    bsz, seq = ql.shape[:2]
    nb = seq // Q_BLOCK
    qblocks = jnp.moveaxis(ql.reshape(bsz, nb, Q_BLOCK, H_KV, Q_PER_KV, HEAD_DIM), 1, 0)
    o_l = lax.map(lambda qb: attend(qb, k_all, v_all), qblocks)
    yb_l = jnp.moveaxis(o_l, 0, 1).reshape(bsz, seq, D_B)

    out_lat = jnp.concatenate([ya_l, yb_l.astype(ya_l.dtype)], axis=-1) @ w_out
    out_ctx = None
    if ctx_out:
        ya_c = rwkv7_finish(ys_c[0] + ys_c[1], rc, vc, [dc[0][1], dc[1][1]], gc, ln_g, ln_b, r_k)
        yb_c = attend(qc, kc, vc_b).reshape(bsz, qc.shape[1], D_B)
        out_ctx = jnp.concatenate([ya_c, yb_c.astype(ya_c.dtype)], axis=-1) @ w_out
    return out_lat, out_ctx


def fourier_mixer(h, w_out):
    bsz, t, _ = h.shape
    hg = h.astype(jnp.float32).reshape(bsz, t, FOURIER_GROUPS, FOURIER_GROUP_DIM)
    f = jnp.fft.fftn(hg, axes=(1, 3), norm='ortho').real
    return f.reshape(bsz, t, D_MODEL).astype(h.dtype) @ w_out


def route_grouped_top2(h, router_w, router_b):
    s = jax.nn.sigmoid((h @ router_w).astype(jnp.float32))
    sel = s + router_b.astype(jnp.float32)
    grp = sel.reshape(-1, N_EXPERT_GROUPS, EXPERTS_PER_GROUP)
    grp_score = jnp.sum(lax.top_k(grp, TOP_K)[0], axis=-1)
    best = jnp.argmax(grp_score, axis=-1)
    in_grp = jnp.repeat(best[:, None] == jnp.arange(N_EXPERT_GROUPS), EXPERTS_PER_GROUP, axis=-1)
    _, idx = lax.top_k(jnp.where(in_grp, sel, -jnp.inf), TOP_K)
    w = jnp.take_along_axis(s, idx, axis=-1)
    w = w / jnp.sum(w, axis=-1, keepdims=True)
    return jnp.sum(jax.nn.one_hot(idx, N_EXPERTS, dtype=jnp.float32) * w[..., None], axis=1)


def moe_ffn(h, router_w, router_b, w_gate, w_up, w_down):
    gates = route_grouped_top2(h, router_w, router_b).astype(h.dtype)
    out = jnp.zeros_like(h)
    for e in range(N_EXPERTS):
        u = jax.nn.silu(h @ w_gate[e]) * (h @ w_up[e])
        out = out + gates[:, e:e + 1] * (u @ w_down[e])
    return out


def setup_inputs(seed: int = 0) -> dict:
    key = jax.random.key(seed)
    ks = iter(list(jax.random.split(key, 40)))
    f32 = jnp.float32
    nrm = lambda shape, s: jax.random.normal(next(ks), shape, f32) * s
    uni = lambda shape: jax.random.uniform(next(ks), shape, f32, 0.0, 0.5)
    return {
        'x': nrm((BATCH, SEQ, D_MODEL), 1.0),
        'c': nrm((BATCH, D_MODEL), 1.0),
        'ctx': nrm((BATCH, CTX_LEN, D_MODEL), 1.0),
        'c_ctx': nrm((D_MODEL,), 1.0),
        'mod_w': nrm((DEPTH, D_MODEL, 6 * D_MODEL), 0.5 * D_MODEL ** -0.5),
        'mod_b': nrm((DEPTH, 6 * D_MODEL), 0.01),
        'norm_mix': 1.0 + nrm((DEPTH, D_MODEL), 0.02),
        'norm_ffn': 1.0 + nrm((DEPTH, D_MODEL), 0.02),
        'ab_w_in': nrm((N_EVEN, D_MODEL, IN_COLS), D_MODEL ** -0.5),
        'ab_mu_prev': uni((N_EVEN, A_COLS)),
        'ab_mu_next': uni((N_EVEN, A_COLS)),
        'rwkv_w0': nrm((N_EVEN, 2, D_A), 0.5),
        'rwkv_w2': nrm((N_EVEN, 2, W_LORA, D_A), 0.1),
        'rwkv_a0': nrm((N_EVEN, 2, D_A), 0.5),
        'rwkv_a2': nrm((N_EVEN, 2, A_LORA, D_A), A_LORA ** -0.5),
        'rwkv_g2': nrm((N_EVEN, G_LORA, D_A), G_LORA ** -0.5),
        'rwkv_k_k': 0.85 + nrm((N_EVEN, D_A), 0.02),
        'rwkv_k_a': 1.0 + nrm((N_EVEN, D_A), 0.02),
        'rwkv_r_k': nrm((N_EVEN, H_A, RWKV_HEAD), 0.1),
        'rwkv_ln_g': 1.0 + nrm((N_EVEN, D_A), 0.02),
        'rwkv_ln_b': nrm((N_EVEN, D_A), 0.01),
        'attn_q_norm': 1.0 + nrm((N_EVEN, HEAD_DIM), 0.02),
        'attn_k_norm': 1.0 + nrm((N_EVEN, HEAD_DIM), 0.02),
        'ab_w_out': nrm((N_EVEN, D_MIX, D_MODEL), D_MIX ** -0.5),
        'fourier_w_out': nrm((N_ODD, D_MODEL, D_MODEL), D_MODEL ** -0.5),
        'router_w': nrm((D_MODEL, N_EXPERTS), D_MODEL ** -0.5),
        'router_b': nrm((N_EXPERTS,), 0.01),
        'exp_w_gate': nrm((DEPTH, N_EXPERTS, D_MODEL, D_EXPERT), D_MODEL ** -0.5),
        'exp_w_up': nrm((DEPTH, N_EXPERTS, D_MODEL, D_EXPERT), D_MODEL ** -0.5),
        'exp_w_down': nrm((DEPTH, N_EXPERTS, D_EXPERT, D_MODEL), D_EXPERT ** -0.5),
    }


def reference(x, c, ctx, c_ctx, mod_w, mod_b, norm_mix, norm_ffn, ab_w_in, ab_mu_prev, ab_mu_next,
              rwkv_w0, rwkv_w2, rwkv_a0, rwkv_a2, rwkv_g2, rwkv_k_k, rwkv_k_a, rwkv_r_k, rwkv_ln_g, rwkv_ln_b,
              attn_q_norm, attn_k_norm, ab_w_out, fourier_w_out, router_w, router_b,
              exp_w_gate, exp_w_up, exp_w_down):
    seq = x.shape[1]
    cos, sin = axial_rope(seq)
    s_lat = jax.nn.silu(c)
    s_ctx = jax.nn.silu(c_ctx)
    for l in range(DEPTH):
        ctx_out = any(j % 2 == 0 for j in range(l + 1, DEPTH))
        uses_ctx = (l % 2 == 0) or ctx_out
        m_lat = (s_lat @ mod_w[l] + mod_b[l])[:, None, :]
        sh1, sc1, gt1, sh2, sc2, gt2 = jnp.split(m_lat, 6, axis=-1)
        h_lat = rms_norm(x, norm_mix[l]) * (1 + sc1) + sh1
        if uses_ctx:
            m_ctx = s_ctx @ mod_w[l] + mod_b[l]
            csh1, csc1, cgt1, csh2, csc2, cgt2 = jnp.split(m_ctx, 6)
            h_ctx = rms_norm(ctx, norm_mix[l]) * (1 + csc1) + csh1
        if l % 2 == 0:
            e = l // 2
            y_lat, y_ctx = even_mixer(h_ctx, h_lat, ab_w_in[e], ab_mu_prev[e], ab_mu_next[e],
                                      rwkv_w0[e], rwkv_w2[e], rwkv_a0[e], rwkv_a2[e], rwkv_g2[e],
                                      rwkv_k_k[e], rwkv_k_a[e], rwkv_r_k[e], rwkv_ln_g[e], rwkv_ln_b[e],
                                      attn_q_norm[e], attn_k_norm[e], ab_w_out[e], cos, sin, ctx_out)
        else:
            o = l // 2
            y_lat = fourier_mixer(h_lat, fourier_w_out[o])
            y_ctx = fourier_mixer(h_ctx, fourier_w_out[o]) if ctx_out else None
        x = x + gt1 * y_lat
        tokens = (rms_norm(x, norm_ffn[l]) * (1 + sc2) + sh2).reshape(-1, D_MODEL)
        if ctx_out:
            ctx = ctx + cgt1 * y_ctx
            h2c = rms_norm(ctx, norm_ffn[l]) * (1 + csc2) + csh2
            tokens = jnp.concatenate([tokens, h2c.reshape(-1, D_MODEL)], axis=0)
        f = moe_ffn(tokens, router_w, router_b, exp_w_gate[l], exp_w_up[l], exp_w_down[l])
        n_lat = x.shape[0] * seq
        x = x + gt2 * f[:n_lat].reshape(x.shape)
        if ctx_out:
            ctx = ctx + cgt2 * f[n_lat:].reshape(ctx.shape)
    return x
```

```cpp
#include <hip/hip_runtime.h>
#include <cstdio>
#include <cstdint>

#ifndef PROBE_PHASE
#define PROBE_PHASE -1
#endif
#ifndef MULTI_LAUNCH
#define MULTI_LAUNCH 0
#endif

typedef _Float16 h16;
typedef _Float16 h16x2 __attribute__((ext_vector_type(2)));
typedef _Float16 h16x4 __attribute__((ext_vector_type(4)));
typedef _Float16 h16x8 __attribute__((ext_vector_type(8)));
typedef float f32x4 __attribute__((ext_vector_type(4)));
typedef unsigned u32x4 __attribute__((ext_vector_type(4)));
#define LAS __attribute__((address_space(3)))

constexpr int D = 2048, NB = 4, SEQ = 2048, CTXL = 256, SALL = SEQ + CTXL;
constexpr int ROWS0 = NB * SALL;
constexpr int ROWSL = NB * SEQ;
constexpr int DA = 1024, HA = 16;
constexpr int A_COLS = 3328, IN_COLS = 4864;
constexpr int NEXP = 16, DEXP = 512;
constexpr int NT = 512;
constexpr int NW = NT / 64;
constexpr int NPHASE = 18;

constexpr size_t OFF_CTL   = 0;
constexpr size_t CTL_BYTES = 65536;
constexpr size_t OFF_MODP  = OFF_CTL + CTL_BYTES;
constexpr size_t OFF_MOD   = OFF_MODP + (size_t)16 * 2 * 5 * 12288 * 4;
constexpr size_t OFF_ROPE  = OFF_MOD + (size_t)2 * 5 * 12288 * 4;
constexpr size_t OFF_WIN   = OFF_ROPE + (size_t)2048 * 64 * 2 * 4;
constexpr size_t OFF_WOUT  = OFF_WIN + (size_t)IN_COLS * D * 2;
constexpr size_t OFF_FW    = OFF_WOUT + (size_t)D * D * 2;
constexpr size_t OFF_W2T   = OFF_FW + (size_t)D * D * 2;
constexpr size_t OFF_A2T   = OFF_W2T + (size_t)2048 * 64 * 2;
constexpr size_t OFF_G2T   = OFF_A2T + (size_t)2048 * 64 * 2;
constexpr size_t OFF_EXP   = OFF_G2T + (size_t)1024 * 128 * 2;
constexpr size_t EGU_BYTES = (size_t)16 * 1024 * 2048 * 2;
constexpr size_t ED_BYTES  = (size_t)16 * 2048 * 512 * 2;
constexpr size_t EXP_L     = EGU_BYTES + ED_BYTES;
constexpr size_t OFF_DT    = OFF_EXP + 2 * EXP_L;
constexpr size_t OFF_DC    = OFF_DT + (size_t)2048 * 4096 * 2;
constexpr size_t OFF_RWH   = OFF_DC + (size_t)512 * 256 * 2;
constexpr size_t OFF_RWL   = OFF_RWH + (size_t)16 * 2048 * 2;
constexpr size_t OFF_H     = OFF_RWL + (size_t)16 * 2048 * 2;
constexpr size_t OFF_P     = OFF_H + (size_t)ROWS0 * D * 2;
constexpr size_t P_BYTES   = (size_t)ROWS0 * IN_COLS * 2;
constexpr size_t OFF_SLOT  = OFF_P;
constexpr size_t OFF_U     = OFF_P + (size_t)16384 * 2048 * 2;
constexpr size_t OFF_STR   = OFF_P + P_BYTES;
constexpr size_t STR16     = (size_t)ROWS0 * DA * 2;
constexpr size_t STR32     = (size_t)ROWS0 * DA * 4;
constexpr size_t OFF_SR    = OFF_STR;
constexpr size_t OFF_SV    = OFF_SR + STR16;
constexpr size_t OFF_SKS   = OFF_SV + STR16;
constexpr size_t OFF_SKK   = OFF_SKS + STR16;
constexpr size_t OFF_SG    = OFF_SKK + STR16;
constexpr size_t OFF_SKD0  = OFF_SG + STR16;
constexpr size_t OFF_SKD1  = OFF_SKD0 + STR16;
constexpr size_t OFF_SB0   = OFF_SKD1 + STR16;
constexpr size_t OFF_SB1   = OFF_SB0 + STR16;
constexpr size_t OFF_SW0   = OFF_SB1 + STR16;
constexpr size_t OFF_SW1   = OFF_SW0 + STR32;
constexpr size_t STR_END   = OFF_SW1 + STR32;
constexpr size_t OFF_Y0    = OFF_SW0;
constexpr size_t OFF_Y1    = OFF_SW0 + (size_t)ROWSL * DA * 4;
static_assert(OFF_Y1 + (size_t)ROWSL * DA * 4 <= STR_END, "y must fit in the decay streams");
constexpr int NCHUNK = SALL / 16;
constexpr int REC_BYTES = 10496;
constexpr size_t FRAG_DIR_BYTES = (size_t)64 * NCHUNK * REC_BYTES;
constexpr size_t OFF_FRAG0 = OFF_H;
constexpr size_t OFF_FRAG1 = OFF_EXP + EXP_L;
static_assert(OFF_FRAG0 + FRAG_DIR_BYTES <= OFF_STR, "frag0 must fit in h|p");
static_assert(FRAG_DIR_BYTES <= EXP_L, "frag1 must fit in the layer-1 expert region");
constexpr size_t OFF_ZT    = OFF_STR;
constexpr size_t OFF_F     = STR_END;
constexpr size_t OFF_Q     = OFF_F + (size_t)ROWS0 * 256 * 2;
constexpr size_t OFF_KB    = OFF_Q + (size_t)NB * 8 * SEQ * 128 * 2;
constexpr size_t OFF_VT    = OFF_KB + (size_t)NB * 2 * SALL * 128 * 2;
constexpr size_t OFF_YMIX  = OFF_VT + (size_t)NB * 2 * 128 * SALL * 2;
constexpr size_t OFF_LIST  = OFF_YMIX + (size_t)ROWSL * D * 2;
constexpr int NLIST = (PROBE_PHASE == 9 || PROBE_PHASE == 15) ? 4 : 2;
constexpr size_t OFF_GW    = OFF_LIST + (size_t)NLIST * 16 * 8192 * 4;
constexpr size_t OFF_HNY   = OFF_GW + (size_t)NLIST * 16384 * 4;
constexpr size_t OFF_VNY   = OFF_HNY + (size_t)NB * D * 4;
constexpr size_t OFF_XH    = OFF_VNY + (size_t)NB * D * 4;
constexpr size_t OFF_VB    = OFF_XH + (size_t)ROWSL * D * 2;
constexpr size_t WS_END    = OFF_VB + (size_t)NB * 2 * SALL * 128 * 2;
static_assert(WS_END <= (size_t)754818112, "workspace budget (sum of the inputs)");
static_assert(OFF_U + (size_t)16384 * 512 * 2 <= OFF_P + P_BYTES, "slot+u must fit in p");
static_assert((size_t)NB * 2048 * 2048 * 2 <= STR_END - OFF_STR, "zt must fit in streams");

constexpr int CW_QUEUE = 4000;
constexpr int CW_AQ    = 10000;
constexpr int CW_MQ    = 8192;
constexpr int CW_DEP   = 8448;
constexpr int CW_TMO   = 9600;
constexpr int CW_CNT   = 4096;

struct Params { const float* in[30]; float* out; char* ws; };

__device__ __forceinline__ float row16_sum(float v) {
    v += __int_as_float(__builtin_amdgcn_update_dpp(0, __float_as_int(v), 0xB1, 0xF, 0xF, true));
    v += __int_as_float(__builtin_amdgcn_update_dpp(0, __float_as_int(v), 0x4E, 0xF, 0xF, true));
    v += __int_as_float(__builtin_amdgcn_update_dpp(0, __float_as_int(v), 0x124, 0xF, 0xF, true));
    v += __int_as_float(__builtin_amdgcn_update_dpp(0, __float_as_int(v), 0x128, 0xF, 0xF, true));
    return v;
}
__device__ __forceinline__ float wave_sum(float v) {
    v = row16_sum(v);
    const int i = __float_as_int(v);
    return (__int_as_float(__builtin_amdgcn_readlane(i, 0)) + __int_as_float(__builtin_amdgcn_readlane(i, 16))) +
           (__int_as_float(__builtin_amdgcn_readlane(i, 32)) + __int_as_float(__builtin_amdgcn_readlane(i, 48)));
}
__device__ __forceinline__ float sigmoidf_(float x) { return 1.0f / (1.0f + expf(-x)); }
__device__ __forceinline__ float siluf_(float x) { return x / (1.0f + expf(-x)); }
__device__ __forceinline__ float fexp_(float x) { return __builtin_amdgcn_exp2f(x * 1.4426950408889634f); }
__device__ __forceinline__ float fsigmoid_(float x) { return __builtin_amdgcn_rcpf(1.0f + fexp_(-x)); }
__device__ __forceinline__ float fsilu_(float x) { return x * fsigmoid_(x); }
__device__ __forceinline__ float ftanh_(float x) { return 1.0f - 2.0f * __builtin_amdgcn_rcpf(1.0f + fexp_(2.0f * x)); }
__device__ __forceinline__ float dpp_xor1(float x) { return __int_as_float(__builtin_amdgcn_update_dpp(0, __float_as_int(x), 0xB1, 0xF, 0xF, true)); }
__device__ __forceinline__ float dpp_xor2(float x) { return __int_as_float(__builtin_amdgcn_update_dpp(0, __float_as_int(x), 0x4E, 0xF, 0xF, true)); }
__device__ __forceinline__ unsigned pack_h2(float lo, float hi) { h16x2 v = {(h16)lo, (h16)hi}; return __builtin_bit_cast(unsigned, v); }

__device__ __forceinline__ f32x4 mfma32(h16x8 a, h16x8 b, f32x4 c) { return __builtin_amdgcn_mfma_f32_16x16x32_f16(a, b, c, 0, 0, 0); }
__device__ __forceinline__ f32x4 mfma16(h16x4 a, h16x4 b, f32x4 c) { return __builtin_amdgcn_mfma_f32_16x16x16f16(a, b, c, 0, 0, 0); }
__device__ __forceinline__ h16x4 cvt4(f32x4 v) { h16x4 o = {(h16)v[0], (h16)v[1], (h16)v[2], (h16)v[3]}; return o; }
__device__ __forceinline__ h16x8 cat8(h16x4 lo, h16x4 hi) { h16x8 o = {lo[0], lo[1], lo[2], lo[3], hi[0], hi[1], hi[2], hi[3]}; return o; }

#define XB_TMO      128
#define XB_XCNT(j)  (256  + 64 * (j))
#define XB_XSUB(j)  (1280 + 64 * (j))
#define XB_XGEN(j)  (2304 + 64 * (j))
#define XB_TOP      3328
#define XB_TOPGEN   3392
#define XCD_BAR_WORDS 3456
#define XB_SPIN_CAP (1u << 27)
__device__ __forceinline__ unsigned xb_ld(unsigned* p)              { return __hip_atomic_load(p, __ATOMIC_RELAXED, __HIP_MEMORY_SCOPE_AGENT); }
__device__ __forceinline__ unsigned xb_add(unsigned* p, unsigned v) { return __hip_atomic_fetch_add(p, v, __ATOMIC_RELAXED, __HIP_MEMORY_SCOPE_AGENT); }
__device__ __forceinline__ unsigned xb_xcc_id() { return (unsigned)__builtin_amdgcn_s_getreg((3 << 11) | 20) & 0xFu; }
#define XB_SPIN(cond, bar) do { unsigned _sp = 0; while (cond) { __builtin_amdgcn_s_sleep(1); \
    if ((++_sp & 255u) == 0u) { if (xb_ld(&(bar)[XB_TMO])) break; if (_sp > XB_SPIN_CAP) { atomicAdd(&(bar)[XB_TMO], 1u); break; } } } } while (0)
struct XcdBarrier { unsigned* bar; unsigned x; volatile LAS unsigned* st; };
__device__ __forceinline__ XcdBarrier xcd_barrier_post(unsigned* bar, volatile LAS unsigned* st) {
    XcdBarrier b; b.bar = bar; b.x = xb_xcc_id(); b.st = st;
    if (threadIdx.x == 0) (void)xb_add(&bar[XB_XCNT(b.x)], 1u);
    return b;
}
__device__ __forceinline__ void xcd_barrier_complete(unsigned* bar, unsigned x, unsigned& nloc, unsigned& nx) {
    const unsigned G = gridDim.x * gridDim.y * gridDim.z;
    unsigned sum, cnt, mine, sp = 0u;
    for (;;) {
        sum = 0u; cnt = 0u; mine = 0u;
#pragma unroll
        for (unsigned j = 0; j < 16; ++j) { const unsigned c = xb_ld(&bar[XB_XCNT(j)]); sum += c; cnt += (c > 0u) ? 1u : 0u; mine = (j == x) ? c : mine; }
        if (sum == G) break;
        __builtin_amdgcn_s_sleep(1);
        if ((++sp & 255u) == 0u) { if (xb_ld(&bar[XB_TMO])) break; if (sp > XB_SPIN_CAP) { atomicAdd(&bar[XB_TMO], 1u); break; } }
    }
    nloc = mine > 0u ? mine : 1u; nx = cnt > 0u ? cnt : 1u;
}
__device__ __forceinline__ void xcd_barrier(const XcdBarrier& b) {
    asm volatile("s_waitcnt vmcnt(0)" ::: "memory");
    __syncthreads();
    if (threadIdx.x == 0) {
        unsigned* bar = b.bar;
        __builtin_amdgcn_s_waitcnt(0);
        unsigned nloc = b.st[0], nx = b.st[1];
        if (nloc == 0u) { xcd_barrier_complete(bar, b.x, nloc, nx); b.st[0] = nloc; b.st[1] = nx; }
        const unsigned old = xb_add(&bar[XB_XSUB(b.x)], 1u);
        const unsigned gen = old / nloc;
        if (old + 1u == (gen + 1u) * nloc) {
            __builtin_amdgcn_fence(__ATOMIC_RELEASE, "agent");
            asm volatile("s_waitcnt vmcnt(0)" ::: "memory");
            const unsigned og = xb_add(&bar[XB_TOP], 1u);
            const unsigned tg = og / nx;
            if (og + 1u == (tg + 1u) * nx) xb_add(&bar[XB_TOPGEN], 1u);
            else XB_SPIN(xb_ld(&bar[XB_TOPGEN]) == tg, bar);
            __builtin_amdgcn_fence(__ATOMIC_ACQUIRE, "agent");
            xb_add(&bar[XB_XGEN(b.x)], 1u);
            asm volatile("s_waitcnt vmcnt(0)" ::: "memory");
        } else {
            XB_SPIN(xb_ld(&bar[XB_XGEN(b.x)]) == gen, bar);
            __builtin_amdgcn_fence(__ATOMIC_ACQUIRE, "agent");
            asm volatile("s_waitcnt vmcnt(0)" ::: "memory");
        }
    }
    __syncthreads();
}

constexpr int GEMM_STAGE = (256 + 256) * 32 * 2;
constexpr int GEMM_LDS = 4 * GEMM_STAGE;
#define WAIT_V(n) asm volatile("s_waitcnt vmcnt(" #n ")" ::: "memory")
__device__ __forceinline__ void glds16(const h16* g, char* l) {
    __builtin_amdgcn_global_load_lds((const __attribute__((address_space(1))) unsigned*)g, (__attribute__((address_space(3))) unsigned*)l, 16, 0, 0);
}
template <typename ARow, typename BRow>
__device__ __forceinline__ void gemm_tile(char* smem, const ARow& arow, const BRow& brow, int K, f32x4 (&acc)[8][4]) {
    const int tid = threadIdx.x, lane = tid & 63, wave = tid >> 6;
    const int wm = wave >> 2, wn = wave & 3;
    const int fr = lane & 15, fq = lane >> 4;
    const int lrow = lane >> 2;
    const int schunk = (lane & 3) ^ ((0x78 >> (2 * ((lane >> 4) & 3))) & 3);
    const h16* ap[2]; const h16* bp[2];
#pragma unroll
    for (int i = 0; i < 2; ++i) { ap[i] = arow(32 * wave + 16 * i + lrow) + schunk * 8; bp[i] = brow(32 * wave + 16 * i + lrow) + schunk * 8; }
    char* ldsA = smem + (2 * wave) * 1024 + lane * 16;
    char* ldsB = smem + 16384 + (2 * wave) * 1024 + lane * 16;
    const int fsw = (0x78 >> (2 * (fr >> 2))) & 3;
    const int rdA = (128 * wm + fr) * 64 + ((fq ^ fsw) << 4);
    const int rdB = 16384 + (64 * wn + fr) * 64 + ((fq ^ fsw) << 4);
#pragma unroll
    for (int mi = 0; mi < 8; ++mi)
#pragma unroll
        for (int ni = 0; ni < 4; ++ni) acc[mi][ni] = (f32x4){0.f, 0.f, 0.f, 0.f};
    const int nk = K >> 5;
    WAIT_V(0);
    __syncthreads();
#pragma unroll
    for (int st = 0; st < 3; ++st) {
        if (st < nk) {
#pragma unroll
            for (int i = 0; i < 2; ++i) { glds16(ap[i] + st * 32, ldsA + st * GEMM_STAGE + i * 1024); glds16(bp[i] + st * 32, ldsB + st * GEMM_STAGE + i * 1024); }
        }
    }
    int cur = 0, nxt = 3 * GEMM_STAGE;
#pragma unroll 1
    for (int kt = 0; kt < nk; ++kt) {
        const int ahead = nk - 1 - kt;
        if (ahead >= 2) { WAIT_V(8); } else if (ahead == 1) { WAIT_V(4); } else { WAIT_V(0); }
        __builtin_amdgcn_s_barrier();
        const char* As = smem + cur + rdA;
        const char* Bs = smem + cur + rdB;
        h16x8 af[8], bf[4];
#pragma unroll
        for (int ni = 0; ni < 4; ++ni) bf[ni] = *(const h16x8*)(Bs + ni * 1024);
#pragma unroll
        for (int mi = 0; mi < 8; ++mi) af[mi] = *(const h16x8*)(As + mi * 1024);
        __builtin_amdgcn_sched_barrier(0);
        if (kt + 3 < nk) {
            const int ko = (kt + 3) * 32;
#pragma unroll
            for (int i = 0; i < 2; ++i) { glds16(ap[i] + ko, ldsA + nxt + i * 1024); glds16(bp[i] + ko, ldsB + nxt + i * 1024); }
        }
        __builtin_amdgcn_sched_barrier(0);
        __builtin_amdgcn_s_setprio(1);
#pragma unroll
        for (int mi = 0; mi < 8; ++mi)
#pragma unroll
            for (int ni = 0; ni < 4; ++ni)
                acc[mi][ni] = __builtin_amdgcn_mfma_f32_16x16x32_f16(bf[ni], af[mi], acc[mi][ni], 0, 0, 0);
        __builtin_amdgcn_s_setprio(0);
        cur = (cur == 3 * GEMM_STAGE) ? 0 : cur + GEMM_STAGE;
        nxt = (nxt == 3 * GEMM_STAGE) ? 0 : nxt + GEMM_STAGE;
    }
}
template <typename F>
__device__ __forceinline__ void acc_foreach(const f32x4 (&acc)[8][4], F f) {
    const int lane = threadIdx.x & 63, wave = threadIdx.x >> 6;
    const int wm = wave >> 2, wn = wave & 3;
#pragma unroll
    for (int mi = 0; mi < 8; ++mi)
#pragma unroll
        for (int ni = 0; ni < 4; ++ni)
            f(128 * wm + 16 * mi + (lane & 15), 64 * wn + 16 * ni + 4 * (lane >> 4), acc[mi][ni]);
}
namespace g8 {
constexpr int BK = 64, HALF = 128, HTB = HALF * BK * 2;
__device__ __forceinline__ int lds_byte(int r, int c) { const int st = (r >> 4) * 2 + (c >> 5), rr = r & 15, cc = c & 31, ob = rr * 64 + cc * 2; return st * 1024 + (ob ^ (((ob >> 9) & 1) << 5)); }
__device__ __forceinline__ void stage_rc(int b, int& R, int& C) { const int st = b / 1024, sb = b % 1024, swz = sb ^ (((sb >> 9) & 1) << 5); R = (st >> 1) * 16 + swz / 64; C = (st & 1) * 32 + (swz % 64) / 2; }
struct Unit { const h16* a; const h16* b; int u0, u1, u2, u3, u4; };
}
template <class Sched, class Epi>
__device__ __forceinline__ void gemm_phase8(char* smem, int lda, int ldb, int K, const Sched& S, const Epi& E) {
    using namespace g8;
    LAS unsigned char* lds = (LAS unsigned char*)smem;
    const int tid = threadIdx.x, wid = __builtin_amdgcn_readfirstlane(tid >> 6), lane = tid & 63, wr = wid >> 2, wc = wid & 3, fr = lane & 15, fq = lane >> 4;
    const int nt = K / BK;
    unsigned voffA[2], voffB[2];
#pragma unroll
    for (int i = 0; i < 2; ++i) { int R, C; stage_rc(tid * 16 + i * 8192, R, C); voffA[i] = (unsigned)(R * lda + C) * 2u; voffB[i] = (unsigned)(R * ldb + C) * 2u; }
    const size_t kstep = (size_t)(BK * 2);
    const size_t hstepA = (size_t)HALF * lda * 2, hstepB = (size_t)HALF * ldb * 2;
    const unsigned ldsw = (unsigned)wid * 1024u;
    const int aoff = lds_byte(wr * 64 + fr, fq * 8), boff = lds_byte(wc * 32 + fr, fq * 8);
#define G8_SA(b, h) (((b) * 2 + (h)) * HTB)
#define G8_SB(b, h) ((4 + (b) * 2 + (h)) * HTB)
#define G8_STAGE(bufoff, gbase, voff) do { _Pragma("unroll") for (int _i = 0; _i < 2; ++_i) \
        __builtin_amdgcn_global_load_lds((const __attribute__((address_space(1))) unsigned*)((const char*)(gbase) + (voff)[_i]), (LAS unsigned*)(lds + (bufoff) + ldsw + _i * 8192), 16, 0, 0); } while (0)
#define G8_LDA(dst, b, h) do { _Pragma("unroll") for (int m = 0; m < 4; ++m) _Pragma("unroll") for (int k = 0; k < 2; ++k) dst[m][k] = *(const LAS h16x8*)(lds + G8_SA(b, h) + aoff + m * 2048 + k * 1024); } while (0)
#define G8_LDB(dst, b, h) do { _Pragma("unroll") for (int n = 0; n < 2; ++n) _Pragma("unroll") for (int k = 0; k < 2; ++k) dst[n][k] = *(const LAS h16x8*)(lds + G8_SB(b, h) + boff + n * 2048 + k * 1024); } while (0)
#define G8_MMA(ai, bj, At, Bt) do { __builtin_amdgcn_s_setprio(1); _Pragma("unroll") for (int m = 0; m < 4; ++m) _Pragma("unroll") for (int n = 0; n < 2; ++n) _Pragma("unroll") for (int k = 0; k < 2; ++k) \
        acc[ai][bj][m][n] = __builtin_amdgcn_mfma_f32_16x16x32_f16(Bt[n][k], At[m][k], acc[ai][bj][m][n], 0, 0, 0); __builtin_amdgcn_s_setprio(0); } while (0)
#define G8_WAIT_V(n) asm volatile("s_waitcnt vmcnt(" #n ")" ::: "memory")
#define G8_WAIT_L(n) asm volatile("s_waitcnt lgkmcnt(" #n ")" ::: "memory")
#define G8_BAR __builtin_amdgcn_s_barrier()
#define G8_SCHED __builtin_amdgcn_sched_barrier(0)
    Unit cur, nxt; int ui = 0;
    G8_WAIT_V(0);
    __syncthreads();
    if (!S(0, cur)) return;
    f32x4 acc[2][2][4][2];
#pragma unroll
    for (int a = 0; a < 2; ++a)
#pragma unroll
        for (int b = 0; b < 2; ++b)
#pragma unroll
            for (int m = 0; m < 4; ++m)
#pragma unroll
                for (int n = 0; n < 2; ++n) acc[a][b][m][n] = (f32x4){0.f, 0.f, 0.f, 0.f};
    h16x8 At[4][2], B0[2][2], B1[2][2];
    const char* cA = (const char*)cur.a; const char* cB = (const char*)cur.b;
    G8_STAGE(G8_SB(0, 0), cB, voffB); G8_STAGE(G8_SA(0, 0), cA, voffA); G8_STAGE(G8_SB(0, 1), cB + hstepB, voffB); G8_STAGE(G8_SA(0, 1), cA + hstepA, voffA);
    if (wr == 1) G8_BAR;
    G8_WAIT_V(4); G8_BAR;
    G8_STAGE(G8_SB(1, 0), cB + kstep, voffB); G8_STAGE(G8_SA(1, 0), cA + kstep, voffA); G8_STAGE(G8_SB(1, 1), cB + hstepB + kstep, voffB);
    G8_WAIT_V(6); G8_BAR;
    for (;;) {
        const bool has_next = S(ui + 1, nxt);
        const char* nA = has_next ? (const char*)nxt.a : cA; const char* nB = has_next ? (const char*)nxt.b : cB;
        for (int t = 0; t < nt; t += 2) {
            const bool last = (t == nt - 2);
            const char* a1 = cA + (size_t)(t + 1) * kstep;
            const char* a2 = last ? nA : cA + (size_t)(t + 2) * kstep; const char* b2 = last ? nB : cB + (size_t)(t + 2) * kstep;
            const char* a3 = a2 + kstep; const char* b3 = b2 + kstep;
            G8_LDB(B0, 0, 0); G8_SCHED; G8_LDA(At, 0, 0); G8_STAGE(G8_SA(1, 1), a1 + hstepA, voffA);
            G8_WAIT_L(8); G8_BAR; G8_WAIT_L(0); G8_MMA(0, 0, At, B0); G8_BAR; G8_SCHED;
            G8_LDB(B1, 0, 1); G8_STAGE(G8_SB(0, 0), b2, voffB);
            G8_BAR; G8_WAIT_L(0); G8_MMA(0, 1, At, B1); G8_BAR;
            G8_LDA(At, 0, 1); G8_STAGE(G8_SA(0, 0), a2, voffA);
            G8_BAR; G8_WAIT_L(0); G8_MMA(1, 0, At, B0); G8_BAR; G8_SCHED;
            G8_STAGE(G8_SB(0, 1), b2 + hstepB, voffB);
            G8_WAIT_V(6); G8_BAR; G8_MMA(1, 1, At, B1); G8_BAR;
            G8_LDB(B0, 1, 0); G8_SCHED; G8_LDA(At, 1, 0); G8_STAGE(G8_SA(0, 1), a2 + hstepA, voffA);
            G8_WAIT_L(8); G8_BAR; G8_WAIT_L(0); G8_MMA(0, 0, At, B0); G8_BAR; G8_SCHED;
            G8_LDB(B1, 1, 1); G8_STAGE(G8_SB(1, 0), b3, voffB);
            G8_BAR; G8_WAIT_L(0); G8_MMA(0, 1, At, B1); G8_BAR;
            G8_LDA(At, 1, 1); G8_STAGE(G8_SA(1, 0), a3, voffA);
            G8_BAR; G8_WAIT_L(0); G8_MMA(1, 0, At, B0); G8_BAR; G8_SCHED;
            G8_STAGE(G8_SB(1, 1), b3 + hstepB, voffB);
            G8_WAIT_V(6); G8_BAR; G8_MMA(1, 1, At, B1); G8_BAR;
        }
        E(cur, acc, wr, wc, fr, fq);
        if (!has_next) break;
#pragma unroll
        for (int a = 0; a < 2; ++a)
#pragma unroll
            for (int b = 0; b < 2; ++b)
#pragma unroll
                for (int m = 0; m < 4; ++m)
#pragma unroll
                    for (int n = 0; n < 2; ++n) acc[a][b][m][n] = (f32x4){0.f, 0.f, 0.f, 0.f};
        cur = nxt; cA = nA; cB = nB; ++ui;
    }
    G8_WAIT_V(0);
    if (wr == 0) G8_BAR;
    G8_BAR;
#undef G8_SA
#undef G8_SB
#undef G8_STAGE
#undef G8_LDA
#undef G8_LDB
#undef G8_MMA
#undef G8_WAIT_V
#undef G8_WAIT_L
#undef G8_BAR
#undef G8_SCHED
}
template <class Sched, class RowOff, class Epi>
__device__ __forceinline__ void gemm_phase8g(char* smem, const h16* baseA_, int ldb, int K, const Sched& S, const RowOff& RO, const Epi& E) {
    using namespace g8;
    LAS unsigned char* lds = (LAS unsigned char*)smem;
    const char* baseA = (const char*)baseA_;
    const int tid = threadIdx.x, wid = __builtin_amdgcn_readfirstlane(tid >> 6), lane = tid & 63, wr = wid >> 2, wc = wid & 3, fr = lane & 15, fq = lane >> 4;
    const int nt = K / BK;
    int Rl[2], Cl[2]; unsigned voffB[2];
#pragma unroll
    for (int i = 0; i < 2; ++i) { stage_rc(tid * 16 + i * 8192, Rl[i], Cl[i]); voffB[i] = (unsigned)(Rl[i] * ldb + Cl[i]) * 2u; }
    const size_t kstep = (size_t)(BK * 2);
    const size_t hstepB = (size_t)HALF * ldb * 2;
    const unsigned ldsw = (unsigned)wid * 1024u;
    const int aoff = lds_byte(wr * 64 + fr, fq * 8), boff = lds_byte(wc * 32 + fr, fq * 8);
#define G8_SA(b, h) (((b) * 2 + (h)) * HTB)
#define G8_SB(b, h) ((4 + (b) * 2 + (h)) * HTB)
#define G8_STAGE(bufoff, gbase, voff) do { _Pragma("unroll") for (int _i = 0; _i < 2; ++_i) \
        __builtin_amdgcn_global_load_lds((const __attribute__((address_space(1))) unsigned*)((const char*)(gbase) + (voff)[_i]), (LAS unsigned*)(lds + (bufoff) + ldsw + _i * 8192), 16, 0, 0); } while (0)
#define G8_LDA(dst, b, h) do { _Pragma("unroll") for (int m = 0; m < 4; ++m) _Pragma("unroll") for (int k = 0; k < 2; ++k) dst[m][k] = *(const LAS h16x8*)(lds + G8_SA(b, h) + aoff + m * 2048 + k * 1024); } while (0)
#define G8_LDB(dst, b, h) do { _Pragma("unroll") for (int n = 0; n < 2; ++n) _Pragma("unroll") for (int k = 0; k < 2; ++k) dst[n][k] = *(const LAS h16x8*)(lds + G8_SB(b, h) + boff + n * 2048 + k * 1024); } while (0)
#define G8_MMA(ai, bj, At, Bt) do { __builtin_amdgcn_s_setprio(1); _Pragma("unroll") for (int m = 0; m < 4; ++m) _Pragma("unroll") for (int n = 0; n < 2; ++n) _Pragma("unroll") for (int k = 0; k < 2; ++k) \
        acc[ai][bj][m][n] = __builtin_amdgcn_mfma_f32_16x16x32_f16(Bt[n][k], At[m][k], acc[ai][bj][m][n], 0, 0, 0); __builtin_amdgcn_s_setprio(0); } while (0)
#define G8_WAIT_V(n) asm volatile("s_waitcnt vmcnt(" #n ")" ::: "memory")
#define G8_WAIT_L(n) asm volatile("s_waitcnt lgkmcnt(" #n ")" ::: "memory")
#define G8_BAR __builtin_amdgcn_s_barrier()
#define G8_SCHED __builtin_amdgcn_sched_barrier(0)
    Unit cur, nxt; int ui = 0;
    G8_WAIT_V(0);
    __syncthreads();
    if (!S(0, cur)) return;
    f32x4 acc[2][2][4][2];
#pragma unroll
    for (int a = 0; a < 2; ++a)
#pragma unroll
        for (int b = 0; b < 2; ++b)
#pragma unroll
            for (int m = 0; m < 4; ++m)
#pragma unroll
                for (int n = 0; n < 2; ++n) acc[a][b][m][n] = (f32x4){0.f, 0.f, 0.f, 0.f};
    h16x8 At[4][2], B0[2][2], B1[2][2];
    unsigned oc0[2], oc1[2], on0[2], on1[2];
#pragma unroll
    for (int i = 0; i < 2; ++i) { oc0[i] = RO(cur, Rl[i]) + (unsigned)Cl[i] * 2u; oc1[i] = RO(cur, HALF + Rl[i]) + (unsigned)Cl[i] * 2u; }
    const char* cB = (const char*)cur.b;
    G8_STAGE(G8_SB(0, 0), cB, voffB); G8_STAGE(G8_SA(0, 0), baseA, oc0); G8_STAGE(G8_SB(0, 1), cB + hstepB, voffB); G8_STAGE(G8_SA(0, 1), baseA, oc1);
    if (wr == 1) G8_BAR;
    G8_WAIT_V(4); G8_BAR;
    G8_STAGE(G8_SB(1, 0), cB + kstep, voffB); G8_STAGE(G8_SA(1, 0), baseA + kstep, oc0); G8_STAGE(G8_SB(1, 1), cB + hstepB + kstep, voffB);
    G8_WAIT_V(6); G8_BAR;
    for (;;) {
        const bool has_next = S(ui + 1, nxt);
        const char* nB = has_next ? (const char*)nxt.b : cB;
#pragma unroll
        for (int i = 0; i < 2; ++i) {
            on0[i] = has_next ? RO(nxt, Rl[i]) + (unsigned)Cl[i] * 2u : oc0[i];
            on1[i] = has_next ? RO(nxt, HALF + Rl[i]) + (unsigned)Cl[i] * 2u : oc1[i];
        }
        for (int t = 0; t < nt; t += 2) {
            const bool last = (t == nt - 2);
            const char* a1 = baseA + (size_t)(t + 1) * kstep;
            const char* a2 = last ? baseA : baseA + (size_t)(t + 2) * kstep;
            const char* b2 = last ? nB : cB + (size_t)(t + 2) * kstep;
            const char* a3 = a2 + kstep; const char* b3 = b2 + kstep;
            unsigned o20[2], o21[2];
#pragma unroll
            for (int i = 0; i < 2; ++i) { o20[i] = last ? on0[i] : oc0[i]; o21[i] = last ? on1[i] : oc1[i]; }
            G8_LDB(B0, 0, 0); G8_SCHED; G8_LDA(At, 0, 0); G8_STAGE(G8_SA(1, 1), a1, oc1);
            G8_WAIT_L(8); G8_BAR; G8_WAIT_L(0); G8_MMA(0, 0, At, B0); G8_BAR; G8_SCHED;
            G8_LDB(B1, 0, 1); G8_STAGE(G8_SB(0, 0), b2, voffB);
            G8_BAR; G8_WAIT_L(0); G8_MMA(0, 1, At, B1); G8_BAR;
            G8_LDA(At, 0, 1); G8_STAGE(G8_SA(0, 0), a2, o20);
            G8_BAR; G8_WAIT_L(0); G8_MMA(1, 0, At, B0); G8_BAR; G8_SCHED;
            G8_STAGE(G8_SB(0, 1), b2 + hstepB, voffB);
            G8_WAIT_V(6); G8_BAR; G8_MMA(1, 1, At, B1); G8_BAR;
            G8_LDB(B0, 1, 0); G8_SCHED; G8_LDA(At, 1, 0); G8_STAGE(G8_SA(0, 1), a2, o21);
            G8_WAIT_L(8); G8_BAR; G8_WAIT_L(0); G8_MMA(0, 0, At, B0); G8_BAR; G8_SCHED;
            G8_LDB(B1, 1, 1); G8_STAGE(G8_SB(1, 0), b3, voffB);
            G8_BAR; G8_WAIT_L(0); G8_MMA(0, 1, At, B1); G8_BAR;
            G8_LDA(At, 1, 1); G8_STAGE(G8_SA(1, 0), a3, o20);
            G8_BAR; G8_WAIT_L(0); G8_MMA(1, 0, At, B0); G8_BAR; G8_SCHED;
            G8_STAGE(G8_SB(1, 1), b3 + hstepB, voffB);
            G8_WAIT_V(6); G8_BAR; G8_MMA(1, 1, At, B1); G8_BAR;
        }
        E(cur, acc, wr, wc, fr, fq);
        if (!has_next) break;
#pragma unroll
        for (int a = 0; a < 2; ++a)
#pragma unroll
            for (int b = 0; b < 2; ++b)
#pragma unroll
                for (int m = 0; m < 4; ++m)
#pragma unroll
                    for (int n = 0; n < 2; ++n) acc[a][b][m][n] = (f32x4){0.f, 0.f, 0.f, 0.f};
        cur = nxt; cB = nB; ++ui;
#pragma unroll
        for (int i = 0; i < 2; ++i) { oc0[i] = on0[i]; oc1[i] = on1[i]; }
    }
    G8_WAIT_V(0);
    if (wr == 0) G8_BAR;
    G8_BAR;
#undef G8_SA
#undef G8_SB
#undef G8_STAGE
#undef G8_LDA
#undef G8_LDB
#undef G8_MMA
#undef G8_WAIT_V
#undef G8_WAIT_L
#undef G8_BAR
#undef G8_SCHED
}
template <typename F>
__device__ __forceinline__ void acc8_foreach(const f32x4 (&acc)[2][2][4][2], int wr, int wc, int fr, int fq, F f) {
#pragma unroll
    for (int ai = 0; ai < 2; ++ai)
#pragma unroll
        for (int m = 0; m < 4; ++m)
#pragma unroll
            for (int bj = 0; bj < 2; ++bj)
#pragma unroll
                for (int n = 0; n < 2; ++n)
                    f(128 * ai + 64 * wr + 16 * m + fr, 128 * bj + 32 * wc + 16 * n + 4 * fq, acc[ai][bj][m][n]);
}
__device__ __forceinline__ void store_h4(h16* p, f32x4 v) { h16x4 o = {(h16)v[0], (h16)v[1], (h16)v[2], (h16)v[3]}; *(h16x4*)p = o; }
__device__ __forceinline__ void tile_order(int t, int MT, int NTl, int& tm, int& tn) {
    const int GM = 8;
    const int per = GM * NTl;
    const int g = t / per, r = t - g * per;
    const int fm = g * GM;
    const int gsz = (MT - fm) < GM ? (MT - fm) : GM;
    tm = fm + (r % gsz); tn = r / gsz;
}

struct ConvDesc { const float* src; h16* dst; int N, ldd, k0, n0, mode; };
constexpr int CONV_T0 = 2432, CONV_T1 = CONV_T0 + 1024, CONV_T2 = CONV_T1 + 1024, CONV_T3 = CONV_T2 + 32, CONV_T4 = CONV_T3 + 32, CONV_T5 = CONV_T4 + 32, CONV_T6 = CONV_T5 + 16 * 768;
__device__ __forceinline__ ConvDesc conv_desc_expert(const Params& p, int l, int u) {
    char* ws = p.ws;
    const int e = u / 768, r = u % 768;
    const int le = l * 16 + e;
    const int which = r >> 8, q = r & 255;
    ConvDesc d;
    if (which < 2) {
        d.src = p.in[27 + which] + (size_t)le * 2048 * 512; d.N = 512; d.k0 = (q >> 3) * 64; d.n0 = (q & 7) * 64;
        d.dst = (h16*)(ws + OFF_EXP + l * EXP_L) + (size_t)e * 1024 * 2048; d.ldd = 2048; d.mode = 1 + which;
    } else {
        d.src = p.in[29] + (size_t)le * 512 * 2048; d.N = 2048; d.k0 = (q >> 5) * 64; d.n0 = (q & 31) * 64;
        d.dst = (h16*)(ws + OFF_EXP + l * EXP_L + EGU_BYTES) + (size_t)e * 2048 * 512; d.ldd = 512; d.mode = 0;
    }
    return d;
}
__device__ __forceinline__ ConvDesc conv_desc_prologue(const Params& p, int t) {
    char* ws = p.ws;
    ConvDesc d; d.mode = 0;
    if (t < CONV_T0) { d.src = p.in[8]; d.N = IN_COLS; d.k0 = (t / 76) * 64; d.n0 = (t % 76) * 64; d.dst = (h16*)(ws + OFF_WIN); d.ldd = D; }
    else if (t < CONV_T1) { const int u = t - CONV_T0; d.src = p.in[23]; d.N = D; d.k0 = (u >> 5) * 64; d.n0 = (u & 31) * 64; d.dst = (h16*)(ws + OFF_WOUT); d.ldd = D; }
    else if (t < CONV_T2) { const int u = t - CONV_T1; d.src = p.in[24]; d.N = D; d.k0 = (u >> 5) * 64; d.n0 = (u & 31) * 64; d.dst = (h16*)(ws + OFF_FW); d.ldd = D; }
    else if (t < CONV_T3) { const int u = t - CONV_T2; const int dd = u >> 4; d.src = p.in[12] + (size_t)dd * 64 * 1024; d.N = 1024; d.k0 = 0; d.n0 = (u & 15) * 64; d.dst = (h16*)(ws + OFF_W2T) + (size_t)dd * 1024 * 64; d.ldd = 64; }
    else if (t < CONV_T4) { const int u = t - CONV_T3; const int dd = u >> 4; d.src = p.in[14] + (size_t)dd * 64 * 1024; d.N = 1024; d.k0 = 0; d.n0 = (u & 15) * 64; d.dst = (h16*)(ws + OFF_A2T) + (size_t)dd * 1024 * 64; d.ldd = 64; }
    else if (t < CONV_T5) { const int u = t - CONV_T4; d.src = p.in[15]; d.N = 1024; d.k0 = (u >> 4) * 64; d.n0 = (u & 15) * 64; d.dst = (h16*)(ws + OFF_G2T); d.ldd = 128; }
    else d = conv_desc_expert(p, 0, t - CONV_T5);
    return d;
}
template <typename DescFn>
__device__ __forceinline__ void conv_run(char* smem, int t_end, DescFn get) {
    const int vb = threadIdx.x >> 8, tid = threadIdx.x & 255;
    unsigned* tile = (unsigned*)(smem + vb * 17408);
    const int nc = tid & 15, kp = tid >> 4;
    const int kc = tid & 7, nr = tid >> 3;
    int tp = blockIdx.x;
    if (4 * tp >= t_end) return;
    auto clampt = [&](int tpp, int u) { const int t = 4 * tpp + 2 * vb + u; return t < t_end ? t : t_end - 1; };
    ConvDesc d[2]; f32x4 a0[2], b0[2], a1[2], b1[2];
#pragma unroll
    for (int u = 0; u < 2; ++u) {
        d[u] = get(clampt(tp, u));
        const float* s0 = d[u].src + (size_t)(d[u].k0 + 2 * kp) * d[u].N + d[u].n0 + 4 * nc;
        a0[u] = *(const f32x4*)s0; b0[u] = *(const f32x4*)(s0 + d[u].N);
        const float* s1 = s0 + (size_t)32 * d[u].N;
        a1[u] = *(const f32x4*)s1; b1[u] = *(const f32x4*)(s1 + d[u].N);
    }
    __syncthreads();
    for (;;) {
        const int tn = tp + (int)gridDim.x;
        const bool more = 4 * tn < t_end;
        ConvDesc dn[2]; f32x4 na0[2], nb0[2], na1[2], nb1[2];
#pragma unroll
        for (int u = 0; u < 2; ++u) { dn[u] = d[u]; na0[u] = a0[u]; nb0[u] = b0[u]; na1[u] = a1[u]; nb1[u] = b1[u]; }
        if (more) {
#pragma unroll
            for (int u = 0; u < 2; ++u) {
                dn[u] = get(clampt(tn, u));
                const float* s0 = dn[u].src + (size_t)(dn[u].k0 + 2 * kp) * dn[u].N + dn[u].n0 + 4 * nc;
                na0[u] = *(const f32x4*)s0; nb0[u] = *(const f32x4*)(s0 + dn[u].N);
                const float* s1 = s0 + (size_t)32 * dn[u].N;
                na1[u] = *(const f32x4*)s1; nb1[u] = *(const f32x4*)(s1 + dn[u].N);
            }
        }
#pragma unroll
        for (int u = 0; u < 2; ++u)
#pragma unroll
            for (int e = 0; e < 4; ++e) { tile[u * 2176 + (4 * nc + e) * 33 + kp] = pack_h2(a0[u][e], b0[u][e]); tile[u * 2176 + (4 * nc + e) * 33 + kp + 16] = pack_h2(a1[u][e], b1[u][e]); }
        __syncthreads();
#pragma unroll
        for (int u = 0; u < 2; ++u)
#pragma unroll
            for (int ps = 0; ps < 2; ++ps) {
                const int n = nr + 32 * ps;
                u32x4 v;
                v[0] = tile[u * 2176 + n * 33 + 4 * kc + 0]; v[1] = tile[u * 2176 + n * 33 + 4 * kc + 1]; v[2] = tile[u * 2176 + n * 33 + 4 * kc + 2]; v[3] = tile[u * 2176 + n * 33 + 4 * kc + 3];
                const int ng = d[u].n0 + n;
                int np = ng;
                if (d[u].mode == 1) np = 32 * (ng >> 4) + (ng & 15);
                else if (d[u].mode == 2) np = 32 * (ng >> 4) + 16 + (ng & 15);
                *(u32x4*)(d[u].dst + (size_t)np * d[u].ldd + d[u].k0 + 8 * kc) = v;
            }
        __syncthreads();
        if (!more) break;
#pragma unroll
        for (int u = 0; u < 2; ++u) { d[u] = dn[u]; a0[u] = na0[u]; b0[u] = nb0[u]; a1[u] = na1[u]; b1[u] = nb1[u]; }
        tp = tn;
    }
}
__device__ __forceinline__ void phase_conv_experts(const Params& p, char* smem, int bid, int nblk, int l) {
    conv_run(smem, 16 * 768, [&](int t) { return conv_desc_expert(p, l, t); });
}
__device__ __forceinline__ void phase_prologue(const Params& p, char* smem, int bid, int nblk) {
    const int tid = threadIdx.x;
    char* ws = p.ws;
    {
        float* sl = (float*)smem;
        float* red = sl + 5 * 2048;
        float* mod = (float*)(ws + OFF_MOD);
        for (int i = tid; i < 5 * 2048; i += NT) {
            const int v = i >> 11, kk = i & 2047;
            const float cv = (v < 4) ? p.in[1][v * D + kk] : p.in[3][kk];
            sl[i] = siluf_(cv);
        }
        __syncthreads();
        const int ks = tid >> 3, cg = tid & 7;
        for (int it = bid; it < 2 * 384; it += nblk) {
            const int l = it / 384, nc = it % 384;
            const int n0 = nc * 32 + cg * 4;
            const float* wp = p.in[4] + ((size_t)l * D + ks * 32) * 12288 + n0;
            f32x4 a0 = {0, 0, 0, 0}, a1 = a0, a2 = a0, a3 = a0, a4 = a0;
#pragma unroll 8
            for (int kk = 0; kk < 32; ++kk) {
                const f32x4 w = *(const f32x4*)(wp + (size_t)kk * 12288);
                const int k = ks * 32 + kk;
                a0 += w * sl[k]; a1 += w * sl[2048 + k]; a2 += w * sl[4096 + k]; a3 += w * sl[6144 + k]; a4 += w * sl[8192 + k];
            }
            float* r = red + ks * 160 + cg * 4;
            *(f32x4*)(r) = a0; *(f32x4*)(r + 32) = a1; *(f32x4*)(r + 64) = a2; *(f32x4*)(r + 96) = a3; *(f32x4*)(r + 128) = a4;
            __syncthreads();
            if (tid < 160) {
                const int v = tid >> 5, c = tid & 31;
                float sum = p.in[5][l * 12288 + nc * 32 + c];
#pragma unroll 8
                for (int q = 0; q < 64; ++q) sum += red[q * 160 + v * 32 + c];
                mod[(size_t)(l * 5 + v) * 12288 + nc * 32 + c] = sum;
            }
            __syncthreads();
        }
    }
    {
        h16* DT = (h16*)(ws + OFF_DT);
        const float sT = 0.022097086912079608f;
        for (size_t i = (size_t)bid * NT + tid; i < (size_t)2048 * 2048; i += (size_t)nblk * NT) {
            const int k = (int)(i >> 11), kp = (int)(i & 2047);
            const int t = kp & 1023;
            const int m = (k * t) & 2047;
            const float x = (float)m * (1.0f / 1024.0f);
            const float v = (kp < 1024) ? cospif(x) : -sinpif(x);
            DT[i] = (h16)(v * sT);
        }
        h16* DC = (h16*)(ws + OFF_DC);
        for (int i = bid * NT + tid; i < 512 * 256; i += nblk * NT) {
            const int n = i >> 8, c = i & 255;
            const int m = ((n & 255) * c) & 255;
            const float x = (float)m * (1.0f / 128.0f);
            const float v = (n < 256) ? cospif(x) : sinpif(x);
            DC[i] = (h16)(v * 0.0625f);
        }
        h16* RWH = (h16*)(ws + OFF_RWH); h16* RWL = (h16*)(ws + OFF_RWL);
        for (int i = bid * NT + tid; i < 16 * 2048; i += nblk * NT) {
            const int e = i >> 11, k = i & 2047;
            const float w = p.in[25][k * 16 + e];
            const h16 wh = (h16)w;
            RWH[i] = wh; RWL[i] = (h16)((w - (float)wh) * 4096.0f);
        }
        float* RP = (float*)(ws + OFF_ROPE);
        for (int i = bid * NT + tid; i < 2048 * 64; i += nblk * NT) {
            const int t = i >> 6, f = i & 63;
            const int fi = f & 31;
            const float inv = powf(10000.0f, -(float)(2 * fi) / 64.0f);
            const float pos = (f < 32) ? (float)(t >> 6) : (float)(t & 63);
            const float ang = pos * inv;
            RP[2 * i] = cosf(ang); RP[2 * i + 1] = sinf(ang);
        }
    }
    __syncthreads();
    conv_run(smem, CONV_T6, [&](int t) { return conv_desc_prologue(p, t); });
}

__device__ __forceinline__ void phase_modfin(const Params& p, int bid, int nblk) {
    const float* modp = (const float*)(p.ws + OFF_MODP);
    float* mod = (float*)(p.ws + OFF_MOD);
    for (int i = bid * NT + threadIdx.x; i < 2 * 5 * 12288; i += nblk * NT) {
        const int n = i % 12288, l = i / (5 * 12288);
        float s = p.in[5][l * 12288 + n];
#pragma unroll
        for (int ks = 0; ks < 16; ++ks) s += modp[(size_t)ks * (2 * 5 * 12288) + i];
        mod[i] = s;
    }
}
__device__ __forceinline__ const float* modv(const Params& p, int l, int v, int part) { return (const float*)(p.ws + OFF_MOD) + ((size_t)(l * 5 + v) * 6 + part) * 2048; }

__device__ __forceinline__ void phase_norm0(const Params& p, int bid, int nblk) {
    const int lane = threadIdx.x & 63, wave = threadIdx.x >> 6;
    h16* H = (h16*)(p.ws + OFF_H);
    for (int R = bid * NW + wave; R < ROWS0; R += nblk * NW) {
        const int b = R / SALL, s = R % SALL;
        const float* xr; int v;
        if (s < CTXL) { xr = p.in[2] + ((size_t)b * CTXL + s) * D; v = 4; } else { xr = p.in[0] + ((size_t)b * SEQ + (s - CTXL)) * D; v = b; }
        const float* sh = modv(p, 0, v, 0); const float* sc = modv(p, 0, v, 1);
        const float* gn = p.in[6];
        f32x4 x[8]; float ss = 0.f;
#pragma unroll
        for (int i = 0; i < 8; ++i) { x[i] = *(const f32x4*)(xr + i * 256 + lane * 4); ss += x[i][0] * x[i][0] + x[i][1] * x[i][1] + x[i][2] * x[i][2] + x[i][3] * x[i][3]; }
        ss = wave_sum(ss);
        const float rstd = rsqrtf(ss * (1.0f / D) + 1e-6f);
#pragma unroll
        for (int i = 0; i < 8; ++i) {
            const int k = i * 256 + lane * 4;
            const f32x4 g = *(const f32x4*)(gn + k), c1 = *(const f32x4*)(sc + k), h1 = *(const f32x4*)(sh + k);
            const f32x4 y = (x[i] * rstd) * g * (c1 + 1.0f) + h1;
            store_h4(H + (size_t)R * D + k, y);
        }
    }
}

__device__ __forceinline__ void phase_gemm_in(const Params& p, char* smem, int bid, int nblk) {
    const h16* A = (const h16*)(p.ws + OFF_H);
    const h16* Bt = (const h16*)(p.ws + OFF_WIN);
    h16* P = (h16*)(p.ws + OFF_P);
    const int MT = ROWS0 / 256, NTl = IN_COLS / 256;
    auto sched = [&](int i, g8::Unit& u) {
        const int t = bid + i * nblk;
        if (t >= MT * NTl) return false;
        int tm, tn; tile_order(t, MT, NTl, tm, tn);
        u.a = A + (size_t)(tm * 256) * D; u.b = Bt + (size_t)(tn * 256) * D; u.u0 = tm; u.u1 = tn; u.u2 = 0; u.u3 = 0;
        return true;
    };
    gemm_phase8(smem, D, D, D, sched, [&](const g8::Unit& u, const f32x4 (&acc)[2][2][4][2], int wr, int wc, int fr, int fq) {
        const int tm = u.u0, tn = u.u1;
        acc8_foreach(acc, wr, wc, fr, fq, [&](int r, int c, f32x4 v) { store_h4(P + (size_t)(tm * 256 + r) * IN_COLS + tn * 256 + c, v); });
    });
}

__device__ __forceinline__ void phase_prep(const Params& p, int bid, int nblk) {
    const int lane = threadIdx.x & 63, wave = threadIdx.x >> 6;
    char* ws = p.ws;
    const h16* P = (const h16*)(ws + OFF_P);
    h16* SR = (h16*)(ws + OFF_SR); h16* SV = (h16*)(ws + OFF_SV); h16* SKS = (h16*)(ws + OFF_SKS); h16* SKK = (h16*)(ws + OFF_SKK);
    h16* F = (h16*)(ws + OFF_F);
    h16* Q = (h16*)(ws + OFF_Q); h16* KB = (h16*)(ws + OFF_KB); h16* VT = (h16*)(ws + OFF_VT);
    const float* RP = (const float*)(ws + OFF_ROPE);
    const float* mup = p.in[9]; const float* mun = p.in[10];
    const float* k_k = p.in[16];
    for (int R = bid * NW + wave; R < ROWS0; R += nblk * NW) {
        const int b = R / SALL, s = R % SALL;
        const bool has_prev = !(s == 0 || s == CTXL);
        const bool has_next = !(s == CTXL - 1 || s == SALL - 1);
        const h16* p0 = P + (size_t)R * IN_COLS;
        const h16* pm = p0 - IN_COLS; const h16* pn = p0 + IN_COLS;
#pragma unroll
        for (int part = 0; part < 3; ++part) {
#pragma unroll
            for (int i = 0; i < 4; ++i) {
                const int c = i * 256 + lane * 4, col = part * 1024 + c;
                const h16x4 a = *(const h16x4*)(p0 + col);
                h16x4 am = {0, 0, 0, 0}, an = {0, 0, 0, 0};
                if (has_prev) am = *(const h16x4*)(pm + col);
                if (has_next) an = *(const h16x4*)(pn + col);
                const f32x4 mp = *(const f32x4*)(mup + col), mn = *(const f32x4*)(mun + col);
                f32x4 y;
#pragma unroll
                for (int e = 0; e < 4; ++e) { const float x0 = (float)a[e]; y[e] = x0 + mp[e] * ((float)am[e] - x0) + mn[e] * ((float)an[e] - x0); }
                if (part == 0) store_h4(SR + (size_t)R * DA + c, y);
                else if (part == 2) store_h4(SV + (size_t)R * DA + c, y);
                else {
                    store_h4(SKS + (size_t)R * DA + c, y);
                    const f32x4 kk4 = *(const f32x4*)(k_k + c);
                    f32x4 z = y * kk4;
                    float ss = z[0] * z[0] + z[1] * z[1] + z[2] * z[2] + z[3] * z[3];
                    ss = row16_sum(ss);
                    z = z * rsqrtf(ss + 1e-12f);
                    store_h4(SKK + (size_t)R * DA + c, z);
                }
            }
        }
        {
            auto shifted = [&](int col) {
                const float x0 = (float)p0[col];
                const float xm = has_prev ? (float)pm[col] : 0.f, xn = has_next ? (float)pn[col] : 0.f;
                return x0 + mup[col] * (xm - x0) + mun[col] * (xn - x0);
            };
            F[(size_t)R * 256 + lane] = (h16)ftanh_(shifted(3072 + lane));
            F[(size_t)R * 256 + 64 + lane] = (h16)shifted(3136 + lane);
            F[(size_t)R * 256 + 128 + lane] = (h16)fsigmoid_(shifted(3200 + lane));
            F[(size_t)R * 256 + 192 + lane] = (h16)fsigmoid_(shifted(3264 + lane));
        }
        {
            const bool lat = (s >= CTXL);
            const int t = s - CTXL;
            float cs = 1.f, sn = 0.f;
            if (lat) { cs = RP[((size_t)t * 64 + lane) * 2]; sn = RP[((size_t)t * 64 + lane) * 2 + 1]; }
            const float qg0 = p.in[21][2 * lane], qg1 = p.in[21][2 * lane + 1];
            const float kg0 = p.in[22][2 * lane], kg1 = p.in[22][2 * lane + 1];
            if (lat) {
#pragma unroll
                for (int h = 0; h < 8; ++h) {
                    const h16x2 v2 = *(const h16x2*)(p0 + A_COLS + h * 128 + 2 * lane);
                    float x0 = (float)v2[0], x1 = (float)v2[1];
                    const float ss = wave_sum(x0 * x0 + x1 * x1);
                    const float rstd = rsqrtf(ss * (1.0f / 128.0f) + 1e-6f);
                    x0 = x0 * rstd * qg0; x1 = x1 * rstd * qg1;
                    const float qs = 0.12751743074602897f;
                    const float o0 = (x0 * cs - x1 * sn) * qs, o1 = (x0 * sn + x1 * cs) * qs;
                    h16x2 o = {(h16)o0, (h16)o1};
                    *(h16x2*)(Q + (((size_t)(b * 8 + h) * SEQ + t) * 128 + 2 * lane)) = o;
                }
            }
#pragma unroll
            for (int h = 0; h < 2; ++h) {
                const h16x2 v2 = *(const h16x2*)(p0 + A_COLS + 1024 + h * 128 + 2 * lane);
                float x0 = (float)v2[0], x1 = (float)v2[1];
                const float ss = wave_sum(x0 * x0 + x1 * x1);
                const float rstd = rsqrtf(ss * (1.0f / 128.0f) + 1e-6f);
                x0 = x0 * rstd * kg0; x1 = x1 * rstd * kg1;
                const float o0 = x0 * cs - x1 * sn, o1 = x0 * sn + x1 * cs;
                h16x2 o = {(h16)o0, (h16)o1};
                *(h16x2*)(KB + (((size_t)(b * 2 + h) * SALL + s) * 128 + 2 * lane)) = o;
                const h16x2 vv = *(const h16x2*)(p0 + A_COLS + 1280 + h * 128 + 2 * lane);
                *(h16x2*)((h16*)(ws + OFF_VB) + (((size_t)(b * 2 + h) * SALL + s) * 128 + 2 * lane)) = vv;
            }
        }
    }
}

__device__ __forceinline__ void phase_lora(const Params& p, char* smem, int bid, int nblk) {
    char* ws = p.ws;
    const h16* F = (const h16*)(ws + OFF_F);
    const int MT = ROWS0 / 256;
    const int T0 = MT * 8, T1 = T0 + MT * 8, T2 = T1 + MT * 4;
    for (int t = bid; t < T2; t += nblk) {
        f32x4 acc[8][4];
        if (t < T0) {
            const int tm = t % MT, tn = t / MT;
            const h16* Bt = (const h16*)(ws + OFF_W2T);
            gemm_tile(smem, [&](int r) { return F + (size_t)(tm * 256 + r) * 256; }, [&](int n) { return Bt + (size_t)(tn * 256 + n) * 64; }, 64, acc);
            const float* w0 = p.in[11];
            acc_foreach(acc, [&](int r, int c, f32x4 v) {
                const int R = tm * 256 + r, n = tn * 256 + c, d = n >> 10, ch = n & 1023;
                const f32x4 b4 = *(const f32x4*)(w0 + n);
                f32x4 o;
#pragma unroll
                for (int e = 0; e < 4; ++e) {
                    const float z = v[e] + b4[e];
                    o[e] = 0.6065306597126334f * fsigmoid_(z);
                }
                h16* W = (h16*)(ws + (d ? OFF_SW1 : OFF_SW0));
                store_h4(W + (size_t)R * DA + ch, o);
            });
        } else if (t < T1) {
            const int u = t - T0; const int tm = u % MT, tn = u / MT;
            const h16* Bt = (const h16*)(ws + OFF_A2T);
            gemm_tile(smem, [&](int r) { return F + (size_t)(tm * 256 + r) * 256 + 64; }, [&](int n) { return Bt + (size_t)(tn * 256 + n) * 64; }, 64, acc);
            const float* a0 = p.in[13];
            acc_foreach(acc, [&](int r, int c, f32x4 v) {
                const int R = tm * 256 + r, n = tn * 256 + c, d = n >> 10, ch = n & 1023;
                const f32x4 b4 = *(const f32x4*)(a0 + n);
                f32x4 av;
#pragma unroll
                for (int e = 0; e < 4; ++e) av[e] = fsigmoid_(v[e] + b4[e]);
                store_h4((h16*)(ws + (d ? OFF_SKD1 : OFF_SKD0)) + (size_t)R * DA + ch, av);
            });
        } else {
            const int u = t - T1; const int tm = u % MT, tn = u / MT;
            const h16* Bt = (const h16*)(ws + OFF_G2T);
            gemm_tile(smem, [&](int r) { return F + (size_t)(tm * 256 + r) * 256 + 128; }, [&](int n) { return Bt + (size_t)(tn * 256 + n) * 128; }, 128, acc);
            h16* SG = (h16*)(ws + OFF_SG);
            acc_foreach(acc, [&](int r, int c, f32x4 v) { store_h4(SG + (size_t)(tm * 256 + r) * DA + tn * 256 + c, v); });
        }
    }
}

__device__ __forceinline__ int srow_of(int dir, int tau) { return dir ? ((tau < CTXL) ? (CTXL - 1 - tau) : (SALL + CTXL - 1 - tau)) : tau; }

__device__ __forceinline__ void phase_chunkprep(const Params& p, char* smem, int bid, int nblk) {
    char* ws = p.ws;
    const int tid = threadIdx.x, lane = tid & 63, wave = tid >> 6;
    const int fr = lane & 15, g = lane >> 4;
    {
        const h16* VB = (const h16*)(ws + OFF_VB); h16* VT = (h16*)(ws + OFF_VT);
        h16* tl = (h16*)smem;
        for (int tile = bid; tile < 8 * (SALL / 64); tile += nblk) {
            const int pair = tile / (SALL / 64), kt = tile % (SALL / 64);
            __syncthreads();
#pragma unroll
            for (int i = 0; i < 2; ++i) {
                const int e = tid + i * NT;
                const h16x8 v = *(const h16x8*)(VB + ((size_t)pair * SALL + kt * 64 + (e >> 4)) * 128 + (e & 15) * 8);
                h16* dp = tl + (e >> 4) * 132 + (e & 15) * 8;
                *(h16x4*)dp = (h16x4){v[0], v[1], v[2], v[3]}; *(h16x4*)(dp + 4) = (h16x4){v[4], v[5], v[6], v[7]};
            }
            __syncthreads();
            const int d = tid >> 2, pc = tid & 3;
            h16x8 o0, o1;
#pragma unroll
            for (int q = 0; q < 16; ++q) {
                const int pos = pc * 16 + q, p32 = pos & 31, gq = p32 >> 3, jj = p32 & 7;
                const int key = (pos & 32) + ((jj < 4) ? (4 * gq + jj) : (16 + 4 * gq + jj - 4));
                const h16 val = tl[key * 132 + d];
                if (q < 8) o0[q] = val; else o1[q - 8] = val;
            }
            h16* dst = VT + ((size_t)pair * 128 + d) * SALL + kt * 64 + pc * 16;
            *(h16x8*)dst = o0; *(h16x8*)(dst + 8) = o1;
        }
        __syncthreads();
    }
    char* wl = smem + wave * 12288;
    h16* At = (h16*)(wl); h16* Rt = (h16*)(wl + 2048); h16* Btl = (h16*)(wl + 4096); h16* Ktl = (h16*)(wl + 6144);
    h16* Bj = (h16*)(wl + 8192); h16* Kj = (h16*)(wl + 10240);
    const h16* SKK = (const h16*)(ws + OFF_SKK); const h16* SR = (const h16*)(ws + OFF_SR);
    for (int u = bid * NW + wave; u < 128 * NCHUNK; u += nblk * NW) {
        const int item = u / NCHUNK, c = u - item * NCHUNK;
        const int dir = item & 1, h = (item >> 1) & 15, b = item >> 5;
        const h16* SW = (const h16*)(ws + (dir ? OFF_SW1 : OFF_SW0));
        const h16* SAL = (const h16*)(ws + (dir ? OFF_SKD1 : OFF_SKD0));
        const h16* SKS = (const h16*)(ws + OFF_SKS);
        const float ka = p.in[17][h * 64 + lane];
        char* rec = ws + (dir ? OFF_FRAG1 : OFF_FRAG0) + ((size_t)((b * 16 + h) * NCHUNK + c)) * REC_BYTES;
        float w[16], at[16], rt[16], bt[16], kt[16];
#pragma unroll
        for (int t = 0; t < 16; ++t) {
            const int s = srow_of(dir, 16 * c + t);
            const size_t idx = ((size_t)(b * SALL + s)) * DA + h * 64 + lane;
            const float kkv = (float)SKK[idx], al = (float)SAL[idx];
            w[t] = fexp_(-(float)SW[idx]); at[t] = -kkv; rt[t] = (float)SR[idx]; bt[t] = kkv * al; kt[t] = (float)SKS[idx] * (1.0f + (al - 1.0f) * ka);
        }
        float wn = 1.f;
        if (c + 1 < NCHUNK) {
#pragma unroll
            for (int t = 0; t < 8; ++t) { const int s = srow_of(dir, 16 * (c + 1) + t); wn *= fexp_(-(float)SW[((size_t)(b * SALL + s)) * DA + h * 64 + lane]); }
        }
        float cum[16];
        cum[0] = w[0];
#pragma unroll
        for (int t = 1; t < 16; ++t) cum[t] = cum[t - 1] * w[t];
        const float w7 = cum[7], inv7 = 1.0f / w7;
        float sigma;
        {
            float rprev = inv7;
#pragma unroll
            for (int t = 0; t < 16; ++t) {
                const float rho = cum[t] * inv7;
                const float irho = w7 / cum[t];
                at[t] *= rprev; rt[t] *= rho; bt[t] *= irho; kt[t] *= irho;
                rprev = rho;
            }
            sigma = rprev * wn;
        }
        __builtin_amdgcn_wave_barrier();
#pragma unroll
        for (int t = 0; t < 16; ++t) { At[t * 64 + lane] = (h16)at[t]; Rt[t * 64 + lane] = (h16)rt[t]; Btl[t * 64 + lane] = (h16)bt[t]; Ktl[t * 64 + lane] = (h16)kt[t]; }
        {
            h16x8 b0, b1, k0, k1;
#pragma unroll
            for (int t = 0; t < 8; ++t) { b0[t] = (h16)bt[t]; b1[t] = (h16)bt[8 + t]; k0[t] = (h16)kt[t]; k1[t] = (h16)kt[8 + t]; }
            *(h16x8*)(Bj + lane * 16) = b0; *(h16x8*)(Bj + lane * 16 + 8) = b1;
            *(h16x8*)(Kj + lane * 16) = k0; *(h16x8*)(Kj + lane * 16 + 8) = k1;
        }
        __builtin_amdgcn_wave_barrier();
#pragma unroll
        for (int ks = 0; ks < 2; ++ks) {
            const h16x4 alo = *(const h16x4*)(At + fr * 64 + 32 * ks + 4 * g), ahi = *(const h16x4*)(At + fr * 64 + 32 * ks + 16 + 4 * g);
            *(h16x8*)(rec + ks * 1024 + lane * 16) = cat8(alo, ahi);
            const h16x4 rlo = *(const h16x4*)(Rt + fr * 64 + 32 * ks + 4 * g), rhi = *(const h16x4*)(Rt + fr * 64 + 32 * ks + 16 + 4 * g);
            *(h16x8*)(rec + 2048 + ks * 1024 + lane * 16) = cat8(rlo, rhi);
        }
#pragma unroll
        for (int jt = 0; jt < 4; ++jt) {
            const h16x4 blo = *(const h16x4*)(Bj + (16 * jt + fr) * 16 + 4 * g), khi = *(const h16x4*)(Kj + (16 * jt + fr) * 16 + 4 * g);
            *(h16x8*)(rec + 4096 + jt * 1024 + lane * 16) = cat8(blo, khi);
        }
        const f32x4 z4 = {0.f, 0.f, 0.f, 0.f};
        f32x4 Nak = z4, Nab = z4, Mkr = z4, Mbr = z4, NT = z4;
#pragma unroll
        for (int ks = 0; ks < 2; ++ks) {
            const h16x8 af = *(const h16x8*)(At + fr * 64 + 32 * ks + 8 * g), rf = *(const h16x8*)(Rt + fr * 64 + 32 * ks + 8 * g);
            const h16x8 bf = *(const h16x8*)(Btl + fr * 64 + 32 * ks + 8 * g), kf = *(const h16x8*)(Ktl + fr * 64 + 32 * ks + 8 * g);
            Nak = mfma32(kf, af, Nak); Nab = mfma32(bf, af, Nab); Mkr = mfma32(kf, rf, Mkr); Mbr = mfma32(bf, rf, Mbr); NT = mfma32(af, bf, NT);
        }
        f32x4 T1;
#pragma unroll
        for (int e = 0; e < 4; ++e) {
            const int row = 4 * g + e;
            if (!(row < fr)) { Nak[e] = 0.f; Nab[e] = 0.f; }
            if (!(row <= fr)) { Mkr[e] = 0.f; Mbr[e] = 0.f; }
            if (!(fr < row)) NT[e] = 0.f;
            T1[e] = Nab[e] + ((row == fr) ? 1.0f : 0.0f);
        }
        const h16x4 n1 = cvt4(Nab), m1 = cvt4(NT);
        const f32x4 N2 = mfma16(m1, n1, z4), M2 = mfma16(n1, m1, z4);
        const h16x4 n2 = cvt4(N2), m2 = cvt4(M2);
        const f32x4 T2 = mfma16(m2, cvt4(T1), T1);
        const f32x4 N4 = mfma16(m2, n2, z4), M4 = mfma16(n2, m2, z4);
        const h16x4 n4 = cvt4(N4), m4 = cvt4(M4);
        const f32x4 T4 = mfma16(m4, cvt4(T2), T2);
        const f32x4 M8 = mfma16(n4, m4, z4);
        const f32x4 T8 = mfma16(cvt4(M8), cvt4(T4), T4);
        *(h16x8*)(rec + 8192 + lane * 16) = cat8(cvt4(Mbr), cvt4(Mkr));
        *(h16x4*)(rec + 9216 + lane * 8) = cvt4(T8);
        *(h16x4*)(rec + 9728 + lane * 8) = cvt4(Nak);
        *(float*)(rec + 10240 + lane * 4) = sigma;
        __builtin_amdgcn_wave_barrier();
    }
}

constexpr int SLOT_BYTES = REC_BYTES + 2048;
__device__ __forceinline__ void scan_item(const Params& p, char* smem, int item) {
    char* ws = p.ws;
    const int tid = threadIdx.x, lane = tid & 63;
    const int wave = __builtin_amdgcn_readfirstlane(tid >> 6);
    const int il = lane & 15, g = lane >> 4;
    const int dir = item & 1, h = (item >> 1) & 15, b = item >> 5;
    const char* rec0 = ws + (dir ? OFF_FRAG1 : OFF_FRAG0) + ((size_t)((b * 16 + h) * NCHUNK)) * REC_BYTES;
    const h16* SV = (const h16*)(ws + OFF_SV);
    h16* Y = (h16*)(ws + (dir ? OFF_Y1 : OFF_Y0));
    const f32x4 z4 = {0.f, 0.f, 0.f, 0.f};
    f32x4 P[4];
#pragma unroll
    for (int jt = 0; jt < 4; ++jt) P[jt] = z4;
    u32x4 lr[11], lv[2];
    auto issue = [&](int c) {
        const char* rec = rec0 + (size_t)c * REC_BYTES;
#pragma unroll
        for (int m = 0; m < 10; ++m) lr[m] = *(const u32x4*)(rec + m * 1024 + lane * 16);
        lr[10] = *(const u32x4*)(rec + 10240 + (lane & 15) * 16);
        const int s = srow_of(dir, 16 * c + (lane >> 2));
        const h16* vp = SV + ((size_t)(b * SALL + s)) * DA + h * 64 + (lane & 3) * 16;
        lv[0] = *(const u32x4*)vp; lv[1] = *(const u32x4*)(vp + 8);
    };
    auto writeslot = [&](int c) {
        char* sl = smem + (c & 3) * SLOT_BYTES;
#pragma unroll
        for (int m = 0; m < 10; ++m) *(u32x4*)(sl + m * 1024 + lane * 16) = lr[m];
        if (lane < 16) *(u32x4*)(sl + 10240 + lane * 16) = lr[10];
        *(u32x4*)(sl + REC_BYTES + (lane >> 2) * 128 + (lane & 3) * 32) = lv[0];
        *(u32x4*)(sl + REC_BYTES + (lane >> 2) * 128 + (lane & 3) * 32 + 16) = lv[1];
    };
    __syncthreads();
    if (wave >= 4) issue(wave - 4);
#pragma unroll 1
    for (int n = 0; n <= NCHUNK; ++n) {
        if (wave >= 4) {
            if (n < NCHUNK && (n & 3) == wave - 4) { writeslot(n); if (n + 4 < NCHUNK) issue(n + 4); }
        } else if (n >= 1) {
            const int c = n - 1;
            const char* sl = smem + (c & 3) * SLOT_BYTES;
            h16x8 a1[2], a3r[2], a4[4];
#pragma unroll
            for (int ks = 0; ks < 2; ++ks) { a1[ks] = *(const h16x8*)(sl + ks * 1024 + lane * 16); a3r[ks] = *(const h16x8*)(sl + 2048 + ks * 1024 + lane * 16); }
#pragma unroll
            for (int jt = 0; jt < 4; ++jt) a4[jt] = *(const h16x8*)(sl + 4096 + jt * 1024 + lane * 16);
            const h16x8 a3m = *(const h16x8*)(sl + 8192 + lane * 16);
            const h16x4 a2 = *(const h16x4*)(sl + 9216 + lane * 8);
            const h16x4 a1v = *(const h16x4*)(sl + 9728 + lane * 8);
            f32x4 sg[4];
#pragma unroll
            for (int jt = 0; jt < 4; ++jt) sg[jt] = *(const f32x4*)(sl + 10240 + (16 * jt + 4 * g) * 4);
            const h16* Vl = (const h16*)(sl + REC_BYTES);
            const h16x4 zh = {0, 0, 0, 0};
            const h16x8 A1V = cat8(zh, a1v);
            const bool lat = (c >= CTXL / 16);
            {
                const int it = wave;
                h16x4 vq;
#pragma unroll
                for (int e = 0; e < 4; ++e) vq[e] = Vl[(4 * g + e) * 64 + 16 * it + il];
                const h16x8 bp0 = cat8(cvt4(P[0]), cvt4(P[1])), bp1 = cat8(cvt4(P[2]), cvt4(P[3]));
                f32x4 G = mfma32(A1V, cat8(zh, vq), z4);
                G = mfma32(a1[0], bp0, G); G = mfma32(a1[1], bp1, G);
                const f32x4 U = mfma16(a2, cvt4(G), z4);
                const h16x8 buv = cat8(cvt4(U), vq);
                if (lat) {
                    f32x4 Yv = mfma32(a3r[0], bp0, z4); Yv = mfma32(a3r[1], bp1, Yv); Yv = mfma32(a3m, buv, Yv);
#pragma unroll
                    for (int e = 0; e < 4; ++e) {
                        const int s = srow_of(dir, 16 * c + 4 * g + e);
                        Y[((size_t)(b * SEQ + s - CTXL)) * DA + h * 64 + 16 * it + il] = (h16)Yv[e];
                    }
                }
#pragma unroll
                for (int jt = 0; jt < 4; ++jt) P[jt] = mfma32(a4[jt], buv, P[jt]) * sg[jt];
            }
        }
        __syncthreads();
    }
}

__device__ __forceinline__ void attn_item(const Params& p, char* smem, int item) {
    char* ws = p.ws;
    const int tid = threadIdx.x, lane = tid & 63, wave = tid >> 6;
    const int fr = lane & 15, fq = lane >> 4;
    const int pair = item >> 6, j = item & 63;
    const int b = pair >> 1, kvh = pair & 1, hq = kvh * 4 + (j >> 4), qt = j & 15;
    const h16* Qp = (const h16*)(ws + OFF_Q) + (((size_t)(b * 8 + hq) * SEQ) + qt * 128 + wave * 16) * 128;
    const h16* Kp = (const h16*)(ws + OFF_KB) + ((size_t)(b * 2 + kvh) * SALL) * 128;
    const h16* Vp = (const h16*)(ws + OFF_VT) + ((size_t)(b * 2 + kvh) * 128) * SALL;
    h16x8 qf[4];
#pragma unroll
    for (int ds = 0; ds < 4; ++ds) qf[ds] = *(const h16x8*)(Qp + (size_t)fr * 128 + 32 * ds + 8 * fq);
    const f32x4 zero4 = {0.f, 0.f, 0.f, 0.f};
    f32x4 o[8];
#pragma unroll
    for (int dt = 0; dt < 8; ++dt) o[dt] = zero4;
    float mrun = -1e30f, lrun = 0.f;
    int ksrc[2], vsrc[2];
#pragma unroll
    for (int i = 0; i < 2; ++i) {
        const int krow = 4 * (2 * wave + i) + (lane >> 4);
        ksrc[i] = krow * 128 + (((lane & 15) ^ (krow & 15)) << 3);
        const int vrow = 8 * (2 * wave + i) + (lane >> 3);
        vsrc[i] = vrow * SALL + (((lane & 7) ^ ((vrow >> 1) & 7)) << 3);
    }
    char* ldsK = smem + (2 * wave) * 1024 + lane * 16;
    char* ldsV = smem + 16384 + (2 * wave) * 1024 + lane * 16;
    const int kfo = fr * 256, vfo = fr * 128, vsw = (fr >> 1) & 7;
    const int NKT = SALL / 64;
    WAIT_V(0);
    __syncthreads();
#pragma unroll
    for (int st0 = 0; st0 < 3; ++st0) {
#pragma unroll
        for (int i = 0; i < 2; ++i) { glds16(Kp + (ksrc[i] + st0 * 64 * 128), ldsK + st0 * 32768 + i * 1024); glds16(Vp + (vsrc[i] + st0 * 64), ldsV + st0 * 32768 + i * 1024); }
    }
#define ATT_S(ST, kbuf) { \
        _Pragma("unroll") for (int k4 = 0; k4 < 4; ++k4) _Pragma("unroll") for (int ds = 0; ds < 4; ++ds) { \
            const h16x8 kf = *(const h16x8*)((kbuf) + k4 * 4096 + kfo + (((4 * ds + fq) ^ fr) << 4)); \
            ST[k4] = __builtin_amdgcn_mfma_f32_16x16x32_f16(kf, qf[ds], ds == 0 ? zero4 : ST[k4], 0, 0, 0); } }
#define ATT_SOFTMAX_PV(ST, vbuf) { \
        float mx = fmaxf(fmaxf(fmaxf(ST[0][0], ST[0][1]), fmaxf(ST[0][2], ST[0][3])), fmaxf(fmaxf(ST[1][0], ST[1][1]), fmaxf(ST[1][2], ST[1][3]))); \
        mx = fmaxf(mx, fmaxf(fmaxf(fmaxf(ST[2][0], ST[2][1]), fmaxf(ST[2][2], ST[2][3])), fmaxf(fmaxf(ST[3][0], ST[3][1]), fmaxf(ST[3][2], ST[3][3])))); \
        mx = fmaxf(mx, __shfl_xor(mx, 16)); mx = fmaxf(mx, __shfl_xor(mx, 32)); \
        const float mnew = fmaxf(mrun, mx); \
        const float alpha = __builtin_amdgcn_exp2f(mrun - mnew); \
        mrun = mnew; \
        float ps = 0.f; \
        _Pragma("unroll") for (int k4 = 0; k4 < 4; ++k4) _Pragma("unroll") for (int e = 0; e < 4; ++e) { const float pe = __builtin_amdgcn_exp2f(ST[k4][e] - mnew); ST[k4][e] = pe; ps += pe; } \
        lrun = lrun * alpha + ps; \
        _Pragma("unroll") for (int dt = 0; dt < 8; ++dt) o[dt] = o[dt] * alpha; \
        const h16x8 pf0 = cat8(cvt4(ST[0]), cvt4(ST[1])), pf1 = cat8(cvt4(ST[2]), cvt4(ST[3])); \
        _Pragma("unroll") for (int dt = 0; dt < 8; ++dt) { \
            const h16x8 v0 = *(const h16x8*)((vbuf) + dt * 2048 + vfo + (((0 + fq) ^ vsw) << 4)); \
            const h16x8 v1 = *(const h16x8*)((vbuf) + dt * 2048 + vfo + (((4 + fq) ^ vsw) << 4)); \
            o[dt] = __builtin_amdgcn_mfma_f32_16x16x32_f16(v0, pf0, o[dt], 0, 0, 0); \
            o[dt] = __builtin_amdgcn_mfma_f32_16x16x32_f16(v1, pf1, o[dt], 0, 0, 0); } }
#define ATT_STEP(kt, STC, STN) { \
        if ((kt) + 2 < NKT) { WAIT_V(4); } else { WAIT_V(0); }        \
        __builtin_amdgcn_s_barrier(); \
        if ((kt) + 3 < NKT) { const int so = (((kt) + 3) & 3) * 32768; \
            _Pragma("unroll") for (int i = 0; i < 2; ++i) { glds16(Kp + (ksrc[i] + ((kt) + 3) * 64 * 128), ldsK + so + i * 1024); glds16(Vp + (vsrc[i] + ((kt) + 3) * 64), ldsV + so + i * 1024); } } \
        if ((kt) + 1 < NKT) ATT_S(STN, smem + (((kt) + 1) & 3) * 32768) \
        ATT_SOFTMAX_PV(STC, smem + ((kt) & 3) * 32768 + 16384) }
    f32x4 stA[4], stB[4];
    WAIT_V(8);
    __builtin_amdgcn_s_barrier();
    ATT_S(stA, smem)
#pragma unroll 1
    for (int kt = 0; kt < NKT; kt += 2) {
        ATT_STEP(kt, stA, stB)
        ATT_STEP(kt + 1, stB, stA)
    }
#undef ATT_STEP
#undef ATT_SOFTMAX_PV
#undef ATT_S
    h16* YM = (h16*)(ws + OFF_YMIX);
    float l = lrun;
    l += __shfl_xor(l, 16); l += __shfl_xor(l, 32);
    const float inv = 1.0f / l;
    const int tok = qt * 128 + wave * 16 + fr;
    h16* dst = YM + ((size_t)(b * SEQ + tok)) * D + 1024 + hq * 128;
#pragma unroll
    for (int dt = 0; dt < 8; ++dt) store_h4(dst + 16 * dt + 4 * fq, o[dt] * inv);
}

__device__ __forceinline__ void phase_mix(const Params& p, char* smem, int bid, int nblk, int qoff, int probe_n) {
    unsigned* ctl = (unsigned*)(p.ws + OFF_CTL);
    volatile LAS int* sitem = (volatile LAS int*)(smem + GEMM_LDS + 16);
    for (;;) {
        __syncthreads();
        if (threadIdx.x == 0) *sitem = (int)atomicAdd(&ctl[CW_QUEUE + qoff], 1u);
        __syncthreads();
        const int item = *sitem;
        if (item >= 128) break;
        scan_item(p, smem, item);
    }
    const int x0 = (int)(xb_xcc_id() & 7u);
    for (int q = 0; q < 8; ++q) {
        const int pair = (x0 + q) & 7;
        for (;;) {
            __syncthreads();
            if (threadIdx.x == 0) *sitem = (int)atomicAdd(&ctl[CW_AQ + qoff + 16 * pair], 1u);
            __syncthreads();
            const int jj = *sitem;
            if (jj >= 64) break;
            const int item = pair * 64 + jj;
            if (PROBE_PHASE == 61) { _Pragma("unroll 1") for (int r = 0; r < probe_n; ++r) attn_item(p, smem, item); }
            else attn_item(p, smem, item);
        }
    }
}

__device__ __forceinline__ void phase_finish(const Params& p, int bid, int nblk) {
    char* ws = p.ws;
    const int lane = threadIdx.x & 63, wave = threadIdx.x >> 6;
    const h16* Y0 = (const h16*)(ws + OFF_Y0); const h16* Y1 = (const h16*)(ws + OFF_Y1);
    const h16* SR = (const h16*)(ws + OFF_SR); const h16* SV = (const h16*)(ws + OFF_SV); const h16* SG = (const h16*)(ws + OFF_SG);
    const h16* KD0 = (const h16*)(ws + OFF_SKD0); const h16* KD1 = (const h16*)(ws + OFF_SKD1);
    const h16* SKS = (const h16*)(ws + OFF_SKS); const float* k_a = p.in[17];
    h16* YM = (h16*)(ws + OFF_YMIX);
    const float* r_k = p.in[18]; const float* ln_g = p.in[19]; const float* ln_b = p.in[20];
    const int c0 = (lane >> 2) * 64 + (lane & 3) * 16;
    for (int tl = bid * NW + wave; tl < ROWSL; tl += nblk * NW) {
        const int b = tl >> 11, t = tl & 2047;
        const size_t R = (size_t)b * SALL + CTXL + t;
        float y[16], r[16], kb[16], v[16], g[16];
#pragma unroll
        for (int u = 0; u < 4; ++u) {
            const h16x4 a = *(const h16x4*)(Y0 + (size_t)tl * DA + c0 + 4 * u), bb = *(const h16x4*)(Y1 + (size_t)tl * DA + c0 + 4 * u);
            const h16x4 rr = *(const h16x4*)(SR + R * DA + c0 + 4 * u), vv = *(const h16x4*)(SV + R * DA + c0 + 4 * u), gg = *(const h16x4*)(SG + R * DA + c0 + 4 * u);
            const h16x4 k0 = *(const h16x4*)(KD0 + R * DA + c0 + 4 * u), k1 = *(const h16x4*)(KD1 + R * DA + c0 + 4 * u), ksv = *(const h16x4*)(SKS + R * DA + c0 + 4 * u);
            const f32x4 ka4 = *(const f32x4*)(k_a + c0 + 4 * u);
#pragma unroll
            for (int e = 0; e < 4; ++e) { y[4 * u + e] = (float)a[e] + (float)bb[e]; r[4 * u + e] = (float)rr[e]; v[4 * u + e] = (float)vv[e]; g[4 * u + e] = (float)gg[e]; kb[4 * u + e] = (float)ksv[e] * (2.0f + ((float)k0[e] + (float)k1[e] - 2.0f) * ka4[e]); }
        }
        float sm = 0.f, bo = 0.f;
#pragma unroll
        for (int j = 0; j < 16; ++j) { sm += y[j]; bo += r[j] * kb[j] * r_k[c0 + j]; }
        sm += __shfl_xor(sm, 1); sm += __shfl_xor(sm, 2);
        bo += __shfl_xor(bo, 1); bo += __shfl_xor(bo, 2);
        const float mu = sm * (1.0f / 64.0f);
        float vs = 0.f;
#pragma unroll
        for (int j = 0; j < 16; ++j) { const float d = y[j] - mu; vs += d * d; }
        vs += __shfl_xor(vs, 1); vs += __shfl_xor(vs, 2);
        const float rstd = rsqrtf(vs * (1.0f / 64.0f) + 64e-5f);
#pragma unroll
        for (int u = 0; u < 4; ++u) {
            f32x4 ov;
#pragma unroll
            for (int e = 0; e < 4; ++e) { const int j = 4 * u + e; const float yn = (y[j] - mu) * rstd * ln_g[c0 + j] + ln_b[c0 + j]; ov[e] = (yn + bo * v[j]) * g[j]; }
            store_h4(YM + (size_t)tl * D + c0 + 4 * u, ov);
        }
    }
}

__device__ __forceinline__ void phase_gemm_res(const Params& p, char* smem, int bid, int nblk, const h16* A, const h16* Bt, const float* base, int layer) {
    const int MT = ROWSL / 256, NTl = D / 256;
    h16* XH = (h16*)(p.ws + OFF_XH);
    auto sched = [&](int i, g8::Unit& u) {
        const int t = bid + i * nblk;
        if (t >= MT * NTl) return false;
        int tm, tn; tile_order(t, MT, NTl, tm, tn);
        u.a = A + (size_t)(tm * 256) * D; u.b = Bt + (size_t)(tn * 256) * D; u.u0 = tm; u.u1 = tn; u.u2 = 0; u.u3 = 0;
        return true;
    };
    gemm_phase8(smem, D, D, D, sched, [&](const g8::Unit& u, const f32x4 (&acc)[2][2][4][2], int wr, int wc, int fr, int fq) {
        const int tm = u.u0, tn = u.u1;
        const int b = (tm * 256) >> 11;
        const float* gt = modv(p, layer, b, 2);
        acc8_foreach(acc, wr, wc, fr, fq, [&](int r, int c, f32x4 v) {
            const size_t o = (size_t)(tm * 256 + r) * D + tn * 256 + c;
            f32x4 x;
            if (layer == 0) x = *(const f32x4*)(base + o);
            else { const h16x4 xh = *(const h16x4*)(XH + o); x = (f32x4){(float)xh[0], (float)xh[1], (float)xh[2], (float)xh[3]}; }
            const f32x4 g = *(const f32x4*)(gt + tn * 256 + c);
            store_h4(XH + o, x + g * v);
        });
    });
}

__device__ __forceinline__ void phase_route(const Params& p, char* smem, int bid, int nblk, int layer, int slot) {
    char* ws = p.ws;
    const int lane = threadIdx.x & 63, wave = threadIdx.x >> 6;
    const int fr = lane & 15, g = lane >> 4;
    h16* TOK = (h16*)(ws + OFF_H);
    unsigned* cnt = (unsigned*)(ws + OFF_CTL) + CW_CNT + slot * 1024;
    int* LIST = (int*)(ws + OFF_LIST) + (size_t)slot * 16 * 8192;
    float* GW = (float*)(ws + OFF_GW) + (size_t)slot * 16384;
    const int vb = wave >> 2, w4 = wave & 3;
    const int kq = w4 * 512 + 8 * g;
    const float* gn = p.in[7] + layer * D + kq;
    const float* rb = p.in[26];
    const h16* RWH = (const h16*)(ws + OFF_RWH) + fr * 2048 + kq;
    const h16* RWL = (const h16*)(ws + OFF_RWL) + fr * 2048 + kq;
    float* red = (float*)smem + vb * (4 * 64 * 8 + 64);
    float* ssp = red + 4 * 64 * 8;
    for (int u0 = bid * 2; u0 < ROWSL / 16; u0 += nblk * 2) {
        const int unit = u0 + vb;
        const int tl = unit * 16 + fr;
        const int b = tl >> 11;
        const h16* xr = (const h16*)(p.ws + OFF_XH) + (size_t)tl * D + kq;
        const float* sh = modv(p, layer, b, 3) + kq; const float* sc = modv(p, layer, b, 4) + kq;
        float ss = 0.f;
#pragma unroll
        for (int i = 0; i < 16; ++i) {
            const h16x8 a = *(const h16x8*)(xr + 32 * i);
#pragma unroll
            for (int e = 0; e < 8; ++e) { const float f = (float)a[e]; ss += f * f; }
        }
        ss += __shfl_xor(ss, 16); ss += __shfl_xor(ss, 32);
        __syncthreads();
        if (g == 0) ssp[w4 * 16 + fr] = ss;
        __syncthreads();
        const float tot = ssp[fr] + ssp[16 + fr] + ssp[32 + fr] + ssp[48 + fr];
        const float rstd = rsqrtf(tot * (1.0f / D) + 1e-6f);
        f32x4 am = {0.f, 0.f, 0.f, 0.f}, ac = {0.f, 0.f, 0.f, 0.f};
        h16* trow = TOK + (size_t)tl * D + kq;
        h16x8 px[3]; f32x4 pg[3][2], pc[3][2], ph[3][2]; h16x8 pwh[3], pwl[3];
#define ROUTE_LOAD(slot, it) { const int k_ = 32 * (it); px[slot] = *(const h16x8*)(xr + k_); \
            pg[slot][0] = *(const f32x4*)(gn + k_); pg[slot][1] = *(const f32x4*)(gn + k_ + 4); \
            pc[slot][0] = *(const f32x4*)(sc + k_); pc[slot][1] = *(const f32x4*)(sc + k_ + 4); ph[slot][0] = *(const f32x4*)(sh + k_); ph[slot][1] = *(const f32x4*)(sh + k_ + 4); \
            pwh[slot] = *(const h16x8*)(RWH + k_); pwl[slot] = *(const h16x8*)(RWL + k_); }
        ROUTE_LOAD(0, 0) ROUTE_LOAD(1, 1)
#pragma unroll
        for (int i = 0; i < 16; ++i) {
            if (i + 2 < 16) ROUTE_LOAD((i + 2) % 3, i + 2)
            const int cs = i % 3;
            h16x8 yh, yl;
#pragma unroll
            for (int hh = 0; hh < 2; ++hh) {
                const f32x4 xq = {(float)px[cs][4 * hh], (float)px[cs][4 * hh + 1], (float)px[cs][4 * hh + 2], (float)px[cs][4 * hh + 3]};
                const f32x4 y = (xq * rstd) * pg[cs][hh] * (pc[cs][hh] + 1.0f) + ph[cs][hh];
#pragma unroll
                for (int e = 0; e < 4; ++e) { const h16 hv = (h16)y[e]; yh[4 * hh + e] = hv; yl[4 * hh + e] = (h16)((y[e] - (float)hv) * 4096.0f); }
            }
            *(h16x8*)(trow + 32 * i) = yh;
            am = mfma32(pwh[cs], yh, am); ac = mfma32(pwl[cs], yh, ac); ac = mfma32(pwh[cs], yl, ac);
        }
#undef ROUTE_LOAD
        *(f32x4*)(red + (w4 * 64 + lane) * 8) = am; *(f32x4*)(red + (w4 * 64 + lane) * 8 + 4) = ac;
        __syncthreads();
        if (w4 == 0) {
            f32x4 sm = {0.f, 0.f, 0.f, 0.f}, scn = {0.f, 0.f, 0.f, 0.f};
#pragma unroll
            for (int w = 0; w < 4; ++w) { sm += *(const f32x4*)(red + (w * 64 + lane) * 8); scn += *(const f32x4*)(red + (w * 64 + lane) * 8 + 4); }
            float sv[4], sel[4];
#pragma unroll
            for (int e = 0; e < 4; ++e) { sv[e] = sigmoidf_(sm[e] + scn[e] * (1.0f / 4096.0f)); sel[e] = sv[e] + rb[4 * g + e]; }
            float m1 = -1e30f, m2 = -1e30f;
#pragma unroll
            for (int e = 0; e < 4; ++e) { const float v = sel[e]; if (v > m1) { m2 = m1; m1 = v; } else if (v > m2) m2 = v; }
            float bs = m1 + m2; int bg = g;
#pragma unroll
            for (int o = 16; o <= 32; o <<= 1) {
                const float os = __shfl_xor(bs, o); const int og = __shfl_xor(bg, o);
                if (os > bs || (os == bs && og < bg)) { bs = os; bg = og; }
            }
            int e0 = -1, e1 = -1; float w0 = 0.f, w1 = 0.f;
            if (bg == g) {
                int i0 = 0, i1 = 0; float v0 = -1e30f, v1 = -1e30f, s0 = 0.f, s1 = 0.f;
#pragma unroll
                for (int e = 0; e < 4; ++e) { if (sel[e] > v0) { v0 = sel[e]; i0 = e; s0 = sv[e]; } }
#pragma unroll
                for (int e = 0; e < 4; ++e) { if (e != i0 && sel[e] > v1) { v1 = sel[e]; i1 = e; s1 = sv[e]; } }
                const float inv = 1.0f / (s0 + s1);
                e0 = 4 * g + i0; e1 = 4 * g + i1; w0 = s0 * inv; w1 = s1 * inv;
            }
            const unsigned long long lt = (1ull << lane) - 1ull;
            int mycount = 0, rank0 = 0, rank1 = 0;
#pragma unroll
            for (int e = 0; e < 16; ++e) {
                const unsigned long long m0 = __ballot(e0 == e), m1 = __ballot(e1 == e);
                const int c0 = __popcll(m0), c1 = __popcll(m1);
                if (lane == e) mycount = c0 + c1;
                if (e0 == e) rank0 = __popcll(m0 & lt);
                if (e1 == e) rank1 = c0 + __popcll(m1 & lt);
            }
            unsigned base = 0;
            if (lane < 16 && mycount > 0) base = atomicAdd(&cnt[lane * 64], (unsigned)mycount);
            const unsigned b0 = __shfl(base, e0 < 0 ? 0 : e0), b1 = __shfl(base, e1 < 0 ? 0 : e1);
            if (e0 >= 0) {
                LIST[e0 * 8192 + b0 + rank0] = tl * 2;
                GW[tl * 2] = w0;
                LIST[e1 * 8192 + b1 + rank1] = tl * 2 + 1;
                GW[tl * 2 + 1] = w1;
            }
        }
    }
    __syncthreads();
}

__device__ __forceinline__ void phase_moe(const Params& p, char* smem, int layer, int dslot) {
    char* ws = p.ws;
    const int tid = threadIdx.x;
    unsigned* ctl = (unsigned*)(ws + OFF_CTL);
    const unsigned* cntp = ctl + CW_CNT + layer * 1024;
    unsigned* queue = ctl + CW_MQ + layer * 64;
    unsigned* dep = ctl + CW_DEP + dslot * 256;
    const int* LIST = (const int*)(ws + OFF_LIST) + (size_t)layer * 16 * 8192;
    const float* GW = (const float*)(ws + OFF_GW) + (size_t)layer * 16384;
    const h16* TOK = (const h16*)(ws + OFF_H);
    h16* U = (h16*)(ws + OFF_U);
    h16* SLOT = (h16*)(ws + OFF_SLOT);
    volatile LAS int* sitem = (volatile LAS int*)(smem + GEMM_LDS + 16);
    int MT = 0;
    int cn[16];
#pragma unroll
    for (int e = 0; e < 16; ++e) cn[e] = __builtin_amdgcn_readfirstlane((int)cntp[e * 64]);
#pragma unroll
    for (int e = 0; e < 16; ++e) MT += (cn[e] + 255) >> 8;
    const int n1 = MT * 4, n2 = MT * 8;
    (void)queue; (void)sitem;
    const int G = (int)gridDim.x, bidx = (int)blockIdx.x;
    const int r1 = (n1 > G) ? (n1 % G) : 0;
    const int nlight = G - r1;
    const int my2 = (bidx >= r1) ? (n2 - (bidx - r1) + nlight - 1) / nlight : 0;
    auto locate = [&](int m, int& e, int& tm, int& off, int& c) {
        int mb = 0; e = 0; off = 0; c = 0;
        bool found = false;
#pragma unroll
        for (int ee = 0; ee < 16; ++ee) {
            const int cc = cn[ee]; const int mt = (cc + 255) >> 8;
            if (!found) { if (m >= mb + mt) { mb += mt; off += cc; } else { e = ee; c = cc; found = true; } }
        }
        tm = m - mb;
    };
    {
        auto sched = [&](int i, g8::Unit& u) {
            const int item = bidx + i * G;
            if (item >= n1) return false;
            const int m = item >> 2, tn = item & 3;
            int e, tm, off, c; locate(m, e, tm, off, c);
            u.a = nullptr; u.b = (const h16*)(ws + OFF_EXP + layer * EXP_L) + ((size_t)e * 1024 + tn * 256) * 2048;
            u.u0 = e; u.u1 = tm; u.u2 = tn | (m << 8); u.u3 = off; u.u4 = c;
            return true;
        };
        auto rowoff = [&](const g8::Unit& u, int r) {
            const int c = u.u4;
            int idx = u.u1 * 256 + r; idx = idx < c ? idx : c - 1;
            return (unsigned)(LIST[u.u0 * 8192 + idx] >> 1) * (unsigned)(D * 2);
        };
        gemm_phase8g(smem, TOK, 2048, D, sched, rowoff, [&](const g8::Unit& u, const f32x4 (&acc)[2][2][4][2], int wr, int wc, int fr, int fq) {
            const int e = u.u0, tm = u.u1, tn = u.u2 & 255, m = u.u2 >> 8, off = u.u3;
            const int c = u.u4;
#pragma unroll
            for (int ai = 0; ai < 2; ++ai)
#pragma unroll
                for (int mm = 0; mm < 4; ++mm) {
                    const int idx = tm * 256 + 128 * ai + 64 * wr + 16 * mm + fr;
                    if (idx < c) {
#pragma unroll
                        for (int bj = 0; bj < 2; ++bj) {
                            const f32x4 g = acc[ai][bj][mm][0], up = acc[ai][bj][mm][1];
                            f32x4 o;
#pragma unroll
                            for (int q = 0; q < 4; ++q) o[q] = fsilu_(g[q]) * up[q];
                            const int col = 16 * (8 * tn + 4 * bj + wc) + 4 * fq;
                            const h16x4 oh = cvt4(o);
                            __hip_atomic_store((unsigned long long*)(U + (size_t)(off + idx) * DEXP + col), __builtin_bit_cast(unsigned long long, oh), __ATOMIC_RELAXED, __HIP_MEMORY_SCOPE_AGENT);
                        }
                    }
                }
            asm volatile("s_waitcnt vmcnt(0)" ::: "memory");
            if ((threadIdx.x & 63) == 0) __hip_atomic_fetch_add(&dep[m], 1u, __ATOMIC_RELAXED, __HIP_MEMORY_SCOPE_AGENT);
        });
    }
    for (int it = 0; it < my2; ++it) {
        const int item = n1 + (bidx - r1) + it * nlight;
        const int m = (item - n1) >> 3;
        const int tn = (item - n1) & 7;
        int e, tm, off, c; locate(m, e, tm, off, c);
        const int* lst = LIST + e * 8192;
        f32x4 acc[8][4];
        {
            if (tid == 0) {
                unsigned sp = 0;
                while (__hip_atomic_load(&dep[m], __ATOMIC_RELAXED, __HIP_MEMORY_SCOPE_AGENT) < 32u) {
                    __builtin_amdgcn_s_sleep(2);
                    if (++sp > (1u << 24)) { atomicAdd(&ctl[CW_TMO], 1u); break; }
                }
                __builtin_amdgcn_fence(__ATOMIC_ACQUIRE, "agent");
                asm volatile("s_waitcnt vmcnt(0)" ::: "memory");
            }
            __syncthreads();
            const h16* Bt = (const h16*)(ws + OFF_EXP + layer * EXP_L + EGU_BYTES) + ((size_t)e * 2048 + tn * 256) * 512;
            gemm_tile(smem, [&](int r) { int idx = tm * 256 + r; idx = idx < c ? idx : c - 1; return U + (size_t)(off + idx) * DEXP; },
                      [&](int n) { return Bt + (size_t)n * 512; }, DEXP, acc);
            acc_foreach(acc, [&](int r, int cc, f32x4 v) {
                const int idx = tm * 256 + r;
                if (idx < c) {
                    const int entry = lst[idx];
                    const float gw = GW[entry];
                    store_h4(SLOT + (size_t)entry * D + tn * 256 + cc, v * gw);
                }
            });
        }
    }
}

template <bool FINAL>
__device__ __forceinline__ float combine_row(const Params& p, int layer, int tl, f32x4 (&x)[8]) {
    const int lane = threadIdx.x & 63;
    const h16* SLOT = (const h16*)(p.ws + OFF_SLOT);
    const int b = tl >> 11;
    h16* xr = (h16*)(p.ws + OFF_XH) + (size_t)tl * D;
    float* outr = p.out + (size_t)tl * D;
    const float* gt2 = modv(p, layer, b, 5);
    float ss = 0.f;
#pragma unroll
    for (int i = 0; i < 8; ++i) {
        const int k = i * 256 + lane * 4;
        const h16x4 xh = *(const h16x4*)(xr + k);
        const f32x4 xv = {(float)xh[0], (float)xh[1], (float)xh[2], (float)xh[3]}, g = *(const f32x4*)(gt2 + k);
        const h16x4 s0 = *(const h16x4*)(SLOT + (size_t)(2 * tl) * D + k), s1 = *(const h16x4*)(SLOT + (size_t)(2 * tl + 1) * D + k);
        f32x4 f;
#pragma unroll
        for (int e = 0; e < 4; ++e) f[e] = (float)s0[e] + (float)s1[e];
        x[i] = xv + g * f;
        if (FINAL) *(f32x4*)(outr + k) = x[i]; else store_h4(xr + k, x[i]);
        ss += x[i][0] * x[i][0] + x[i][1] * x[i][1] + x[i][2] * x[i][2] + x[i][3] * x[i][3];
    }
    return wave_sum(ss);
}
__device__ __forceinline__ void phase_combine_final(const Params& p, int bid, int nblk, int layer) {
    const int wave = threadIdx.x >> 6;
    for (int tl = bid * NW + wave; tl < ROWSL; tl += nblk * NW) { f32x4 x[8]; (void)combine_row<true>(p, layer, tl, x); }
}
__device__ __forceinline__ void phase_combine_fold(const Params& p, int bid, int nblk) {
    char* ws = p.ws;
    const int lane = threadIdx.x & 63, wave = threadIdx.x >> 6;
    h16* HF = (h16*)(ws + OFF_H);
    float* HNY = (float*)(ws + OFF_HNY);
    const float* gn = p.in[6] + D;
    for (int u = bid * NW + wave; u < NB * 1025; u += nblk * NW) {
        const int b = u / 1025, t = u - b * 1025;
        const float* sh = modv(p, 1, b, 0); const float* sc = modv(p, 1, b, 1);
        f32x4 xa[8];
        const float ssa = combine_row<false>(p, 0, b * SEQ + t, xa);
        const float ra = rsqrtf(ssa * (1.0f / D) + 1e-6f);
        const bool paired = (t >= 1 && t <= 1023);
        f32x4 xb[8]; float rb2 = 0.f;
        if (paired) { const float ssb = combine_row<false>(p, 0, b * SEQ + (SEQ - t), xb); rb2 = rsqrtf(ssb * (1.0f / D) + 1e-6f); }
#pragma unroll
        for (int i = 0; i < 8; ++i) {
            const int k = i * 256 + lane * 4;
            const f32x4 g = *(const f32x4*)(gn + k), c1 = *(const f32x4*)(sc + k), h1 = *(const f32x4*)(sh + k);
            const f32x4 ha = (xa[i] * ra) * g * (c1 + 1.0f) + h1;
            if (paired) {
                const f32x4 hb = (xb[i] * rb2) * g * (c1 + 1.0f) + h1;
                store_h4(HF + (size_t)(b * SEQ + t) * D + k, ha + hb);
                store_h4(HF + (size_t)(b * SEQ + 1024 + t) * D + k, ha - hb);
            } else if (t == 0) {
                store_h4(HF + (size_t)(b * SEQ) * D + k, ha);
                store_h4(HF + (size_t)(b * SEQ + 1024) * D + k, (f32x4){0.f, 0.f, 0.f, 0.f});
            } else {
                *(f32x4*)(HNY + (size_t)b * D + k) = ha;
            }
        }
    }
}

__device__ __forceinline__ void phase_dft_c(const Params& p, char* smem, int bid, int nblk) {
    char* ws = p.ws;
    const h16* DC = (const h16*)(ws + OFF_DC);
    const h16* HF = (const h16*)(ws + OFF_H);
    h16* ZT = (h16*)(ws + OFF_ZT);
    {
        const float* HNY = (const float*)(ws + OFF_HNY);
        float* VNY = (float*)(ws + OFF_VNY);
        for (int i = bid * NT + threadIdx.x; i < NB * D; i += nblk * NT) {
            const int b = i >> 11, gg = (i >> 8) & 7, n = i & 255;
            const float* hr = HNY + (size_t)b * D + gg * 256;
            const h16* dr = DC + (size_t)n * 256;
            float a = 0.f;
#pragma unroll 8
            for (int c = 0; c < 256; ++c) a += hr[c] * (float)dr[c];
            VNY[i] = a * 0.022097086912079608f;
        }
    }
    {
        auto sched = [&](int i, g8::Unit& u) {
            const int t = bid + i * nblk;
            if (t >= 32 * 8) return false;
            const int bg = t >> 3, tn = t & 7;
            const int b = bg >> 3, g = bg & 7;
            u.a = DC + (size_t)((tn < 4) ? 0 : 256) * 256; u.b = HF + (size_t)(b * SEQ + tn * 256) * D + g * 256; u.u0 = b; u.u1 = g; u.u2 = tn; u.u3 = 0;
            return true;
        };
        gemm_phase8(smem, 256, D, 256, sched, [&](const g8::Unit& u, const f32x4 (&acc)[2][2][4][2], int wr, int wc, int fr, int fq) {
            const int b = u.u0, g = u.u1, tn = u.u2;
            acc8_foreach(acc, wr, wc, fr, fq, [&](int r, int c, f32x4 v) { store_h4(ZT + ((size_t)(b * 2048 + g * 256 + r)) * 2048 + tn * 256 + c, v); });
        });
    }
}
__device__ __forceinline__ void phase_dft_t(const Params& p, char* smem, int bid, int nblk) {
    char* ws = p.ws;
    const h16* DT = (const h16*)(ws + OFF_DT);
    const h16* ZT = (const h16*)(ws + OFF_ZT);
    const float* VNY = (const float*)(ws + OFF_VNY);
    h16* FB = (h16*)(ws + OFF_YMIX);
    auto sched = [&](int i, g8::Unit& u) {
        const int t = bid + i * nblk;
        if (t >= 4 * 64) return false;
        const int b = t >> 6, r8 = t & 63;
        int tm, tn; tile_order(r8, 8, 8, tm, tn);
        u.a = DT + (size_t)(tm * 256) * 2048; u.b = ZT + ((size_t)(b * 2048 + tn * 256)) * 2048; u.u0 = b; u.u1 = tm; u.u2 = tn; u.u3 = 0;
        return true;
    };
    gemm_phase8(smem, 2048, 2048, 2048, sched, [&](const g8::Unit& u, const f32x4 (&acc)[2][2][4][2], int wr, int wc, int fr, int fq) {
        const int b = u.u0, tm = u.u1, tn = u.u2;
        acc8_foreach(acc, wr, wc, fr, fq, [&](int r, int c, f32x4 v) {
            const f32x4 ny = *(const f32x4*)(VNY + (size_t)b * D + tn * 256 + c);
            const float sg = (r & 1) ? -1.0f : 1.0f;
            store_h4(FB + (size_t)(b * SEQ + tm * 256 + r) * D + tn * 256 + c, v + ny * sg);
        });
    });
}

__global__ void __launch_bounds__(NT, 2) mk_forward(Params p, int ph_lo, int ph_hi, int probe_k, int probe_n) {
    __shared__ __attribute__((aligned(16))) char smem[GEMM_LDS + 64];
    const int bid = blockIdx.x, nblk = gridDim.x;
    volatile LAS unsigned* bst = (volatile LAS unsigned*)(smem + GEMM_LDS);
    XcdBarrier xb;
    const bool need_bar = (ph_hi - ph_lo) > 1;
    if (need_bar) {
        if (threadIdx.x == 0) { bst[0] = 0u; bst[1] = 0u; }
        __syncthreads();
        xb = xcd_barrier_post((unsigned*)(p.ws + OFF_CTL), bst);
    }
#define PHASE(k, call) if (ph_lo <= (k) && (k) < ph_hi) { \
        if ((k) == PROBE_PHASE) { _Pragma("unroll 1") for (int rep = 0; rep < probe_n; ++rep) { call; if (rep + 1 < probe_n) xcd_barrier(xb); } } \
        else { const int rep = 0; (void)rep; call; } \
        if ((k) + 1 < ph_hi) xcd_barrier(xb); }
    PHASE(0, phase_prologue(p, smem, bid, nblk))
    PHASE(1, phase_norm0(p, bid, nblk))
    PHASE(2, phase_gemm_in(p, smem, bid, nblk))
    PHASE(3, phase_prep(p, bid, nblk))
    PHASE(4, phase_lora(p, smem, bid, nblk))
    PHASE(5, phase_chunkprep(p, smem, bid, nblk))
    PHASE(6, phase_mix(p, smem, bid, nblk, rep * 128, probe_n))
    PHASE(7, { phase_finish(p, bid, nblk); phase_conv_experts(p, smem, bid, nblk, 1); })
    PHASE(8, phase_gemm_res(p, smem, bid, nblk, (const h16*)(p.ws + OFF_YMIX), (const h16*)(p.ws + OFF_WOUT), p.in[0], 0))
    PHASE(9, phase_route(p, smem, bid, nblk, 0, 0 + 2 * rep))
    PHASE(10, phase_moe(p, smem, 0, 0 + 2 * rep))
    PHASE(11, phase_combine_fold(p, bid, nblk))
    PHASE(12, phase_dft_c(p, smem, bid, nblk))
    PHASE(13, phase_dft_t(p, smem, bid, nblk))
    PHASE(14, phase_gemm_res(p, smem, bid, nblk, (const h16*)(p.ws + OFF_YMIX), (const h16*)(p.ws + OFF_FW), p.out, 1))
    PHASE(15, phase_route(p, smem, bid, nblk, 1, 1 + 2 * rep))
    PHASE(16, phase_moe(p, smem, 1, 1 + 2 * rep))
    PHASE(17, phase_combine_final(p, bid, nblk, 1))
#undef PHASE
}

extern "C" void kernel_launch(void* const* d_in, const int* in_sizes, int n_in, void* d_out, int out_size, void* d_ws, size_t ws_size, hipStream_t stream) {
    static int grid = 0;
    if (grid == 0) {
        if (n_in != 30 || ws_size < WS_END) { fprintf(stderr, "kernel_launch: need 30 inputs and %zu bytes of workspace (got %d, %zu)\n", (size_t)WS_END, n_in, ws_size); grid = -1; return; }
        int dev = 0, cus = 0, per_cu = 0;
        hipGetDevice(&dev);
        hipDeviceGetAttribute(&cus, hipDeviceAttributeMultiprocessorCount, dev);
        hipOccupancyMaxActiveBlocksPerMultiprocessor(&per_cu, (const void*)mk_forward, NT, 0);
        if (per_cu < 1) { fprintf(stderr, "kernel_launch: occupancy query returned %d\n", per_cu); grid = -1; return; }
        if (per_cu > 1) per_cu = 1;
        grid = cus * per_cu;
    }
    if (grid < 0) return;
    hipMemsetAsync((char*)d_ws + OFF_CTL, 0, CTL_BYTES, stream);
    Params p{};
    for (int i = 0; i < 30; ++i) p.in[i] = (const float*)d_in[i];
    p.out = (float*)d_out; p.ws = (char*)d_ws;
#if MULTI_LAUNCH
    for (int ph = 0; ph < NPHASE; ++ph) hipLaunchKernelGGL(mk_forward, dim3(grid), dim3(NT), 0, stream, p, ph, ph + 1, -1, 1);
#else
    int lo = 0, hi = NPHASE, pk = PROBE_PHASE, pn = 2;
    void* args[] = {&p, &lo, &hi, &pk, &pn};
    hipError_t e = hipLaunchCooperativeKernel((const void*)mk_forward, dim3(grid), dim3(NT), args, 0, stream);
    if (e != hipSuccess) fprintf(stderr, "cooperative launch failed: %s (grid %d)\n", hipGetErrorString(e), grid);
#endif
}
```

```cpp
#include <hip/hip_runtime.h>
#include <cstdio>
#include <cstdint>

#ifndef PROBE_PHASE
#define PROBE_PHASE -1
#endif
#ifndef MULTI_LAUNCH
#define MULTI_LAUNCH 0
#endif

typedef _Float16 h16;
typedef _Float16 h16x2 __attribute__((ext_vector_type(2)));
typedef _Float16 h16x4 __attribute__((ext_vector_type(4)));
typedef _Float16 h16x8 __attribute__((ext_vector_type(8)));
typedef float f32x4 __attribute__((ext_vector_type(4)));
typedef unsigned u32x4 __attribute__((ext_vector_type(4)));
#define LAS __attribute__((address_space(3)))

constexpr int D = 2048, NB = 4, SEQ = 2048, CTXL = 256, SALL = SEQ + CTXL;
constexpr int ROWS0 = NB * SALL;
constexpr int ROWSL = NB * SEQ;
constexpr int DA = 1024, HA = 16;
constexpr int A_COLS = 3328, IN_COLS = 4864;
constexpr int NEXP = 16, DEXP = 512;
constexpr int NT = 512;
constexpr int NW = NT / 64;
constexpr int NPHASE = 18;

constexpr size_t OFF_CTL   = 0;
constexpr size_t CTL_BYTES = 65536;
constexpr size_t OFF_MODP  = OFF_CTL + CTL_BYTES;
constexpr size_t OFF_MOD   = OFF_MODP + (size_t)16 * 2 * 5 * 12288 * 4;
constexpr size_t OFF_ROPE  = OFF_MOD + (size_t)2 * 5 * 12288 * 4;
constexpr size_t OFF_WIN   = OFF_ROPE + (size_t)2048 * 64 * 2 * 4;
constexpr size_t OFF_WOUT  = OFF_WIN + (size_t)IN_COLS * D * 2;
constexpr size_t OFF_FW    = OFF_WOUT + (size_t)D * D * 2;
constexpr size_t OFF_W2T   = OFF_FW + (size_t)D * D * 2;
constexpr size_t OFF_A2T   = OFF_W2T + (size_t)2048 * 64 * 2;
constexpr size_t OFF_G2T   = OFF_A2T + (size_t)2048 * 64 * 2;
constexpr size_t OFF_EXP   = OFF_G2T + (size_t)1024 * 128 * 2;
constexpr size_t EGU_BYTES = (size_t)16 * 1024 * 2048 * 2;
constexpr size_t ED_BYTES  = (size_t)16 * 2048 * 512 * 2;
constexpr size_t EXP_L     = EGU_BYTES + ED_BYTES;
constexpr size_t OFF_DT    = OFF_EXP + 2 * EXP_L;
constexpr size_t OFF_DC    = OFF_DT + (size_t)2048 * 4096 * 2;
constexpr size_t OFF_RWH   = OFF_DC + (size_t)512 * 256 * 2;
constexpr size_t OFF_RWL   = OFF_RWH + (size_t)16 * 2048 * 2;
constexpr size_t OFF_H     = OFF_RWL + (size_t)16 * 2048 * 2;
constexpr size_t OFF_P     = OFF_H + (size_t)ROWS0 * D * 2;
constexpr size_t P_BYTES   = (size_t)ROWS0 * IN_COLS * 2;
constexpr size_t OFF_SLOT  = OFF_P;
constexpr size_t OFF_U     = OFF_P + (size_t)16384 * 2048 * 2;
constexpr size_t OFF_STR   = OFF_P + P_BYTES;
constexpr size_t STR16     = (size_t)ROWS0 * DA * 2;
constexpr size_t STR32     = (size_t)ROWS0 * DA * 4;
constexpr size_t OFF_SR    = OFF_STR;
constexpr size_t OFF_SV    = OFF_SR + STR16;
constexpr size_t OFF_SKS   = OFF_SV + STR16;
constexpr size_t OFF_SKK   = OFF_SKS + STR16;
constexpr size_t OFF_SG    = OFF_SKK + STR16;
constexpr size_t OFF_SKD0  = OFF_SG + STR16;
constexpr size_t OFF_SKD1  = OFF_SKD0 + STR16;
constexpr size_t OFF_SB0   = OFF_SKD1 + STR16;
constexpr size_t OFF_SB1   = OFF_SB0 + STR16;
constexpr size_t OFF_SW0   = OFF_SB1 + STR16;
constexpr size_t OFF_SW1   = OFF_SW0 + STR32;
constexpr size_t STR_END   = OFF_SW1 + STR32;
constexpr size_t OFF_Y0    = OFF_SW0;
constexpr size_t OFF_Y1    = OFF_SW0 + (size_t)ROWSL * DA * 4;
static_assert(OFF_Y1 + (size_t)ROWSL * DA * 4 <= STR_END, "y must fit in the decay streams");
constexpr int NCHUNK = SALL / 16;
constexpr int REC_BYTES = 10496;
constexpr size_t FRAG_DIR_BYTES = (size_t)64 * NCHUNK * REC_BYTES;
constexpr size_t OFF_FRAG0 = OFF_H;
constexpr size_t OFF_FRAG1 = OFF_EXP + EXP_L;
static_assert(OFF_FRAG0 + FRAG_DIR_BYTES <= OFF_STR, "frag0 must fit in h|p");
static_assert(FRAG_DIR_BYTES <= EXP_L, "frag1 must fit in the layer-1 expert region");
constexpr size_t OFF_ZT    = OFF_STR;
constexpr size_t OFF_F     = STR_END;
constexpr size_t OFF_Q     = OFF_F + (size_t)ROWS0 * 256 * 2;
constexpr size_t OFF_KB    = OFF_Q + (size_t)NB * 8 * SEQ * 128 * 2;
constexpr size_t OFF_VT    = OFF_KB + (size_t)NB * 2 * SALL * 128 * 2;
constexpr size_t OFF_YMIX  = OFF_VT + (size_t)NB * 2 * 128 * SALL * 2;
constexpr size_t OFF_LIST  = OFF_YMIX + (size_t)ROWSL * D * 2;
constexpr int NLIST = (PROBE_PHASE == 9 || PROBE_PHASE == 15) ? 4 : 2;
constexpr size_t OFF_GW    = OFF_LIST + (size_t)NLIST * 16 * 8192 * 4;
constexpr size_t OFF_HNY   = OFF_GW + (size_t)NLIST * 16384 * 4;
constexpr size_t OFF_VNY   = OFF_HNY + (size_t)NB * D * 4;
constexpr size_t OFF_XH    = OFF_VNY + (size_t)NB * D * 4;
constexpr size_t OFF_VB    = OFF_XH + (size_t)ROWSL * D * 2;
constexpr size_t WS_END    = OFF_VB + (size_t)NB * 2 * SALL * 128 * 2;
static_assert(WS_END <= (size_t)754818112, "workspace budget (sum of the inputs)");
static_assert(OFF_U + (size_t)16384 * 512 * 2 <= OFF_P + P_BYTES, "slot+u must fit in p");
static_assert((size_t)NB * 2048 * 2048 * 2 <= STR_END - OFF_STR, "zt must fit in streams");

constexpr int CW_QUEUE = 4000;
constexpr int CW_AQ    = 10000;
constexpr int CW_MQ    = 8192;
constexpr int CW_DEP   = 8448;
constexpr int CW_TMO   = 9600;
constexpr int CW_CNT   = 4096;

struct Params { const float* in[30]; float* out; char* ws; };

__device__ __forceinline__ float row16_sum(float v) {
    v += __int_as_float(__builtin_amdgcn_update_dpp(0, __float_as_int(v), 0xB1, 0xF, 0xF, true));
    v += __int_as_float(__builtin_amdgcn_update_dpp(0, __float_as_int(v), 0x4E, 0xF, 0xF, true));
    v += __int_as_float(__builtin_amdgcn_update_dpp(0, __float_as_int(v), 0x124, 0xF, 0xF, true));
    v += __int_as_float(__builtin_amdgcn_update_dpp(0, __float_as_int(v), 0x128, 0xF, 0xF, true));
    return v;
}
__device__ __forceinline__ float wave_sum(float v) {
    v = row16_sum(v);
    const int i = __float_as_int(v);
    return (__int_as_float(__builtin_amdgcn_readlane(i, 0)) + __int_as_float(__builtin_amdgcn_readlane(i, 16))) +
           (__int_as_float(__builtin_amdgcn_readlane(i, 32)) + __int_as_float(__builtin_amdgcn_readlane(i, 48)));
}
__device__ __forceinline__ float sigmoidf_(float x) { return 1.0f / (1.0f + expf(-x)); }
__device__ __forceinline__ float siluf_(float x) { return x / (1.0f + expf(-x)); }
__device__ __forceinline__ float fexp_(float x) { return __builtin_amdgcn_exp2f(x * 1.4426950408889634f); }
__device__ __forceinline__ float fsigmoid_(float x) { return __builtin_amdgcn_rcpf(1.0f + fexp_(-x)); }
__device__ __forceinline__ float fsilu_(float x) { return x * fsigmoid_(x); }
__device__ __forceinline__ float ftanh_(float x) { return 1.0f - 2.0f * __builtin_amdgcn_rcpf(1.0f + fexp_(2.0f * x)); }
__device__ __forceinline__ float dpp_xor1(float x) { return __int_as_float(__builtin_amdgcn_update_dpp(0, __float_as_int(x), 0xB1, 0xF, 0xF, true)); }
__device__ __forceinline__ float dpp_xor2(float x) { return __int_as_float(__builtin_amdgcn_update_dpp(0, __float_as_int(x), 0x4E, 0xF, 0xF, true)); }
__device__ __forceinline__ unsigned pack_h2(float lo, float hi) { h16x2 v = {(h16)lo, (h16)hi}; return __builtin_bit_cast(unsigned, v); }

__device__ __forceinline__ f32x4 mfma32(h16x8 a, h16x8 b, f32x4 c) { return __builtin_amdgcn_mfma_f32_16x16x32_f16(a, b, c, 0, 0, 0); }
__device__ __forceinline__ f32x4 mfma16(h16x4 a, h16x4 b, f32x4 c) { return __builtin_amdgcn_mfma_f32_16x16x16f16(a, b, c, 0, 0, 0); }
__device__ __forceinline__ h16x4 cvt4(f32x4 v) { h16x4 o = {(h16)v[0], (h16)v[1], (h16)v[2], (h16)v[3]}; return o; }
__device__ __forceinline__ h16x8 cat8(h16x4 lo, h16x4 hi) { h16x8 o = {lo[0], lo[1], lo[2], lo[3], hi[0], hi[1], hi[2], hi[3]}; return o; }

#define XB_TMO      128
#define XB_XCNT(j)  (256  + 64 * (j))
#define XB_XSUB(j)  (1280 + 64 * (j))
#define XB_XGEN(j)  (2304 + 64 * (j))
#define XB_TOP      3328
#define XB_TOPGEN   3392
#define XCD_BAR_WORDS 3456
#define XB_SPIN_CAP (1u << 27)
__device__ __forceinline__ unsigned xb_ld(unsigned* p)              { return __hip_atomic_load(p, __ATOMIC_RELAXED, __HIP_MEMORY_SCOPE_AGENT); }
__device__ __forceinline__ unsigned xb_add(unsigned* p, unsigned v) { return __hip_atomic_fetch_add(p, v, __ATOMIC_RELAXED, __HIP_MEMORY_SCOPE_AGENT); }
__device__ __forceinline__ unsigned xb_xcc_id() { return (unsigned)__builtin_amdgcn_s_getreg((3 << 11) | 20) & 0xFu; }
#define XB_SPIN(cond, bar) do { unsigned _sp = 0; while (cond) { __builtin_amdgcn_s_sleep(1); \
    if ((++_sp & 255u) == 0u) { if (xb_ld(&(bar)[XB_TMO])) break; if (_sp > XB_SPIN_CAP) { atomicAdd(&(bar)[XB_TMO], 1u); break; } } } } while (0)
struct XcdBarrier { unsigned* bar; unsigned x; volatile LAS unsigned* st; };
__device__ __forceinline__ XcdBarrier xcd_barrier_post(unsigned* bar, volatile LAS unsigned* st) {
    XcdBarrier b; b.bar = bar; b.x = xb_xcc_id(); b.st = st;
    if (threadIdx.x == 0) (void)xb_add(&bar[XB_XCNT(b.x)], 1u);
    return b;
}
__device__ __forceinline__ void xcd_barrier_complete(unsigned* bar, unsigned x, unsigned& nloc, unsigned& nx) {
    const unsigned G = gridDim.x * gridDim.y * gridDim.z;
    unsigned sum, cnt, mine, sp = 0u;
    for (;;) {
        sum = 0u; cnt = 0u; mine = 0u;
#pragma unroll
        for (unsigned j = 0; j < 16; ++j) { const unsigned c = xb_ld(&bar[XB_XCNT(j)]); sum += c; cnt += (c > 0u) ? 1u : 0u; mine = (j == x) ? c : mine; }
        if (sum == G) break;
        __builtin_amdgcn_s_sleep(1);
        if ((++sp & 255u) == 0u) { if (xb_ld(&bar[XB_TMO])) break; if (sp > XB_SPIN_CAP) { atomicAdd(&bar[XB_TMO], 1u); break; } }
    }
    nloc = mine > 0u ? mine : 1u; nx = cnt > 0u ? cnt : 1u;
}
__device__ __forceinline__ void xcd_barrier(const XcdBarrier& b) {
    asm volatile("s_waitcnt vmcnt(0)" ::: "memory");
    __syncthreads();
    if (threadIdx.x == 0) {
        unsigned* bar = b.bar;
        __builtin_amdgcn_s_waitcnt(0);
        unsigned nloc = b.st[0], nx = b.st[1];
        if (nloc == 0u) { xcd_barrier_complete(bar, b.x, nloc, nx); b.st[0] = nloc; b.st[1] = nx; }
        const unsigned old = xb_add(&bar[XB_XSUB(b.x)], 1u);
        const unsigned gen = old / nloc;
        if (old + 1u == (gen + 1u) * nloc) {
            __builtin_amdgcn_fence(__ATOMIC_RELEASE, "agent");
            asm volatile("s_waitcnt vmcnt(0)" ::: "memory");
            const unsigned og = xb_add(&bar[XB_TOP], 1u);
            const unsigned tg = og / nx;
            if (og + 1u == (tg + 1u) * nx) xb_add(&bar[XB_TOPGEN], 1u);
            else XB_SPIN(xb_ld(&bar[XB_TOPGEN]) == tg, bar);
            __builtin_amdgcn_fence(__ATOMIC_ACQUIRE, "agent");
            xb_add(&bar[XB_XGEN(b.x)], 1u);
            asm volatile("s_waitcnt vmcnt(0)" ::: "memory");
        } else {
            XB_SPIN(xb_ld(&bar[XB_XGEN(b.x)]) == gen, bar);
            __builtin_amdgcn_fence(__ATOMIC_ACQUIRE, "agent");
            asm volatile("s_waitcnt vmcnt(0)" ::: "memory");
        }
    }
    __syncthreads();
}

constexpr int GEMM_STAGE = (256 + 256) * 32 * 2;
constexpr int GEMM_LDS = 4 * GEMM_STAGE;
#define WAIT_V(n) asm volatile("s_waitcnt vmcnt(" #n ")" ::: "memory")
__device__ __forceinline__ void glds16(const h16* g, char* l) {
    __builtin_amdgcn_global_load_lds((const __attribute__((address_space(1))) unsigned*)g, (__attribute__((address_space(3))) unsigned*)l, 16, 0, 0);
}
template <typename ARow, typename BRow>
__device__ __forceinline__ void gemm_tile(char* smem, const ARow& arow, const BRow& brow, int K, f32x4 (&acc)[8][4]) {
    const int tid = threadIdx.x, lane = tid & 63, wave = tid >> 6;
    const int wm = wave >> 2, wn = wave & 3;
    const int fr = lane & 15, fq = lane >> 4;
    const int lrow = lane >> 2;
    const int schunk = (lane & 3) ^ ((0x78 >> (2 * ((lane >> 4) & 3))) & 3);
    const h16* ap[2]; const h16* bp[2];
#pragma unroll
    for (int i = 0; i < 2; ++i) { ap[i] = arow(32 * wave + 16 * i + lrow) + schunk * 8; bp[i] = brow(32 * wave + 16 * i + lrow) + schunk * 8; }
    char* ldsA = smem + (2 * wave) * 1024 + lane * 16;
    char* ldsB = smem + 16384 + (2 * wave) * 1024 + lane * 16;
    const int fsw = (0x78 >> (2 * (fr >> 2))) & 3;
    const int rdA = (128 * wm + fr) * 64 + ((fq ^ fsw) << 4);
    const int rdB = 16384 + (64 * wn + fr) * 64 + ((fq ^ fsw) << 4);
#pragma unroll
    for (int mi = 0; mi < 8; ++mi)
#pragma unroll
        for (int ni = 0; ni < 4; ++ni) acc[mi][ni] = (f32x4){0.f, 0.f, 0.f, 0.f};
    const int nk = K >> 5;
    WAIT_V(0);
    __syncthreads();
#pragma unroll
    for (int st = 0; st < 3; ++st) {
        if (st < nk) {
#pragma unroll
            for (int i = 0; i < 2; ++i) { glds16(ap[i] + st * 32, ldsA + st * GEMM_STAGE + i * 1024); glds16(bp[i] + st * 32, ldsB + st * GEMM_STAGE + i * 1024); }
        }
    }
    int cur = 0, nxt = 3 * GEMM_STAGE;
#pragma unroll 1
    for (int kt = 0; kt < nk; ++kt) {
        const int ahead = nk - 1 - kt;
        if (ahead >= 2) { WAIT_V(8); } else if (ahead == 1) { WAIT_V(4); } else { WAIT_V(0); }
        __builtin_amdgcn_s_barrier();
        const char* As = smem + cur + rdA;
        const char* Bs = smem + cur + rdB;
        h16x8 af[8], bf[4];
#pragma unroll
        for (int ni = 0; ni < 4; ++ni) bf[ni] = *(const h16x8*)(Bs + ni * 1024);
#pragma unroll
        for (int mi = 0; mi < 8; ++mi) af[mi] = *(const h16x8*)(As + mi * 1024);
        __builtin_amdgcn_sched_barrier(0);
        if (kt + 3 < nk) {
            const int ko = (kt + 3) * 32;
#pragma unroll
            for (int i = 0; i < 2; ++i) { glds16(ap[i] + ko, ldsA + nxt + i * 1024); glds16(bp[i] + ko, ldsB + nxt + i * 1024); }
        }
        __builtin_amdgcn_sched_barrier(0);
        __builtin_amdgcn_s_setprio(1);
#pragma unroll
        for (int mi = 0; mi < 8; ++mi)
#pragma unroll
            for (int ni = 0; ni < 4; ++ni)
                acc[mi][ni] = __builtin_amdgcn_mfma_f32_16x16x32_f16(bf[ni], af[mi], acc[mi][ni], 0, 0, 0);
        __builtin_amdgcn_s_setprio(0);
        cur = (cur == 3 * GEMM_STAGE) ? 0 : cur + GEMM_STAGE;
        nxt = (nxt == 3 * GEMM_STAGE) ? 0 : nxt + GEMM_STAGE;
    }
}
template <typename F>
__device__ __forceinline__ void acc_foreach(const f32x4 (&acc)[8][4], F f) {
    const int lane = threadIdx.x & 63, wave = threadIdx.x >> 6;
    const int wm = wave >> 2, wn = wave & 3;
#pragma unroll
    for (int mi = 0; mi < 8; ++mi)
#pragma unroll
        for (int ni = 0; ni < 4; ++ni)
            f(128 * wm + 16 * mi + (lane & 15), 64 * wn + 16 * ni + 4 * (lane >> 4), acc[mi][ni]);
}
namespace g8 {
constexpr int BK = 64, HALF = 128, HTB = HALF * BK * 2;
__device__ __forceinline__ int lds_byte(int r, int c) { const int st = (r >> 4) * 2 + (c >> 5), rr = r & 15, cc = c & 31, ob = rr * 64 + cc * 2; return st * 1024 + (ob ^ (((ob >> 9) & 1) << 5)); }
__device__ __forceinline__ void stage_rc(int b, int& R, int& C) { const int st = b / 1024, sb = b % 1024, swz = sb ^ (((sb >> 9) & 1) << 5); R = (st >> 1) * 16 + swz / 64; C = (st & 1) * 32 + (swz % 64) / 2; }
struct Unit { const h16* a; const h16* b; int u0, u1, u2, u3, u4; };
}
template <class Sched, class Epi>
__device__ __forceinline__ void gemm_phase8(char* smem, int lda, int ldb, int K, const Sched& S, const Epi& E) {
    using namespace g8;
    LAS unsigned char* lds = (LAS unsigned char*)smem;
    const int tid = threadIdx.x, wid = __builtin_amdgcn_readfirstlane(tid >> 6), lane = tid & 63, wr = wid >> 2, wc = wid & 3, fr = lane & 15, fq = lane >> 4;
    const int nt = K / BK;
    unsigned voffA[2], voffB[2];
#pragma unroll
    for (int i = 0; i < 2; ++i) { int R, C; stage_rc(tid * 16 + i * 8192, R, C); voffA[i] = (unsigned)(R * lda + C) * 2u; voffB[i] = (unsigned)(R * ldb + C) * 2u; }
    const size_t kstep = (size_t)(BK * 2);
    const size_t hstepA = (size_t)HALF * lda * 2, hstepB = (size_t)HALF * ldb * 2;
    const unsigned ldsw = (unsigned)wid * 1024u;
    const int aoff = lds_byte(wr * 64 + fr, fq * 8), boff = lds_byte(wc * 32 + fr, fq * 8);
#define G8_SA(b, h) (((b) * 2 + (h)) * HTB)
#define G8_SB(b, h) ((4 + (b) * 2 + (h)) * HTB)
#define G8_STAGE(bufoff, gbase, voff) do { _Pragma("unroll") for (int _i = 0; _i < 2; ++_i) \
        __builtin_amdgcn_global_load_lds((const __attribute__((address_space(1))) unsigned*)((const char*)(gbase) + (voff)[_i]), (LAS unsigned*)(lds + (bufoff) + ldsw + _i * 8192), 16, 0, 0); } while (0)
#define G8_LDA(dst, b, h) do { _Pragma("unroll") for (int m = 0; m < 4; ++m) _Pragma("unroll") for (int k = 0; k < 2; ++k) dst[m][k] = *(const LAS h16x8*)(lds + G8_SA(b, h) + aoff + m * 2048 + k * 1024); } while (0)
#define G8_LDB(dst, b, h) do { _Pragma("unroll") for (int n = 0; n < 2; ++n) _Pragma("unroll") for (int k = 0; k < 2; ++k) dst[n][k] = *(const LAS h16x8*)(lds + G8_SB(b, h) + boff + n * 2048 + k * 1024); } while (0)
#define G8_MMA(ai, bj, At, Bt) do { __builtin_amdgcn_s_setprio(1); _Pragma("unroll") for (int m = 0; m < 4; ++m) _Pragma("unroll") for (int n = 0; n < 2; ++n) _Pragma("unroll") for (int k = 0; k < 2; ++k) \
        acc[ai][bj][m][n] = __builtin_amdgcn_mfma_f32_16x16x32_f16(Bt[n][k], At[m][k], acc[ai][bj][m][n], 0, 0, 0); __builtin_amdgcn_s_setprio(0); } while (0)
#define G8_WAIT_V(n) asm volatile("s_waitcnt vmcnt(" #n ")" ::: "memory")
#define G8_WAIT_L(n) asm volatile("s_waitcnt lgkmcnt(" #n ")" ::: "memory")
#define G8_BAR __builtin_amdgcn_s_barrier()
#define G8_SCHED __builtin_amdgcn_sched_barrier(0)
    Unit cur, nxt; int ui = 0;
    G8_WAIT_V(0);
    __syncthreads();
    if (!S(0, cur)) return;
    f32x4 acc[2][2][4][2];
#pragma unroll
    for (int a = 0; a < 2; ++a)
#pragma unroll
        for (int b = 0; b < 2; ++b)
#pragma unroll
            for (int m = 0; m < 4; ++m)
#pragma unroll
                for (int n = 0; n < 2; ++n) acc[a][b][m][n] = (f32x4){0.f, 0.f, 0.f, 0.f};
    h16x8 At[4][2], B0[2][2], B1[2][2];
    const char* cA = (const char*)cur.a; const char* cB = (const char*)cur.b;
    G8_STAGE(G8_SB(0, 0), cB, voffB); G8_STAGE(G8_SA(0, 0), cA, voffA); G8_STAGE(G8_SB(0, 1), cB + hstepB, voffB); G8_STAGE(G8_SA(0, 1), cA + hstepA, voffA);
    if (wr == 1) G8_BAR;
    G8_WAIT_V(4); G8_BAR;
    G8_STAGE(G8_SB(1, 0), cB + kstep, voffB); G8_STAGE(G8_SA(1, 0), cA + kstep, voffA); G8_STAGE(G8_SB(1, 1), cB + hstepB + kstep, voffB);
    G8_WAIT_V(6); G8_BAR;
    for (;;) {
        const bool has_next = S(ui + 1, nxt);
        const char* nA = has_next ? (const char*)nxt.a : cA; const char* nB = has_next ? (const char*)nxt.b : cB;
        for (int t = 0; t < nt; t += 2) {
            const bool last = (t == nt - 2);
            const char* a1 = cA + (size_t)(t + 1) * kstep;
            const char* a2 = last ? nA : cA + (size_t)(t + 2) * kstep; const char* b2 = last ? nB : cB + (size_t)(t + 2) * kstep;
            const char* a3 = a2 + kstep; const char* b3 = b2 + kstep;
            G8_LDB(B0, 0, 0); G8_SCHED; G8_LDA(At, 0, 0); G8_STAGE(G8_SA(1, 1), a1 + hstepA, voffA);
            G8_WAIT_L(8); G8_BAR; G8_WAIT_L(0); G8_MMA(0, 0, At, B0); G8_BAR; G8_SCHED;
            G8_LDB(B1, 0, 1); G8_STAGE(G8_SB(0, 0), b2, voffB);
            G8_BAR; G8_WAIT_L(0); G8_MMA(0, 1, At, B1); G8_BAR;
            G8_LDA(At, 0, 1); G8_STAGE(G8_SA(0, 0), a2, voffA);
            G8_BAR; G8_WAIT_L(0); G8_MMA(1, 0, At, B0); G8_BAR; G8_SCHED;
            G8_STAGE(G8_SB(0, 1), b2 + hstepB, voffB);
            G8_WAIT_V(6); G8_BAR; G8_MMA(1, 1, At, B1); G8_BAR;
            G8_LDB(B0, 1, 0); G8_SCHED; G8_LDA(At, 1, 0); G8_STAGE(G8_SA(0, 1), a2 + hstepA, voffA);
            G8_WAIT_L(8); G8_BAR; G8_WAIT_L(0); G8_MMA(0, 0, At, B0); G8_BAR; G8_SCHED;
            G8_LDB(B1, 1, 1); G8_STAGE(G8_SB(1, 0), b3, voffB);
            G8_BAR; G8_WAIT_L(0); G8_MMA(0, 1, At, B1); G8_BAR;
            G8_LDA(At, 1, 1); G8_STAGE(G8_SA(1, 0), a3, voffA);
            G8_BAR; G8_WAIT_L(0); G8_MMA(1, 0, At, B0); G8_BAR; G8_SCHED;
            G8_STAGE(G8_SB(1, 1), b3 + hstepB, voffB);
            G8_WAIT_V(6); G8_BAR; G8_MMA(1, 1, At, B1); G8_BAR;
        }
        E(cur, acc, wr, wc, fr, fq);
        if (!has_next) break;
#pragma unroll
        for (int a = 0; a < 2; ++a)
#pragma unroll
            for (int b = 0; b < 2; ++b)
#pragma unroll
                for (int m = 0; m < 4; ++m)
#pragma unroll
                    for (int n = 0; n < 2; ++n) acc[a][b][m][n] = (f32x4){0.f, 0.f, 0.f, 0.f};
        cur = nxt; cA = nA; cB = nB; ++ui;
    }
    G8_WAIT_V(0);
    if (wr == 0) G8_BAR;
    G8_BAR;
#undef G8_SA
#undef G8_SB
#undef G8_STAGE
#undef G8_LDA
#undef G8_LDB
#undef G8_MMA
#undef G8_WAIT_V
#undef G8_WAIT_L
#undef G8_BAR
#undef G8_SCHED
}
template <int ACPOL, class Sched, class RowOff, class Epi>
__device__ __forceinline__ void gemm_phase8g(char* smem, const h16* baseA_, int ldb, int K, const Sched& S, const RowOff& RO, const Epi& E) {
    using namespace g8;
    LAS unsigned char* lds = (LAS unsigned char*)smem;
    const char* baseA = (const char*)baseA_;
    const int tid = threadIdx.x, wid = __builtin_amdgcn_readfirstlane(tid >> 6), lane = tid & 63, wr = wid >> 2, wc = wid & 3, fr = lane & 15, fq = lane >> 4;
    const int nt = K / BK;
    int Rl[2], Cl[2]; unsigned voffB[2];
#pragma unroll
    for (int i = 0; i < 2; ++i) { stage_rc(tid * 16 + i * 8192, Rl[i], Cl[i]); voffB[i] = (unsigned)(Rl[i] * ldb + Cl[i]) * 2u; }
    const size_t kstep = (size_t)(BK * 2);
    const size_t hstepB = (size_t)HALF * ldb * 2;
    const unsigned ldsw = (unsigned)wid * 1024u;
    const int aoff = lds_byte(wr * 64 + fr, fq * 8), boff = lds_byte(wc * 32 + fr, fq * 8);
#define G8_SA(b, h) (((b) * 2 + (h)) * HTB)
#define G8_SB(b, h) ((4 + (b) * 2 + (h)) * HTB)
#define G8_STAGE(bufoff, gbase, voff) do { _Pragma("unroll") for (int _i = 0; _i < 2; ++_i) \
        __builtin_amdgcn_global_load_lds((const __attribute__((address_space(1))) unsigned*)((const char*)(gbase) + (voff)[_i]), (LAS unsigned*)(lds + (bufoff) + ldsw + _i * 8192), 16, 0, 0); } while (0)
#define G8_STAGEA(bufoff, gbase, voff) do { _Pragma("unroll") for (int _i = 0; _i < 2; ++_i) \
        __builtin_amdgcn_global_load_lds((const __attribute__((address_space(1))) unsigned*)((const char*)(gbase) + (voff)[_i]), (LAS unsigned*)(lds + (bufoff) + ldsw + _i * 8192), 16, 0, ACPOL); } while (0)
#define G8_LDA(dst, b, h) do { _Pragma("unroll") for (int m = 0; m < 4; ++m) _Pragma("unroll") for (int k = 0; k < 2; ++k) dst[m][k] = *(const LAS h16x8*)(lds + G8_SA(b, h) + aoff + m * 2048 + k * 1024); } while (0)
#define G8_LDB(dst, b, h) do { _Pragma("unroll") for (int n = 0; n < 2; ++n) _Pragma("unroll") for (int k = 0; k < 2; ++k) dst[n][k] = *(const LAS h16x8*)(lds + G8_SB(b, h) + boff + n * 2048 + k * 1024); } while (0)
#define G8_MMA(ai, bj, At, Bt) do { __builtin_amdgcn_s_setprio(1); _Pragma("unroll") for (int m = 0; m < 4; ++m) _Pragma("unroll") for (int n = 0; n < 2; ++n) _Pragma("unroll") for (int k = 0; k < 2; ++k) \
        acc[ai][bj][m][n] = __builtin_amdgcn_mfma_f32_16x16x32_f16(Bt[n][k], At[m][k], acc[ai][bj][m][n], 0, 0, 0); __builtin_amdgcn_s_setprio(0); } while (0)
#define G8_WAIT_V(n) asm volatile("s_waitcnt vmcnt(" #n ")" ::: "memory")
#define G8_WAIT_L(n) asm volatile("s_waitcnt lgkmcnt(" #n ")" ::: "memory")
#define G8_BAR __builtin_amdgcn_s_barrier()
#define G8_SCHED __builtin_amdgcn_sched_barrier(0)
    Unit cur, nxt; int ui = 0;
    G8_WAIT_V(0);
    __syncthreads();
    if (!S(0, cur)) return;
    f32x4 acc[2][2][4][2];
#pragma unroll
    for (int a = 0; a < 2; ++a)
#pragma unroll
        for (int b = 0; b < 2; ++b)
#pragma unroll
            for (int m = 0; m < 4; ++m)
#pragma unroll
                for (int n = 0; n < 2; ++n) acc[a][b][m][n] = (f32x4){0.f, 0.f, 0.f, 0.f};
    h16x8 At[4][2], B0[2][2], B1[2][2];
    unsigned oc0[2], oc1[2], on0[2], on1[2];
#pragma unroll
    for (int i = 0; i < 2; ++i) { oc0[i] = RO(cur, Rl[i]) + (unsigned)Cl[i] * 2u; oc1[i] = RO(cur, HALF + Rl[i]) + (unsigned)Cl[i] * 2u; }
    const char* cB = (const char*)cur.b;
    G8_STAGE(G8_SB(0, 0), cB, voffB); G8_STAGEA(G8_SA(0, 0), baseA, oc0); G8_STAGE(G8_SB(0, 1), cB + hstepB, voffB); G8_STAGEA(G8_SA(0, 1), baseA, oc1);
    if (wr == 1) G8_BAR;
    G8_WAIT_V(4); G8_BAR;
    G8_STAGE(G8_SB(1, 0), cB + kstep, voffB); G8_STAGEA(G8_SA(1, 0), baseA + kstep, oc0); G8_STAGE(G8_SB(1, 1), cB + hstepB + kstep, voffB);
    G8_WAIT_V(6); G8_BAR;
    for (;;) {
        const bool has_next = S(ui + 1, nxt);
        const char* nB = has_next ? (const char*)nxt.b : cB;
#pragma unroll
        for (int i = 0; i < 2; ++i) {
            on0[i] = has_next ? RO(nxt, Rl[i]) + (unsigned)Cl[i] * 2u : oc0[i];
            on1[i] = has_next ? RO(nxt, HALF + Rl[i]) + (unsigned)Cl[i] * 2u : oc1[i];
        }
        for (int t = 0; t < nt; t += 2) {
            const bool last = (t == nt - 2);
            const char* a1 = baseA + (size_t)(t + 1) * kstep;
            const char* a2 = last ? baseA : baseA + (size_t)(t + 2) * kstep;
            const char* b2 = last ? nB : cB + (size_t)(t + 2) * kstep;
            const char* a3 = a2 + kstep; const char* b3 = b2 + kstep;
            unsigned o20[2], o21[2];
#pragma unroll
            for (int i = 0; i < 2; ++i) { o20[i] = last ? on0[i] : oc0[i]; o21[i] = last ? on1[i] : oc1[i]; }
            G8_LDB(B0, 0, 0); G8_SCHED; G8_LDA(At, 0, 0); G8_STAGEA(G8_SA(1, 1), a1, oc1);
            G8_WAIT_L(8); G8_BAR; G8_WAIT_L(0); G8_MMA(0, 0, At, B0); G8_BAR; G8_SCHED;
            G8_LDB(B1, 0, 1); G8_STAGE(G8_SB(0, 0), b2, voffB);
            G8_BAR; G8_WAIT_L(0); G8_MMA(0, 1, At, B1); G8_BAR;
            G8_LDA(At, 0, 1); G8_STAGEA(G8_SA(0, 0), a2, o20);
            G8_BAR; G8_WAIT_L(0); G8_MMA(1, 0, At, B0); G8_BAR; G8_SCHED;
            G8_STAGE(G8_SB(0, 1), b2 + hstepB, voffB);
            G8_WAIT_V(6); G8_BAR; G8_MMA(1, 1, At, B1); G8_BAR;
            G8_LDB(B0, 1, 0); G8_SCHED; G8_LDA(At, 1, 0); G8_STAGEA(G8_SA(0, 1), a2, o21);
            G8_WAIT_L(8); G8_BAR; G8_WAIT_L(0); G8_MMA(0, 0, At, B0); G8_BAR; G8_SCHED;
            G8_LDB(B1, 1, 1); G8_STAGE(G8_SB(1, 0), b3, voffB);
            G8_BAR; G8_WAIT_L(0); G8_MMA(0, 1, At, B1); G8_BAR;
            G8_LDA(At, 1, 1); G8_STAGEA(G8_SA(1, 0), a3, o20);
            G8_BAR; G8_WAIT_L(0); G8_MMA(1, 0, At, B0); G8_BAR; G8_SCHED;
            G8_STAGE(G8_SB(1, 1), b3 + hstepB, voffB);
            G8_WAIT_V(6); G8_BAR; G8_MMA(1, 1, At, B1); G8_BAR;
        }
        E(cur, acc, wr, wc, fr, fq);
        if (!has_next) break;
#pragma unroll
        for (int a = 0; a < 2; ++a)
#pragma unroll
            for (int b = 0; b < 2; ++b)
#pragma unroll
                for (int m = 0; m < 4; ++m)
#pragma unroll
                    for (int n = 0; n < 2; ++n) acc[a][b][m][n] = (f32x4){0.f, 0.f, 0.f, 0.f};
        cur = nxt; cB = nB; ++ui;
#pragma unroll
        for (int i = 0; i < 2; ++i) { oc0[i] = on0[i]; oc1[i] = on1[i]; }
    }
    G8_WAIT_V(0);
    if (wr == 0) G8_BAR;
    G8_BAR;
#undef G8_SA
#undef G8_SB
#undef G8_STAGE
#undef G8_STAGEA
#undef G8_LDA
#undef G8_LDB
#undef G8_MMA
#undef G8_WAIT_V
#undef G8_WAIT_L
#undef G8_BAR
#undef G8_SCHED
}
template <typename F>
__device__ __forceinline__ void acc8_foreach(const f32x4 (&acc)[2][2][4][2], int wr, int wc, int fr, int fq, F f) {
#pragma unroll
    for (int ai = 0; ai < 2; ++ai)
#pragma unroll
        for (int m = 0; m < 4; ++m)
#pragma unroll
            for (int bj = 0; bj < 2; ++bj)
#pragma unroll
                for (int n = 0; n < 2; ++n)
                    f(128 * ai + 64 * wr + 16 * m + fr, 128 * bj + 32 * wc + 16 * n + 4 * fq, acc[ai][bj][m][n]);
}
__device__ __forceinline__ void store_h4(h16* p, f32x4 v) { h16x4 o = {(h16)v[0], (h16)v[1], (h16)v[2], (h16)v[3]}; *(h16x4*)p = o; }
__device__ __forceinline__ void tile_order(int t, int MT, int NTl, int& tm, int& tn) {
    const int GM = 8;
    const int per = GM * NTl;
    const int g = t / per, r = t - g * per;
    const int fm = g * GM;
    const int gsz = (MT - fm) < GM ? (MT - fm) : GM;
    tm = fm + (r % gsz); tn = r / gsz;
}

struct ConvDesc { const float* src; h16* dst; int N, ldd, k0, n0, mode; };
constexpr int CONV_T0 = 2432, CONV_T1 = CONV_T0 + 1024, CONV_T2 = CONV_T1 + 1024, CONV_T3 = CONV_T2 + 32, CONV_T4 = CONV_T3 + 32, CONV_T5 = CONV_T4 + 32, CONV_T6 = CONV_T5 + 16 * 768;
__device__ __forceinline__ ConvDesc conv_desc_expert(const Params& p, int l, int u) {
    char* ws = p.ws;
    const int e = u / 768, r = u % 768;
    const int le = l * 16 + e;
    const int which = r >> 8, q = r & 255;
    ConvDesc d;
    if (which < 2) {
        d.src = p.in[27 + which] + (size_t)le * 2048 * 512; d.N = 512; d.k0 = (q >> 3) * 64; d.n0 = (q & 7) * 64;
        d.dst = (h16*)(ws + OFF_EXP + l * EXP_L) + (size_t)e * 1024 * 2048; d.ldd = 2048; d.mode = 1 + which;
    } else {
        d.src = p.in[29] + (size_t)le * 512 * 2048; d.N = 2048; d.k0 = (q >> 5) * 64; d.n0 = (q & 31) * 64;
        d.dst = (h16*)(ws + OFF_EXP + l * EXP_L + EGU_BYTES) + (size_t)e * 2048 * 512; d.ldd = 512; d.mode = 0;
    }
    return d;
}
__device__ __forceinline__ ConvDesc conv_desc_prologue(const Params& p, int t) {
    char* ws = p.ws;
    ConvDesc d; d.mode = 0;
    if (t < CONV_T0) { d.src = p.in[8]; d.N = IN_COLS; d.k0 = (t / 76) * 64; d.n0 = (t % 76) * 64; d.dst = (h16*)(ws + OFF_WIN); d.ldd = D; }
    else if (t < CONV_T1) { const int u = t - CONV_T0; d.src = p.in[23]; d.N = D; d.k0 = (u >> 5) * 64; d.n0 = (u & 31) * 64; d.dst = (h16*)(ws + OFF_WOUT); d.ldd = D; }
    else if (t < CONV_T2) { const int u = t - CONV_T1; d.src = p.in[24]; d.N = D; d.k0 = (u >> 5) * 64; d.n0 = (u & 31) * 64; d.dst = (h16*)(ws + OFF_FW); d.ldd = D; }
    else if (t < CONV_T3) { const int u = t - CONV_T2; const int dd = u >> 4; d.src = p.in[12] + (size_t)dd * 64 * 1024; d.N = 1024; d.k0 = 0; d.n0 = (u & 15) * 64; d.dst = (h16*)(ws + OFF_W2T) + (size_t)dd * 1024 * 64; d.ldd = 64; }
    else if (t < CONV_T4) { const int u = t - CONV_T3; const int dd = u >> 4; d.src = p.in[14] + (size_t)dd * 64 * 1024; d.N = 1024; d.k0 = 0; d.n0 = (u & 15) * 64; d.dst = (h16*)(ws + OFF_A2T) + (size_t)dd * 1024 * 64; d.ldd = 64; }
    else if (t < CONV_T5) { const int u = t - CONV_T4; d.src = p.in[15]; d.N = 1024; d.k0 = (u >> 4) * 64; d.n0 = (u & 15) * 64; d.dst = (h16*)(ws + OFF_G2T); d.ldd = 128; }
    else d = conv_desc_expert(p, 0, t - CONV_T5);
    return d;
}
template <typename DescFn>
__device__ __forceinline__ void conv_run(char* smem, int t_end, DescFn get) {
    const int vb = threadIdx.x >> 8, tid = threadIdx.x & 255;
    unsigned* tile = (unsigned*)(smem + vb * 17408);
    const int nc = tid & 15, kp = tid >> 4;
    const int kc = tid & 7, nr = tid >> 3;
    int tp = blockIdx.x;
    if (4 * tp >= t_end) return;
    auto clampt = [&](int tpp, int u) { const int t = 4 * tpp + 2 * vb + u; return t < t_end ? t : t_end - 1; };
    ConvDesc d[2]; f32x4 a0[2], b0[2], a1[2], b1[2];
#pragma unroll
    for (int u = 0; u < 2; ++u) {
        d[u] = get(clampt(tp, u));
        const float* s0 = d[u].src + (size_t)(d[u].k0 + 2 * kp) * d[u].N + d[u].n0 + 4 * nc;
        a0[u] = *(const f32x4*)s0; b0[u] = *(const f32x4*)(s0 + d[u].N);
        const float* s1 = s0 + (size_t)32 * d[u].N;
        a1[u] = *(const f32x4*)s1; b1[u] = *(const f32x4*)(s1 + d[u].N);
    }
    __syncthreads();
    for (;;) {
        const int tn = tp + (int)gridDim.x;
        const bool more = 4 * tn < t_end;
        ConvDesc dn[2]; f32x4 na0[2], nb0[2], na1[2], nb1[2];
#pragma unroll
        for (int u = 0; u < 2; ++u) { dn[u] = d[u]; na0[u] = a0[u]; nb0[u] = b0[u]; na1[u] = a1[u]; nb1[u] = b1[u]; }
        if (more) {
#pragma unroll
            for (int u = 0; u < 2; ++u) {
                dn[u] = get(clampt(tn, u));
                const float* s0 = dn[u].src + (size_t)(dn[u].k0 + 2 * kp) * dn[u].N + dn[u].n0 + 4 * nc;
                na0[u] = *(const f32x4*)s0; nb0[u] = *(const f32x4*)(s0 + dn[u].N);
                const float* s1 = s0 + (size_t)32 * dn[u].N;
                na1[u] = *(const f32x4*)s1; nb1[u] = *(const f32x4*)(s1 + dn[u].N);
            }
        }
#pragma unroll
        for (int u = 0; u < 2; ++u)
#pragma unroll
            for (int e = 0; e < 4; ++e) { tile[u * 2176 + (4 * nc + e) * 33 + kp] = pack_h2(a0[u][e], b0[u][e]); tile[u * 2176 + (4 * nc + e) * 33 + kp + 16] = pack_h2(a1[u][e], b1[u][e]); }
        __syncthreads();
#pragma unroll
        for (int u = 0; u < 2; ++u)
#pragma unroll
            for (int ps = 0; ps < 2; ++ps) {
                const int n = nr + 32 * ps;
                u32x4 v;
                v[0] = tile[u * 2176 + n * 33 + 4 * kc + 0]; v[1] = tile[u * 2176 + n * 33 + 4 * kc + 1]; v[2] = tile[u * 2176 + n * 33 + 4 * kc + 2]; v[3] = tile[u * 2176 + n * 33 + 4 * kc + 3];
                const int ng = d[u].n0 + n;
                int np = ng;
                if (d[u].mode == 1) np = 32 * (ng >> 4) + (ng & 15);
                else if (d[u].mode == 2) np = 32 * (ng >> 4) + 16 + (ng & 15);
                *(u32x4*)(d[u].dst + (size_t)np * d[u].ldd + d[u].k0 + 8 * kc) = v;
            }
        __syncthreads();
        if (!more) break;
#pragma unroll
        for (int u = 0; u < 2; ++u) { d[u] = dn[u]; a0[u] = na0[u]; b0[u] = nb0[u]; a1[u] = na1[u]; b1[u] = nb1[u]; }
        tp = tn;
    }
}
__device__ __forceinline__ void phase_conv_experts(const Params& p, char* smem, int bid, int nblk, int l) {
    conv_run(smem, 16 * 768, [&](int t) { return conv_desc_expert(p, l, t); });
}
__device__ __forceinline__ void phase_prologue(const Params& p, char* smem, int bid, int nblk) {
    const int tid = threadIdx.x;
    char* ws = p.ws;
    {
        float* sl = (float*)smem;
        float* red = sl + 5 * 2048;
        float* mod = (float*)(ws + OFF_MOD);
        for (int i = tid; i < 5 * 2048; i += NT) {
            const int v = i >> 11, kk = i & 2047;
            const float cv = (v < 4) ? p.in[1][v * D + kk] : p.in[3][kk];
            sl[i] = siluf_(cv);
        }
        __syncthreads();
        const int ks = tid >> 3, cg = tid & 7;
        for (int it = bid; it < 2 * 384; it += nblk) {
            const int l = it / 384, nc = it % 384;
            const int n0 = nc * 32 + cg * 4;
            const float* wp = p.in[4] + ((size_t)l * D + ks * 32) * 12288 + n0;
            f32x4 a0 = {0, 0, 0, 0}, a1 = a0, a2 = a0, a3 = a0, a4 = a0;
#pragma unroll 8
            for (int kk = 0; kk < 32; ++kk) {
                const f32x4 w = *(const f32x4*)(wp + (size_t)kk * 12288);
                const int k = ks * 32 + kk;
                a0 += w * sl[k]; a1 += w * sl[2048 + k]; a2 += w * sl[4096 + k]; a3 += w * sl[6144 + k]; a4 += w * sl[8192 + k];
            }
            float* r = red + ks * 160 + cg * 4;
            *(f32x4*)(r) = a0; *(f32x4*)(r + 32) = a1; *(f32x4*)(r + 64) = a2; *(f32x4*)(r + 96) = a3; *(f32x4*)(r + 128) = a4;
            __syncthreads();
            if (tid < 160) {
                const int v = tid >> 5, c = tid & 31;
                float sum = p.in[5][l * 12288 + nc * 32 + c];
#pragma unroll 8
                for (int q = 0; q < 64; ++q) sum += red[q * 160 + v * 32 + c];
                mod[(size_t)(l * 5 + v) * 12288 + nc * 32 + c] = sum;
            }
            __syncthreads();
        }
    }
    {
        h16* DT = (h16*)(ws + OFF_DT);
        const float sT = 0.022097086912079608f;
        for (size_t i = (size_t)bid * NT + tid; i < (size_t)2048 * 2048; i += (size_t)nblk * NT) {
            const int k = (int)(i >> 11), kp = (int)(i & 2047);
            const int t = kp & 1023;
            const int m = (k * t) & 2047;
            const float x = (float)m * (1.0f / 1024.0f);
            const float v = (kp < 1024) ? cospif(x) : -sinpif(x);
            DT[i] = (h16)(v * sT);
        }
        h16* DC = (h16*)(ws + OFF_DC);
        for (int i = bid * NT + tid; i < 512 * 256; i += nblk * NT) {
            const int n = i >> 8, c = i & 255;
            const int m = ((n & 255) * c) & 255;
            const float x = (float)m * (1.0f / 128.0f);
            const float v = (n < 256) ? cospif(x) : sinpif(x);
            DC[i] = (h16)(v * 0.0625f);
        }
        h16* RWH = (h16*)(ws + OFF_RWH); h16* RWL = (h16*)(ws + OFF_RWL);
        for (int i = bid * NT + tid; i < 16 * 2048; i += nblk * NT) {
            const int e = i >> 11, k = i & 2047;
            const float w = p.in[25][k * 16 + e];
            const h16 wh = (h16)w;
            RWH[i] = wh; RWL[i] = (h16)((w - (float)wh) * 4096.0f);
        }
        float* RP = (float*)(ws + OFF_ROPE);
        for (int i = bid * NT + tid; i < 2048 * 64; i += nblk * NT) {
            const int t = i >> 6, f = i & 63;
            const int fi = f & 31;
            const float inv = powf(10000.0f, -(float)(2 * fi) / 64.0f);
            const float pos = (f < 32) ? (float)(t >> 6) : (float)(t & 63);
            const float ang = pos * inv;
            RP[2 * i] = cosf(ang); RP[2 * i + 1] = sinf(ang);
        }
    }
    __syncthreads();
    conv_run(smem, CONV_T6, [&](int t) { return conv_desc_prologue(p, t); });
}

__device__ __forceinline__ void phase_modfin(const Params& p, int bid, int nblk) {
    const float* modp = (const float*)(p.ws + OFF_MODP);
    float* mod = (float*)(p.ws + OFF_MOD);
    for (int i = bid * NT + threadIdx.x; i < 2 * 5 * 12288; i += nblk * NT) {
        const int n = i % 12288, l = i / (5 * 12288);
        float s = p.in[5][l * 12288 + n];
#pragma unroll
        for (int ks = 0; ks < 16; ++ks) s += modp[(size_t)ks * (2 * 5 * 12288) + i];
        mod[i] = s;
    }
}
__device__ __forceinline__ const float* modv(const Params& p, int l, int v, int part) { return (const float*)(p.ws + OFF_MOD) + ((size_t)(l * 5 + v) * 6 + part) * 2048; }

__device__ __forceinline__ void phase_norm0(const Params& p, int bid, int nblk) {
    const int lane = threadIdx.x & 63, wave = threadIdx.x >> 6;
    h16* H = (h16*)(p.ws + OFF_H);
    for (int R = bid * NW + wave; R < ROWS0; R += nblk * NW) {
        const int b = R / SALL, s = R % SALL;
        const float* xr; int v;
        if (s < CTXL) { xr = p.in[2] + ((size_t)b * CTXL + s) * D; v = 4; } else { xr = p.in[0] + ((size_t)b * SEQ + (s - CTXL)) * D; v = b; }
        const float* sh = modv(p, 0, v, 0); const float* sc = modv(p, 0, v, 1);
        const float* gn = p.in[6];
        f32x4 x[8]; float ss = 0.f;
#pragma unroll
        for (int i = 0; i < 8; ++i) { x[i] = *(const f32x4*)(xr + i * 256 + lane * 4); ss += x[i][0] * x[i][0] + x[i][1] * x[i][1] + x[i][2] * x[i][2] + x[i][3] * x[i][3]; }
        ss = wave_sum(ss);
        const float rstd = rsqrtf(ss * (1.0f / D) + 1e-6f);
#pragma unroll
        for (int i = 0; i < 8; ++i) {
            const int k = i * 256 + lane * 4;
            const f32x4 g = *(const f32x4*)(gn + k), c1 = *(const f32x4*)(sc + k), h1 = *(const f32x4*)(sh + k);
            const f32x4 y = (x[i] * rstd) * g * (c1 + 1.0f) + h1;
            store_h4(H + (size_t)R * D + k, y);
        }
    }
}

__device__ __forceinline__ void phase_gemm_in(const Params& p, char* smem, int bid, int nblk) {
    const h16* A = (const h16*)(p.ws + OFF_H);
    const h16* Bt = (const h16*)(p.ws + OFF_WIN);
    h16* P = (h16*)(p.ws + OFF_P);
    const int MT = ROWS0 / 256, NTl = IN_COLS / 256;
    auto sched = [&](int i, g8::Unit& u) {
        const int t = bid + i * nblk;
        if (t >= MT * NTl) return false;
        int tm, tn; tile_order(t, MT, NTl, tm, tn);
        u.a = A + (size_t)(tm * 256) * D; u.b = Bt + (size_t)(tn * 256) * D; u.u0 = tm; u.u1 = tn; u.u2 = 0; u.u3 = 0;
        return true;
    };
    gemm_phase8(smem, D, D, D, sched, [&](const g8::Unit& u, const f32x4 (&acc)[2][2][4][2], int wr, int wc, int fr, int fq) {
        const int tm = u.u0, tn = u.u1;
        acc8_foreach(acc, wr, wc, fr, fq, [&](int r, int c, f32x4 v) { store_h4(P + (size_t)(tm * 256 + r) * IN_COLS + tn * 256 + c, v); });
    });
}

__device__ __forceinline__ void phase_prep(const Params& p, int bid, int nblk) {
    const int lane = threadIdx.x & 63, wave = threadIdx.x >> 6;
    char* ws = p.ws;
    const h16* P = (const h16*)(ws + OFF_P);
    h16* SR = (h16*)(ws + OFF_SR); h16* SV = (h16*)(ws + OFF_SV); h16* SKS = (h16*)(ws + OFF_SKS); h16* SKK = (h16*)(ws + OFF_SKK);
    h16* F = (h16*)(ws + OFF_F);
    h16* Q = (h16*)(ws + OFF_Q); h16* KB = (h16*)(ws + OFF_KB); h16* VT = (h16*)(ws + OFF_VT);
    const float* RP = (const float*)(ws + OFF_ROPE);
    const float* mup = p.in[9]; const float* mun = p.in[10];
    const float* k_k = p.in[16];
    for (int R = bid * NW + wave; R < ROWS0; R += nblk * NW) {
        const int b = R / SALL, s = R % SALL;
        const bool has_prev = !(s == 0 || s == CTXL);
        const bool has_next = !(s == CTXL - 1 || s == SALL - 1);
        const h16* p0 = P + (size_t)R * IN_COLS;
        const h16* pm = p0 - IN_COLS; const h16* pn = p0 + IN_COLS;
#pragma unroll
        for (int part = 0; part < 3; ++part) {
#pragma unroll
            for (int i = 0; i < 4; ++i) {
                const int c = i * 256 + lane * 4, col = part * 1024 + c;
                const h16x4 a = *(const h16x4*)(p0 + col);
                h16x4 am = {0, 0, 0, 0}, an = {0, 0, 0, 0};
                if (has_prev) am = *(const h16x4*)(pm + col);
                if (has_next) an = *(const h16x4*)(pn + col);
                const f32x4 mp = *(const f32x4*)(mup + col), mn = *(const f32x4*)(mun + col);
                f32x4 y;
#pragma unroll
                for (int e = 0; e < 4; ++e) { const float x0 = (float)a[e]; y[e] = x0 + mp[e] * ((float)am[e] - x0) + mn[e] * ((float)an[e] - x0); }
                if (part == 0) store_h4(SR + (size_t)R * DA + c, y);
                else if (part == 2) store_h4(SV + (size_t)R * DA + c, y);
                else {
                    store_h4(SKS + (size_t)R * DA + c, y);
                    const f32x4 kk4 = *(const f32x4*)(k_k + c);
                    f32x4 z = y * kk4;
                    float ss = z[0] * z[0] + z[1] * z[1] + z[2] * z[2] + z[3] * z[3];
                    ss = row16_sum(ss);
                    z = z * rsqrtf(ss + 1e-12f);
                    store_h4(SKK + (size_t)R * DA + c, z);
                }
            }
        }
        {
            auto shifted = [&](int col) {
                const float x0 = (float)p0[col];
                const float xm = has_prev ? (float)pm[col] : 0.f, xn = has_next ? (float)pn[col] : 0.f;
                return x0 + mup[col] * (xm - x0) + mun[col] * (xn - x0);
            };
            F[(size_t)R * 256 + lane] = (h16)ftanh_(shifted(3072 + lane));
            F[(size_t)R * 256 + 64 + lane] = (h16)shifted(3136 + lane);
            F[(size_t)R * 256 + 128 + lane] = (h16)fsigmoid_(shifted(3200 + lane));
            F[(size_t)R * 256 + 192 + lane] = (h16)fsigmoid_(shifted(3264 + lane));
        }
        {
            const bool lat = (s >= CTXL);
            const int t = s - CTXL;
            float cs = 1.f, sn = 0.f;
            if (lat) { cs = RP[((size_t)t * 64 + lane) * 2]; sn = RP[((size_t)t * 64 + lane) * 2 + 1]; }
            const float qg0 = p.in[21][2 * lane], qg1 = p.in[21][2 * lane + 1];
            const float kg0 = p.in[22][2 * lane], kg1 = p.in[22][2 * lane + 1];
            if (lat) {
#pragma unroll
                for (int h = 0; h < 8; ++h) {
                    const h16x2 v2 = *(const h16x2*)(p0 + A_COLS + h * 128 + 2 * lane);
                    float x0 = (float)v2[0], x1 = (float)v2[1];
                    const float ss = wave_sum(x0 * x0 + x1 * x1);
                    const float rstd = rsqrtf(ss * (1.0f / 128.0f) + 1e-6f);
                    x0 = x0 * rstd * qg0; x1 = x1 * rstd * qg1;
                    const float qs = 0.12751743074602897f;
                    const float o0 = (x0 * cs - x1 * sn) * qs, o1 = (x0 * sn + x1 * cs) * qs;
                    h16x2 o = {(h16)o0, (h16)o1};
                    *(h16x2*)(Q + (((size_t)(b * 8 + h) * SEQ + t) * 128 + 2 * lane)) = o;
                }
            }
#pragma unroll
            for (int h = 0; h < 2; ++h) {
                const h16x2 v2 = *(const h16x2*)(p0 + A_COLS + 1024 + h * 128 + 2 * lane);
                float x0 = (float)v2[0], x1 = (float)v2[1];
                const float ss = wave_sum(x0 * x0 + x1 * x1);
                const float rstd = rsqrtf(ss * (1.0f / 128.0f) + 1e-6f);
                x0 = x0 * rstd * kg0; x1 = x1 * rstd * kg1;
                const float o0 = x0 * cs - x1 * sn, o1 = x0 * sn + x1 * cs;
                h16x2 o = {(h16)o0, (h16)o1};
                *(h16x2*)(KB + (((size_t)(b * 2 + h) * SALL + s) * 128 + 2 * lane)) = o;
                const h16x2 vv = *(const h16x2*)(p0 + A_COLS + 1280 + h * 128 + 2 * lane);
                *(h16x2*)((h16*)(ws + OFF_VB) + (((size_t)(b * 2 + h) * SALL + s) * 128 + 2 * lane)) = vv;
            }
        }
    }
}

__device__ __forceinline__ void phase_lora(const Params& p, char* smem, int bid, int nblk) {
    char* ws = p.ws;
    const h16* F = (const h16*)(ws + OFF_F);
    const int MT = ROWS0 / 256;
    const int T0 = MT * 8, T1 = T0 + MT * 8, T2 = T1 + MT * 4;
    for (int t = bid; t < T2; t += nblk) {
        f32x4 acc[8][4];
        if (t < T0) {
            const int tm = t % MT, tn = t / MT;
            const h16* Bt = (const h16*)(ws + OFF_W2T);
            gemm_tile(smem, [&](int r) { return F + (size_t)(tm * 256 + r) * 256; }, [&](int n) { return Bt + (size_t)(tn * 256 + n) * 64; }, 64, acc);
            const float* w0 = p.in[11];
            acc_foreach(acc, [&](int r, int c, f32x4 v) {
                const int R = tm * 256 + r, n = tn * 256 + c, d = n >> 10, ch = n & 1023;
                const f32x4 b4 = *(const f32x4*)(w0 + n);
                f32x4 o;
#pragma unroll
                for (int e = 0; e < 4; ++e) {
                    const float z = v[e] + b4[e];
                    o[e] = 0.6065306597126334f * fsigmoid_(z);
                }
                h16* W = (h16*)(ws + (d ? OFF_SW1 : OFF_SW0));
                store_h4(W + (size_t)R * DA + ch, o);
            });
        } else if (t < T1) {
            const int u = t - T0; const int tm = u % MT, tn = u / MT;
            const h16* Bt = (const h16*)(ws + OFF_A2T);
            gemm_tile(smem, [&](int r) { return F + (size_t)(tm * 256 + r) * 256 + 64; }, [&](int n) { return Bt + (size_t)(tn * 256 + n) * 64; }, 64, acc);
            const float* a0 = p.in[13];
            acc_foreach(acc, [&](int r, int c, f32x4 v) {
                const int R = tm * 256 + r, n = tn * 256 + c, d = n >> 10, ch = n & 1023;
                const f32x4 b4 = *(const f32x4*)(a0 + n);
                f32x4 av;
#pragma unroll
                for (int e = 0; e < 4; ++e) av[e] = fsigmoid_(v[e] + b4[e]);
                store_h4((h16*)(ws + (d ? OFF_SKD1 : OFF_SKD0)) + (size_t)R * DA + ch, av);
            });
        } else {
            const int u = t - T1; const int tm = u % MT, tn = u / MT;
            const h16* Bt = (const h16*)(ws + OFF_G2T);
            gemm_tile(smem, [&](int r) { return F + (size_t)(tm * 256 + r) * 256 + 128; }, [&](int n) { return Bt + (size_t)(tn * 256 + n) * 128; }, 128, acc);
            h16* SG = (h16*)(ws + OFF_SG);
            acc_foreach(acc, [&](int r, int c, f32x4 v) { store_h4(SG + (size_t)(tm * 256 + r) * DA + tn * 256 + c, v); });
        }
    }
}

__device__ __forceinline__ int srow_of(int dir, int tau) { return dir ? ((tau < CTXL) ? (CTXL - 1 - tau) : (SALL + CTXL - 1 - tau)) : tau; }

__device__ __forceinline__ void phase_chunkprep(const Params& p, char* smem, int bid, int nblk) {
    char* ws = p.ws;
    const int tid = threadIdx.x, lane = tid & 63, wave = tid >> 6;
    const int fr = lane & 15, g = lane >> 4;
    {
        const h16* VB = (const h16*)(ws + OFF_VB); h16* VT = (h16*)(ws + OFF_VT);
        h16* tl = (h16*)smem;
        for (int tile = bid; tile < 8 * (SALL / 64); tile += nblk) {
            const int pair = tile / (SALL / 64), kt = tile % (SALL / 64);
            __syncthreads();
#pragma unroll
            for (int i = 0; i < 2; ++i) {
                const int e = tid + i * NT;
                const h16x8 v = *(const h16x8*)(VB + ((size_t)pair * SALL + kt * 64 + (e >> 4)) * 128 + (e & 15) * 8);
                h16* dp = tl + (e >> 4) * 132 + (e & 15) * 8;
                *(h16x4*)dp = (h16x4){v[0], v[1], v[2], v[3]}; *(h16x4*)(dp + 4) = (h16x4){v[4], v[5], v[6], v[7]};
            }
            __syncthreads();
            const int d = tid >> 2, pc = tid & 3;
            h16x8 o0, o1;
#pragma unroll
            for (int q = 0; q < 16; ++q) {
                const int pos = pc * 16 + q, p32 = pos & 31, gq = p32 >> 3, jj = p32 & 7;
                const int key = (pos & 32) + ((jj < 4) ? (4 * gq + jj) : (16 + 4 * gq + jj - 4));
                const h16 val = tl[key * 132 + d];
                if (q < 8) o0[q] = val; else o1[q - 8] = val;
            }
            h16* dst = VT + ((size_t)pair * 128 + d) * SALL + kt * 64 + pc * 16;
            *(h16x8*)dst = o0; *(h16x8*)(dst + 8) = o1;
        }
        __syncthreads();
    }
    char* wl = smem + wave * 12288;
    h16* At = (h16*)(wl); h16* Rt = (h16*)(wl + 2048); h16* Btl = (h16*)(wl + 4096); h16* Ktl = (h16*)(wl + 6144);
    h16* Bj = (h16*)(wl + 8192); h16* Kj = (h16*)(wl + 10240);
    const h16* SKK = (const h16*)(ws + OFF_SKK); const h16* SR = (const h16*)(ws + OFF_SR);
    for (int u = bid * NW + wave; u < 128 * NCHUNK; u += nblk * NW) {
        const int item = u / NCHUNK, c = u - item * NCHUNK;
        const int dir = item & 1, h = (item >> 1) & 15, b = item >> 5;
        const h16* SW = (const h16*)(ws + (dir ? OFF_SW1 : OFF_SW0));
        const h16* SAL = (const h16*)(ws + (dir ? OFF_SKD1 : OFF_SKD0));
        const h16* SKS = (const h16*)(ws + OFF_SKS);
        const float ka = p.in[17][h * 64 + lane];
        char* rec = ws + (dir ? OFF_FRAG1 : OFF_FRAG0) + ((size_t)((b * 16 + h) * NCHUNK + c)) * REC_BYTES;
        float w[16], at[16], rt[16], bt[16], kt[16];
#pragma unroll
        for (int t = 0; t < 16; ++t) {
            const int s = srow_of(dir, 16 * c + t);
            const size_t idx = ((size_t)(b * SALL + s)) * DA + h * 64 + lane;
            const float kkv = (float)SKK[idx], al = (float)SAL[idx];
            w[t] = fexp_(-(float)SW[idx]); at[t] = -kkv; rt[t] = (float)SR[idx]; bt[t] = kkv * al; kt[t] = (float)SKS[idx] * (1.0f + (al - 1.0f) * ka);
        }
        float wn = 1.f;
        if (c + 1 < NCHUNK) {
#pragma unroll
            for (int t = 0; t < 8; ++t) { const int s = srow_of(dir, 16 * (c + 1) + t); wn *= fexp_(-(float)SW[((size_t)(b * SALL + s)) * DA + h * 64 + lane]); }
        }
        float cum[16];
        cum[0] = w[0];
#pragma unroll
        for (int t = 1; t < 16; ++t) cum[t] = cum[t - 1] * w[t];
        const float w7 = cum[7], inv7 = 1.0f / w7;
        float sigma;
        {
            float rprev = inv7;
#pragma unroll
            for (int t = 0; t < 16; ++t) {
                const float rho = cum[t] * inv7;
                const float irho = w7 / cum[t];
                at[t] *= rprev; rt[t] *= rho; bt[t] *= irho; kt[t] *= irho;
                rprev = rho;
            }
            sigma = rprev * wn;
        }
        __builtin_amdgcn_wave_barrier();
#pragma unroll
        for (int t = 0; t < 16; ++t) { At[t * 64 + lane] = (h16)at[t]; Rt[t * 64 + lane] = (h16)rt[t]; Btl[t * 64 + lane] = (h16)bt[t]; Ktl[t * 64 + lane] = (h16)kt[t]; }
        {
            h16x8 b0, b1, k0, k1;
#pragma unroll
            for (int t = 0; t < 8; ++t) { b0[t] = (h16)bt[t]; b1[t] = (h16)bt[8 + t]; k0[t] = (h16)kt[t]; k1[t] = (h16)kt[8 + t]; }
            *(h16x8*)(Bj + lane * 16) = b0; *(h16x8*)(Bj + lane * 16 + 8) = b1;
            *(h16x8*)(Kj + lane * 16) = k0; *(h16x8*)(Kj + lane * 16 + 8) = k1;
        }
        __builtin_amdgcn_wave_barrier();
#pragma unroll
        for (int ks = 0; ks < 2; ++ks) {
            const h16x4 alo = *(const h16x4*)(At + fr * 64 + 32 * ks + 4 * g), ahi = *(const h16x4*)(At + fr * 64 + 32 * ks + 16 + 4 * g);
            *(h16x8*)(rec + ks * 1024 + lane * 16) = cat8(alo, ahi);
            const h16x4 rlo = *(const h16x4*)(Rt + fr * 64 + 32 * ks + 4 * g), rhi = *(const h16x4*)(Rt + fr * 64 + 32 * ks + 16 + 4 * g);
            *(h16x8*)(rec + 2048 + ks * 1024 + lane * 16) = cat8(rlo, rhi);
        }
#pragma unroll
        for (int jt = 0; jt < 4; ++jt) {
            const h16x4 blo = *(const h16x4*)(Bj + (16 * jt + fr) * 16 + 4 * g), khi = *(const h16x4*)(Kj + (16 * jt + fr) * 16 + 4 * g);
            *(h16x8*)(rec + 4096 + jt * 1024 + lane * 16) = cat8(blo, khi);
        }
        const f32x4 z4 = {0.f, 0.f, 0.f, 0.f};
        f32x4 Nak = z4, Nab = z4, Mkr = z4, Mbr = z4, NT = z4;
#pragma unroll
        for (int ks = 0; ks < 2; ++ks) {
            const h16x8 af = *(const h16x8*)(At + fr * 64 + 32 * ks + 8 * g), rf = *(const h16x8*)(Rt + fr * 64 + 32 * ks + 8 * g);
            const h16x8 bf = *(const h16x8*)(Btl + fr * 64 + 32 * ks + 8 * g), kf = *(const h16x8*)(Ktl + fr * 64 + 32 * ks + 8 * g);
            Nak = mfma32(kf, af, Nak); Nab = mfma32(bf, af, Nab); Mkr = mfma32(kf, rf, Mkr); Mbr = mfma32(bf, rf, Mbr); NT = mfma32(af, bf, NT);
        }
        f32x4 T1;
#pragma unroll
        for (int e = 0; e < 4; ++e) {
            const int row = 4 * g + e;
            if (!(row < fr)) { Nak[e] = 0.f; Nab[e] = 0.f; }
            if (!(row <= fr)) { Mkr[e] = 0.f; Mbr[e] = 0.f; }
            if (!(fr < row)) NT[e] = 0.f;
            T1[e] = Nab[e] + ((row == fr) ? 1.0f : 0.0f);
        }
        const h16x4 n1 = cvt4(Nab), m1 = cvt4(NT);
        const f32x4 N2 = mfma16(m1, n1, z4), M2 = mfma16(n1, m1, z4);
        const h16x4 n2 = cvt4(N2), m2 = cvt4(M2);
        const f32x4 T2 = mfma16(m2, cvt4(T1), T1);
        const f32x4 N4 = mfma16(m2, n2, z4), M4 = mfma16(n2, m2, z4);
        const h16x4 n4 = cvt4(N4), m4 = cvt4(M4);
        const f32x4 T4 = mfma16(m4, cvt4(T2), T2);
        const f32x4 M8 = mfma16(n4, m4, z4);
        const f32x4 T8 = mfma16(cvt4(M8), cvt4(T4), T4);
        *(h16x8*)(rec + 8192 + lane * 16) = cat8(cvt4(Mbr), cvt4(Mkr));
        *(h16x4*)(rec + 9216 + lane * 8) = cvt4(T8);
        *(h16x4*)(rec + 9728 + lane * 8) = cvt4(Nak);
        *(float*)(rec + 10240 + lane * 4) = sigma;
        __builtin_amdgcn_wave_barrier();
    }
}

constexpr int SLOT_BYTES = REC_BYTES + 2048;
__device__ __forceinline__ void scan_item(const Params& p, char* smem, int item) {
    char* ws = p.ws;
    const int tid = threadIdx.x, lane = tid & 63;
    const int wave = __builtin_amdgcn_readfirstlane(tid >> 6);
    const int il = lane & 15, g = lane >> 4;
    const int dir = item & 1, h = (item >> 1) & 15, b = item >> 5;
    const char* rec0 = ws + (dir ? OFF_FRAG1 : OFF_FRAG0) + ((size_t)((b * 16 + h) * NCHUNK)) * REC_BYTES;
    const h16* SV = (const h16*)(ws + OFF_SV);
    h16* Y = (h16*)(ws + (dir ? OFF_Y1 : OFF_Y0));
    const f32x4 z4 = {0.f, 0.f, 0.f, 0.f};
    f32x4 P[4];
#pragma unroll
    for (int jt = 0; jt < 4; ++jt) P[jt] = z4;
    u32x4 lr[11], lv[2];
    auto issue = [&](int c) {
        const char* rec = rec0 + (size_t)c * REC_BYTES;
#pragma unroll
        for (int m = 0; m < 10; ++m) lr[m] = *(const u32x4*)(rec + m * 1024 + lane * 16);
        lr[10] = *(const u32x4*)(rec + 10240 + (lane & 15) * 16);
        const int s = srow_of(dir, 16 * c + (lane >> 2));
        const h16* vp = SV + ((size_t)(b * SALL + s)) * DA + h * 64 + (lane & 3) * 16;
        lv[0] = *(const u32x4*)vp; lv[1] = *(const u32x4*)(vp + 8);
    };
    auto writeslot = [&](int c) {
        char* sl = smem + (c & 3) * SLOT_BYTES;
#pragma unroll
        for (int m = 0; m < 10; ++m) *(u32x4*)(sl + m * 1024 + lane * 16) = lr[m];
        if (lane < 16) *(u32x4*)(sl + 10240 + lane * 16) = lr[10];
        *(u32x4*)(sl + REC_BYTES + (lane >> 2) * 128 + (lane & 3) * 32) = lv[0];
        *(u32x4*)(sl + REC_BYTES + (lane >> 2) * 128 + (lane & 3) * 32 + 16) = lv[1];
    };
    __syncthreads();
    if (wave >= 4) issue(wave - 4);
#pragma unroll 1
    for (int n = 0; n <= NCHUNK; ++n) {
        if (wave >= 4) {
            if (n < NCHUNK && (n & 3) == wave - 4) { writeslot(n); if (n + 4 < NCHUNK) issue(n + 4); }
        } else if (n >= 1) {
            const int c = n - 1;
            const char* sl = smem + (c & 3) * SLOT_BYTES;
            h16x8 a1[2], a3r[2], a4[4];
#pragma unroll
            for (int ks = 0; ks < 2; ++ks) { a1[ks] = *(const h16x8*)(sl + ks * 1024 + lane * 16); a3r[ks] = *(const h16x8*)(sl + 2048 + ks * 1024 + lane * 16); }
#pragma unroll
            for (int jt = 0; jt < 4; ++jt) a4[jt] = *(const h16x8*)(sl + 4096 + jt * 1024 + lane * 16);
            const h16x8 a3m = *(const h16x8*)(sl + 8192 + lane * 16);
            const h16x4 a2 = *(const h16x4*)(sl + 9216 + lane * 8);
            const h16x4 a1v = *(const h16x4*)(sl + 9728 + lane * 8);
            f32x4 sg[4];
#pragma unroll
            for (int jt = 0; jt < 4; ++jt) sg[jt] = *(const f32x4*)(sl + 10240 + (16 * jt + 4 * g) * 4);
            const h16* Vl = (const h16*)(sl + REC_BYTES);
            const h16x4 zh = {0, 0, 0, 0};
            const h16x8 A1V = cat8(zh, a1v);
            const bool lat = (c >= CTXL / 16);
            {
                const int it = wave;
                h16x4 vq;
#pragma unroll
                for (int e = 0; e < 4; ++e) vq[e] = Vl[(4 * g + e) * 64 + 16 * it + il];
                const h16x8 bp0 = cat8(cvt4(P[0]), cvt4(P[1])), bp1 = cat8(cvt4(P[2]), cvt4(P[3]));
                f32x4 G = mfma32(A1V, cat8(zh, vq), z4);
                G = mfma32(a1[0], bp0, G); G = mfma32(a1[1], bp1, G);
                const f32x4 U = mfma16(a2, cvt4(G), z4);
                const h16x8 buv = cat8(cvt4(U), vq);
                if (lat) {
                    f32x4 Yv = mfma32(a3r[0], bp0, z4); Yv = mfma32(a3r[1], bp1, Yv); Yv = mfma32(a3m, buv, Yv);
#pragma unroll
                    for (int e = 0; e < 4; ++e) {
                        const int s = srow_of(dir, 16 * c + 4 * g + e);
                        Y[((size_t)(b * SEQ + s - CTXL)) * DA + h * 64 + 16 * it + il] = (h16)Yv[e];
                    }
                }
#pragma unroll
                for (int jt = 0; jt < 4; ++jt) P[jt] = mfma32(a4[jt], buv, P[jt]) * sg[jt];
            }
        }
        __syncthreads();
    }
}

__device__ __forceinline__ void attn_item(const Params& p, char* smem, int item) {
    char* ws = p.ws;
    const int tid = threadIdx.x, lane = tid & 63, wave = tid >> 6;
    const int fr = lane & 15, fq = lane >> 4;
    const int pair = item >> 6, j = item & 63;
    const int b = pair >> 1, kvh = pair & 1, hq = kvh * 4 + (j >> 4), qt = j & 15;
    const h16* Qp = (const h16*)(ws + OFF_Q) + (((size_t)(b * 8 + hq) * SEQ) + qt * 128 + wave * 16) * 128;
    const h16* Kp = (const h16*)(ws + OFF_KB) + ((size_t)(b * 2 + kvh) * SALL) * 128;
    const h16* Vp = (const h16*)(ws + OFF_VT) + ((size_t)(b * 2 + kvh) * 128) * SALL;
    h16x8 qf[4];
#pragma unroll
    for (int ds = 0; ds < 4; ++ds) qf[ds] = *(const h16x8*)(Qp + (size_t)fr * 128 + 32 * ds + 8 * fq);
    const f32x4 zero4 = {0.f, 0.f, 0.f, 0.f};
    f32x4 o[8];
#pragma unroll
    for (int dt = 0; dt < 8; ++dt) o[dt] = zero4;
    float mrun = -1e30f, lrun = 0.f;
    int ksrc[2], vsrc[2];
#pragma unroll
    for (int i = 0; i < 2; ++i) {
        const int krow = 4 * (2 * wave + i) + (lane >> 4);
        ksrc[i] = krow * 128 + (((lane & 15) ^ (krow & 15)) << 3);
        const int vrow = 8 * (2 * wave + i) + (lane >> 3);
        vsrc[i] = vrow * SALL + (((lane & 7) ^ ((vrow >> 1) & 7)) << 3);
    }
    char* ldsK = smem + (2 * wave) * 1024 + lane * 16;
    char* ldsV = smem + 16384 + (2 * wave) * 1024 + lane * 16;
    const int kfo = fr * 256, vfo = fr * 128, vsw = (fr >> 1) & 7;
    const int NKT = SALL / 64;
    WAIT_V(0);
    __syncthreads();
#pragma unroll
    for (int st0 = 0; st0 < 3; ++st0) {
#pragma unroll
        for (int i = 0; i < 2; ++i) { glds16(Kp + (ksrc[i] + st0 * 64 * 128), ldsK + st0 * 32768 + i * 1024); glds16(Vp + (vsrc[i] + st0 * 64), ldsV + st0 * 32768 + i * 1024); }
    }
#define ATT_S(ST, kbuf) { \
        _Pragma("unroll") for (int k4 = 0; k4 < 4; ++k4) _Pragma("unroll") for (int ds = 0; ds < 4; ++ds) { \
            const h16x8 kf = *(const h16x8*)((kbuf) + k4 * 4096 + kfo + (((4 * ds + fq) ^ fr) << 4)); \
            ST[k4] = __builtin_amdgcn_mfma_f32_16x16x32_f16(kf, qf[ds], ds == 0 ? zero4 : ST[k4], 0, 0, 0); } }
#define ATT_SOFTMAX_PV(ST, vbuf) { \
        float mx = fmaxf(fmaxf(fmaxf(ST[0][0], ST[0][1]), fmaxf(ST[0][2], ST[0][3])), fmaxf(fmaxf(ST[1][0], ST[1][1]), fmaxf(ST[1][2], ST[1][3]))); \
        mx = fmaxf(mx, fmaxf(fmaxf(fmaxf(ST[2][0], ST[2][1]), fmaxf(ST[2][2], ST[2][3])), fmaxf(fmaxf(ST[3][0], ST[3][1]), fmaxf(ST[3][2], ST[3][3])))); \
        mx = fmaxf(mx, __shfl_xor(mx, 16)); mx = fmaxf(mx, __shfl_xor(mx, 32)); \
        const float mnew = fmaxf(mrun, mx); \
        const float alpha = __builtin_amdgcn_exp2f(mrun - mnew); \
        mrun = mnew; \
        float ps = 0.f; \
        _Pragma("unroll") for (int k4 = 0; k4 < 4; ++k4) _Pragma("unroll") for (int e = 0; e < 4; ++e) { const float pe = __builtin_amdgcn_exp2f(ST[k4][e] - mnew); ST[k4][e] = pe; ps += pe; } \
        lrun = lrun * alpha + ps; \
        _Pragma("unroll") for (int dt = 0; dt < 8; ++dt) o[dt] = o[dt] * alpha; \
        const h16x8 pf0 = cat8(cvt4(ST[0]), cvt4(ST[1])), pf1 = cat8(cvt4(ST[2]), cvt4(ST[3])); \
        _Pragma("unroll") for (int dt = 0; dt < 8; ++dt) { \
            const h16x8 v0 = *(const h16x8*)((vbuf) + dt * 2048 + vfo + (((0 + fq) ^ vsw) << 4)); \
            const h16x8 v1 = *(const h16x8*)((vbuf) + dt * 2048 + vfo + (((4 + fq) ^ vsw) << 4)); \
            o[dt] = __builtin_amdgcn_mfma_f32_16x16x32_f16(v0, pf0, o[dt], 0, 0, 0); \
            o[dt] = __builtin_amdgcn_mfma_f32_16x16x32_f16(v1, pf1, o[dt], 0, 0, 0); } }
#define ATT_STEP(kt, STC, STN) { \
        if ((kt) + 2 < NKT) { WAIT_V(4); } else { WAIT_V(0); }        \
        __builtin_amdgcn_s_barrier(); \
        if ((kt) + 3 < NKT) { const int so = (((kt) + 3) & 3) * 32768; \
            _Pragma("unroll") for (int i = 0; i < 2; ++i) { glds16(Kp + (ksrc[i] + ((kt) + 3) * 64 * 128), ldsK + so + i * 1024); glds16(Vp + (vsrc[i] + ((kt) + 3) * 64), ldsV + so + i * 1024); } } \
        if ((kt) + 1 < NKT) ATT_S(STN, smem + (((kt) + 1) & 3) * 32768) \
        ATT_SOFTMAX_PV(STC, smem + ((kt) & 3) * 32768 + 16384) }
    f32x4 stA[4], stB[4];
    WAIT_V(8);
    __builtin_amdgcn_s_barrier();
    ATT_S(stA, smem)
#pragma unroll 1
    for (int kt = 0; kt < NKT; kt += 2) {
        ATT_STEP(kt, stA, stB)
        ATT_STEP(kt + 1, stB, stA)
    }
#undef ATT_STEP
#undef ATT_SOFTMAX_PV
#undef ATT_S
    h16* YM = (h16*)(ws + OFF_YMIX);
    float l = lrun;
    l += __shfl_xor(l, 16); l += __shfl_xor(l, 32);
    const float inv = 1.0f / l;
    const int tok = qt * 128 + wave * 16 + fr;
    h16* dst = YM + ((size_t)(b * SEQ + tok)) * D + 1024 + hq * 128;
#pragma unroll
    for (int dt = 0; dt < 8; ++dt) store_h4(dst + 16 * dt + 4 * fq, o[dt] * inv);
}

__device__ __forceinline__ void phase_mix(const Params& p, char* smem, int bid, int nblk, int qoff, int probe_n) {
    unsigned* ctl = (unsigned*)(p.ws + OFF_CTL);
    volatile LAS int* sitem = (volatile LAS int*)(smem + GEMM_LDS + 16);
    for (;;) {
        __syncthreads();
        if (threadIdx.x == 0) *sitem = (int)atomicAdd(&ctl[CW_QUEUE + qoff], 1u);
        __syncthreads();
        const int item = *sitem;
        if (item >= 128) break;
        scan_item(p, smem, item);
    }
    const int x0 = (int)(xb_xcc_id() & 7u);
    for (int q = 0; q < 8; ++q) {
        const int pair = (x0 + q) & 7;
        for (;;) {
            __syncthreads();
            if (threadIdx.x == 0) *sitem = (int)atomicAdd(&ctl[CW_AQ + qoff + 16 * pair], 1u);
            __syncthreads();
            const int jj = *sitem;
            if (jj >= 64) break;
            const int item = pair * 64 + jj;
            if (PROBE_PHASE == 61) { _Pragma("unroll 1") for (int r = 0; r < probe_n; ++r) attn_item(p, smem, item); }
            else attn_item(p, smem, item);
        }
    }
}

__device__ __forceinline__ void phase_finish(const Params& p, int bid, int nblk) {
    char* ws = p.ws;
    const int lane = threadIdx.x & 63, wave = threadIdx.x >> 6;
    const h16* Y0 = (const h16*)(ws + OFF_Y0); const h16* Y1 = (const h16*)(ws + OFF_Y1);
    const h16* SR = (const h16*)(ws + OFF_SR); const h16* SV = (const h16*)(ws + OFF_SV); const h16* SG = (const h16*)(ws + OFF_SG);
    const h16* KD0 = (const h16*)(ws + OFF_SKD0); const h16* KD1 = (const h16*)(ws + OFF_SKD1);
    const h16* SKS = (const h16*)(ws + OFF_SKS); const float* k_a = p.in[17];
    h16* YM = (h16*)(ws + OFF_YMIX);
    const float* r_k = p.in[18]; const float* ln_g = p.in[19]; const float* ln_b = p.in[20];
    const int c0 = (lane >> 2) * 64 + (lane & 3) * 16;
    for (int tl = bid * NW + wave; tl < ROWSL; tl += nblk * NW) {
        const int b = tl >> 11, t = tl & 2047;
        const size_t R = (size_t)b * SALL + CTXL + t;
        float y[16], r[16], kb[16], v[16], g[16];
#pragma unroll
        for (int u = 0; u < 4; ++u) {
            const h16x4 a = *(const h16x4*)(Y0 + (size_t)tl * DA + c0 + 4 * u), bb = *(const h16x4*)(Y1 + (size_t)tl * DA + c0 + 4 * u);
            const h16x4 rr = *(const h16x4*)(SR + R * DA + c0 + 4 * u), vv = *(const h16x4*)(SV + R * DA + c0 + 4 * u), gg = *(const h16x4*)(SG + R * DA + c0 + 4 * u);
            const h16x4 k0 = *(const h16x4*)(KD0 + R * DA + c0 + 4 * u), k1 = *(const h16x4*)(KD1 + R * DA + c0 + 4 * u), ksv = *(const h16x4*)(SKS + R * DA + c0 + 4 * u);
            const f32x4 ka4 = *(const f32x4*)(k_a + c0 + 4 * u);
#pragma unroll
            for (int e = 0; e < 4; ++e) { y[4 * u + e] = (float)a[e] + (float)bb[e]; r[4 * u + e] = (float)rr[e]; v[4 * u + e] = (float)vv[e]; g[4 * u + e] = (float)gg[e]; kb[4 * u + e] = (float)ksv[e] * (2.0f + ((float)k0[e] + (float)k1[e] - 2.0f) * ka4[e]); }
        }
        float sm = 0.f, bo = 0.f;
#pragma unroll
        for (int j = 0; j < 16; ++j) { sm += y[j]; bo += r[j] * kb[j] * r_k[c0 + j]; }
        sm += __shfl_xor(sm, 1); sm += __shfl_xor(sm, 2);
        bo += __shfl_xor(bo, 1); bo += __shfl_xor(bo, 2);
        const float mu = sm * (1.0f / 64.0f);
        float vs = 0.f;
#pragma unroll
        for (int j = 0; j < 16; ++j) { const float d = y[j] - mu; vs += d * d; }
        vs += __shfl_xor(vs, 1); vs += __shfl_xor(vs, 2);
        const float rstd = rsqrtf(vs * (1.0f / 64.0f) + 64e-5f);
#pragma unroll
        for (int u = 0; u < 4; ++u) {
            f32x4 ov;
#pragma unroll
            for (int e = 0; e < 4; ++e) { const int j = 4 * u + e; const float yn = (y[j] - mu) * rstd * ln_g[c0 + j] + ln_b[c0 + j]; ov[e] = (yn + bo * v[j]) * g[j]; }
            store_h4(YM + (size_t)tl * D + c0 + 4 * u, ov);
        }
    }
}

__device__ __forceinline__ void phase_gemm_res(const Params& p, char* smem, int bid, int nblk, const h16* A, const h16* Bt, const float* base, int layer) {
    const int MT = ROWSL / 256, NTl = D / 256;
    h16* XH = (h16*)(p.ws + OFF_XH);
    auto sched = [&](int i, g8::Unit& u) {
        const int t = bid + i * nblk;
        if (t >= MT * NTl) return false;
        int tm, tn; tile_order(t, MT, NTl, tm, tn);
        u.a = A + (size_t)(tm * 256) * D; u.b = Bt + (size_t)(tn * 256) * D; u.u0 = tm; u.u1 = tn; u.u2 = 0; u.u3 = 0;
        return true;
    };
    gemm_phase8(smem, D, D, D, sched, [&](const g8::Unit& u, const f32x4 (&acc)[2][2][4][2], int wr, int wc, int fr, int fq) {
        const int tm = u.u0, tn = u.u1;
        const int b = (tm * 256) >> 11;
        const float* gt = modv(p, layer, b, 2);
        acc8_foreach(acc, wr, wc, fr, fq, [&](int r, int c, f32x4 v) {
            const size_t o = (size_t)(tm * 256 + r) * D + tn * 256 + c;
            f32x4 x;
            if (layer == 0) x = *(const f32x4*)(base + o);
            else { const h16x4 xh = *(const h16x4*)(XH + o); x = (f32x4){(float)xh[0], (float)xh[1], (float)xh[2], (float)xh[3]}; }
            const f32x4 g = *(const f32x4*)(gt + tn * 256 + c);
            store_h4(XH + o, x + g * v);
        });
    });
}

__device__ __forceinline__ void phase_route(const Params& p, char* smem, int bid, int nblk, int layer, int slot) {
    char* ws = p.ws;
    const int lane = threadIdx.x & 63, wave = threadIdx.x >> 6;
    const int fr = lane & 15, g = lane >> 4;
    h16* TOK = (h16*)(ws + OFF_H);
    unsigned* cnt = (unsigned*)(ws + OFF_CTL) + CW_CNT + slot * 1024;
    int* LIST = (int*)(ws + OFF_LIST) + (size_t)slot * 16 * 8192;
    float* GW = (float*)(ws + OFF_GW) + (size_t)slot * 16384;
    const int vb = wave >> 2, w4 = wave & 3;
    const int kq = w4 * 512 + 8 * g;
    const float* gn = p.in[7] + layer * D + kq;
    const float* rb = p.in[26];
    const h16* RWH = (const h16*)(ws + OFF_RWH) + fr * 2048 + kq;
    const h16* RWL = (const h16*)(ws + OFF_RWL) + fr * 2048 + kq;
    float* red = (float*)smem + vb * (4 * 64 * 8 + 64);
    float* ssp = red + 4 * 64 * 8;
    for (int u0 = bid * 2; u0 < ROWSL / 16; u0 += nblk * 2) {
        const int unit = u0 + vb;
        const int tl = unit * 16 + fr;
        const int b = tl >> 11;
        const h16* xr = (const h16*)(p.ws + OFF_XH) + (size_t)tl * D + kq;
        const float* sh = modv(p, layer, b, 3) + kq; const float* sc = modv(p, layer, b, 4) + kq;
        float ss = 0.f;
#pragma unroll
        for (int i = 0; i < 16; ++i) {
            const h16x8 a = *(const h16x8*)(xr + 32 * i);
#pragma unroll
            for (int e = 0; e < 8; ++e) { const float f = (float)a[e]; ss += f * f; }
        }
        ss += __shfl_xor(ss, 16); ss += __shfl_xor(ss, 32);
        __syncthreads();
        if (g == 0) ssp[w4 * 16 + fr] = ss;
        __syncthreads();
        const float tot = ssp[fr] + ssp[16 + fr] + ssp[32 + fr] + ssp[48 + fr];
        const float rstd = rsqrtf(tot * (1.0f / D) + 1e-6f);
        f32x4 am = {0.f, 0.f, 0.f, 0.f}, ac = {0.f, 0.f, 0.f, 0.f};
        h16* trow = TOK + (size_t)tl * D + kq;
        h16x8 px[3]; f32x4 pg[3][2], pc[3][2], ph[3][2]; h16x8 pwh[3], pwl[3];
#define ROUTE_LOAD(slot, it) { const int k_ = 32 * (it); px[slot] = *(const h16x8*)(xr + k_); \
            pg[slot][0] = *(const f32x4*)(gn + k_); pg[slot][1] = *(const f32x4*)(gn + k_ + 4); \
            pc[slot][0] = *(const f32x4*)(sc + k_); pc[slot][1] = *(const f32x4*)(sc + k_ + 4); ph[slot][0] = *(const f32x4*)(sh + k_); ph[slot][1] = *(const f32x4*)(sh + k_ + 4); \
            pwh[slot] = *(const h16x8*)(RWH + k_); pwl[slot] = *(const h16x8*)(RWL + k_); }
        ROUTE_LOAD(0, 0) ROUTE_LOAD(1, 1)
#pragma unroll
        for (int i = 0; i < 16; ++i) {
            if (i + 2 < 16) ROUTE_LOAD((i + 2) % 3, i + 2)
            const int cs = i % 3;
            h16x8 yh, yl;
#pragma unroll
            for (int hh = 0; hh < 2; ++hh) {
                const f32x4 xq = {(float)px[cs][4 * hh], (float)px[cs][4 * hh + 1], (float)px[cs][4 * hh + 2], (float)px[cs][4 * hh + 3]};
                const f32x4 y = (xq * rstd) * pg[cs][hh] * (pc[cs][hh] + 1.0f) + ph[cs][hh];
#pragma unroll
                for (int e = 0; e < 4; ++e) { const h16 hv = (h16)y[e]; yh[4 * hh + e] = hv; yl[4 * hh + e] = (h16)((y[e] - (float)hv) * 4096.0f); }
            }
            *(h16x8*)(trow + 32 * i) = yh;
            am = mfma32(pwh[cs], yh, am); ac = mfma32(pwl[cs], yh, ac); ac = mfma32(pwh[cs], yl, ac);
        }
#undef ROUTE_LOAD
        *(f32x4*)(red + (w4 * 64 + lane) * 8) = am; *(f32x4*)(red + (w4 * 64 + lane) * 8 + 4) = ac;
        __syncthreads();
        if (w4 == 0) {
            f32x4 sm = {0.f, 0.f, 0.f, 0.f}, scn = {0.f, 0.f, 0.f, 0.f};
#pragma unroll
            for (int w = 0; w < 4; ++w) { sm += *(const f32x4*)(red + (w * 64 + lane) * 8); scn += *(const f32x4*)(red + (w * 64 + lane) * 8 + 4); }
            float sv[4], sel[4];
#pragma unroll
            for (int e = 0; e < 4; ++e) { sv[e] = sigmoidf_(sm[e] + scn[e] * (1.0f / 4096.0f)); sel[e] = sv[e] + rb[4 * g + e]; }
            float m1 = -1e30f, m2 = -1e30f;
#pragma unroll
            for (int e = 0; e < 4; ++e) { const float v = sel[e]; if (v > m1) { m2 = m1; m1 = v; } else if (v > m2) m2 = v; }
            float bs = m1 + m2; int bg = g;
#pragma unroll
            for (int o = 16; o <= 32; o <<= 1) {
                const float os = __shfl_xor(bs, o); const int og = __shfl_xor(bg, o);
                if (os > bs || (os == bs && og < bg)) { bs = os; bg = og; }
            }
            int e0 = -1, e1 = -1; float w0 = 0.f, w1 = 0.f;
            if (bg == g) {
                int i0 = 0, i1 = 0; float v0 = -1e30f, v1 = -1e30f, s0 = 0.f, s1 = 0.f;
#pragma unroll
                for (int e = 0; e < 4; ++e) { if (sel[e] > v0) { v0 = sel[e]; i0 = e; s0 = sv[e]; } }
#pragma unroll
                for (int e = 0; e < 4; ++e) { if (e != i0 && sel[e] > v1) { v1 = sel[e]; i1 = e; s1 = sv[e]; } }
                const float inv = 1.0f / (s0 + s1);
                e0 = 4 * g + i0; e1 = 4 * g + i1; w0 = s0 * inv; w1 = s1 * inv;
            }
            const unsigned long long lt = (1ull << lane) - 1ull;
            int mycount = 0, rank0 = 0, rank1 = 0;
#pragma unroll
            for (int e = 0; e < 16; ++e) {
                const unsigned long long m0 = __ballot(e0 == e), m1 = __ballot(e1 == e);
                const int c0 = __popcll(m0), c1 = __popcll(m1);
                if (lane == e) mycount = c0 + c1;
                if (e0 == e) rank0 = __popcll(m0 & lt);
                if (e1 == e) rank1 = c0 + __popcll(m1 & lt);
            }
            unsigned base = 0;
            if (lane < 16 && mycount > 0) base = atomicAdd(&cnt[lane * 64], (unsigned)mycount);
            const unsigned b0 = __shfl(base, e0 < 0 ? 0 : e0), b1 = __shfl(base, e1 < 0 ? 0 : e1);
            if (e0 >= 0) {
                LIST[e0 * 8192 + b0 + rank0] = tl * 2;
                GW[tl * 2] = w0;
                LIST[e1 * 8192 + b1 + rank1] = tl * 2 + 1;
                GW[tl * 2 + 1] = w1;
            }
        }
    }
    __syncthreads();
}

__device__ __forceinline__ void phase_moe(const Params& p, char* smem, int layer, int dslot) {
    char* ws = p.ws;
    const int tid = threadIdx.x;
    unsigned* ctl = (unsigned*)(ws + OFF_CTL);
    const unsigned* cntp = ctl + CW_CNT + layer * 1024;
    unsigned* queue = ctl + CW_MQ + layer * 64;
    unsigned* dep = ctl + CW_DEP + dslot * 256;
    const int* LIST = (const int*)(ws + OFF_LIST) + (size_t)layer * 16 * 8192;
    const float* GW = (const float*)(ws + OFF_GW) + (size_t)layer * 16384;
    const h16* TOK = (const h16*)(ws + OFF_H);
    h16* U = (h16*)(ws + OFF_U);
    h16* SLOT = (h16*)(ws + OFF_SLOT);
    volatile LAS int* sitem = (volatile LAS int*)(smem + GEMM_LDS + 16);
    int MT = 0;
    int cn[16];
#pragma unroll
    for (int e = 0; e < 16; ++e) cn[e] = __builtin_amdgcn_readfirstlane((int)cntp[e * 64]);
#pragma unroll
    for (int e = 0; e < 16; ++e) MT += (cn[e] + 255) >> 8;
    const int n1 = MT * 4, n2 = MT * 8;
    (void)queue; (void)sitem;
    const int G = (int)gridDim.x, bidx = (int)blockIdx.x;
    const int r1 = (n1 > G) ? (n1 % G) : 0;
    const int nlight = G - r1;
    const int my2 = (bidx >= r1) ? (n2 - (bidx - r1) + nlight - 1) / nlight : 0;
    auto locate = [&](int m, int& e, int& tm, int& off, int& c) {
        int mb = 0; e = 0; off = 0; c = 0;
        bool found = false;
#pragma unroll
        for (int ee = 0; ee < 16; ++ee) {
            const int cc = cn[ee]; const int mt = (cc + 255) >> 8;
            if (!found) { if (m >= mb + mt) { mb += mt; off += cc; } else { e = ee; c = cc; found = true; } }
        }
        tm = m - mb;
    };
    {
        auto sched = [&](int i, g8::Unit& u) {
            const int item = bidx + i * G;
            if (item >= n1) return false;
            const int m = item >> 2, tn = item & 3;
            int e, tm, off, c; locate(m, e, tm, off, c);
            u.a = nullptr; u.b = (const h16*)(ws + OFF_EXP + layer * EXP_L) + ((size_t)e * 1024 + tn * 256) * 2048;
            u.u0 = e; u.u1 = tm; u.u2 = tn | (m << 8); u.u3 = off; u.u4 = c;
            return true;
        };
        auto rowoff = [&](const g8::Unit& u, int r) {
            const int c = u.u4;
            int idx = u.u1 * 256 + r; idx = idx < c ? idx : c - 1;
            return (unsigned)(LIST[u.u0 * 8192 + idx] >> 1) * (unsigned)(D * 2);
        };
        gemm_phase8g<0>(smem, TOK, 2048, D, sched, rowoff, [&](const g8::Unit& u, const f32x4 (&acc)[2][2][4][2], int wr, int wc, int fr, int fq) {
            const int e = u.u0, tm = u.u1, tn = u.u2 & 255, m = u.u2 >> 8, off = u.u3;
            const int c = u.u4;
#pragma unroll
            for (int ai = 0; ai < 2; ++ai)
#pragma unroll
                for (int mm = 0; mm < 4; ++mm) {
                    const int idx = tm * 256 + 128 * ai + 64 * wr + 16 * mm + fr;
                    if (idx < c) {
#pragma unroll
                        for (int bj = 0; bj < 2; ++bj) {
                            const f32x4 g = acc[ai][bj][mm][0], up = acc[ai][bj][mm][1];
                            f32x4 o;
#pragma unroll
                            for (int q = 0; q < 4; ++q) o[q] = fsilu_(g[q]) * up[q];
                            const int col = 16 * (8 * tn + 4 * bj + wc) + 4 * fq;
                            const h16x4 oh = cvt4(o);
                            __hip_atomic_store((unsigned long long*)(U + (size_t)(off + idx) * DEXP + col), __builtin_bit_cast(unsigned long long, oh), __ATOMIC_RELAXED, __HIP_MEMORY_SCOPE_AGENT);
                        }
                    }
                }
            asm volatile("s_waitcnt vmcnt(0)" ::: "memory");
            if ((threadIdx.x & 63) == 0) __hip_atomic_fetch_add(&dep[m], 1u, __ATOMIC_RELAXED, __HIP_MEMORY_SCOPE_AGENT);
        });
    }
    const int mearly = (n1 > G) ? (G >> 2) : MT;
    const int nearly_all = (mearly * 8 < n2) ? mearly * 8 : n2;
    const int iearly = (bidx >= r1 && nearly_all > bidx - r1) ? (nearly_all - (bidx - r1) + nlight - 1) / nlight : 0;
    auto wait_dep = [&](int m) {
        if ((tid & 63) == 0) {
            unsigned sp = 0;
            while (__hip_atomic_load(&dep[m], __ATOMIC_RELAXED, __HIP_MEMORY_SCOPE_AGENT) < 32u) {
                __builtin_amdgcn_s_sleep(2);
                if (++sp > (1u << 24)) { atomicAdd(&ctl[CW_TMO], 1u); break; }
            }
        }
    };
    auto rowoff2 = [&](const g8::Unit& u, int r) {
        int idx = u.u1 * 256 + r; idx = idx < u.u4 ? idx : u.u4 - 1;
        return (unsigned)(u.u3 + idx) * (unsigned)(DEXP * 2);
    };
    auto epi2 = [&](const g8::Unit& u, const f32x4 (&acc)[2][2][4][2], int wr, int wc, int fr, int fq) {
        const int e = u.u0, tm = u.u1, tn = u.u2, c = u.u4;
        const int* lst = LIST + e * 8192;
#pragma unroll
        for (int ai = 0; ai < 2; ++ai)
#pragma unroll
            for (int mm = 0; mm < 4; ++mm) {
                const int idx = tm * 256 + 128 * ai + 64 * wr + 16 * mm + fr;
                if (idx < c) {
                    const int entry = lst[idx];
                    const float gw = GW[entry];
                    h16* dst = SLOT + (size_t)entry * D + tn * 256 + 32 * wc + 4 * fq;
#pragma unroll
                    for (int bj = 0; bj < 2; ++bj)
#pragma unroll
                        for (int n = 0; n < 2; ++n) store_h4(dst + 128 * bj + 16 * n, acc[ai][bj][mm][n] * gw);
                }
            }
    };
#pragma unroll 1
    for (int pass = 0; pass < 2; ++pass) {
        const int ibeg = pass ? iearly : 0, iend = pass ? my2 : iearly;
        auto sched2 = [&](int i, g8::Unit& u) {
            const int it = ibeg + i;
            if (it >= iend) return false;
            const int item = (bidx - r1) + it * nlight;
            const int m = item >> 3, tn = item & 7;
            int e, tm, off, c; locate(m, e, tm, off, c);
            wait_dep(m);
            u.a = nullptr; u.b = (const h16*)(ws + OFF_EXP + layer * EXP_L + EGU_BYTES) + ((size_t)e * 2048 + tn * 256) * 512;
            u.u0 = e; u.u1 = tm; u.u2 = tn; u.u3 = off; u.u4 = c;
            return true;
        };
        gemm_phase8g<0>(smem, U, 512, DEXP, sched2, rowoff2, epi2);
    }
}

template <bool FINAL>
__device__ __forceinline__ float combine_row(const Params& p, int layer, int tl, f32x4 (&x)[8]) {
    const int lane = threadIdx.x & 63;
    const h16* SLOT = (const h16*)(p.ws + OFF_SLOT);
    const int b = tl >> 11;
    h16* xr = (h16*)(p.ws + OFF_XH) + (size_t)tl * D;
    float* outr = p.out + (size_t)tl * D;
    const float* gt2 = modv(p, layer, b, 5);
    float ss = 0.f;
#pragma unroll
    for (int i = 0; i < 8; ++i) {
        const int k = i * 256 + lane * 4;
        const h16x4 xh = *(const h16x4*)(xr + k);
        const f32x4 xv = {(float)xh[0], (float)xh[1], (float)xh[2], (float)xh[3]}, g = *(const f32x4*)(gt2 + k);
        const h16x4 s0 = *(const h16x4*)(SLOT + (size_t)(2 * tl) * D + k), s1 = *(const h16x4*)(SLOT + (size_t)(2 * tl + 1) * D + k);
        f32x4 f;
#pragma unroll
        for (int e = 0; e < 4; ++e) f[e] = (float)s0[e] + (float)s1[e];
        x[i] = xv + g * f;
        if (FINAL) *(f32x4*)(outr + k) = x[i]; else store_h4(xr + k, x[i]);
        ss += x[i][0] * x[i][0] + x[i][1] * x[i][1] + x[i][2] * x[i][2] + x[i][3] * x[i][3];
    }
    return wave_sum(ss);
}
__device__ __forceinline__ void phase_combine_final(const Params& p, int bid, int nblk, int layer) {
    const int wave = threadIdx.x >> 6;
    for (int tl = bid * NW + wave; tl < ROWSL; tl += nblk * NW) { f32x4 x[8]; (void)combine_row<true>(p, layer, tl, x); }
}
__device__ __forceinline__ void phase_combine_fold(const Params& p, int bid, int nblk) {
    char* ws = p.ws;
    const int lane = threadIdx.x & 63, wave = threadIdx.x >> 6;
    h16* HF = (h16*)(ws + OFF_H);
    float* HNY = (float*)(ws + OFF_HNY);
    const float* gn = p.in[6] + D;
    for (int u = bid * NW + wave; u < NB * 1025; u += nblk * NW) {
        const int b = u / 1025, t = u - b * 1025;
        const float* sh = modv(p, 1, b, 0); const float* sc = modv(p, 1, b, 1);
        f32x4 xa[8];
        const float ssa = combine_row<false>(p, 0, b * SEQ + t, xa);
        const float ra = rsqrtf(ssa * (1.0f / D) + 1e-6f);
        const bool paired = (t >= 1 && t <= 1023);
        f32x4 xb[8]; float rb2 = 0.f;
        if (paired) { const float ssb = combine_row<false>(p, 0, b * SEQ + (SEQ - t), xb); rb2 = rsqrtf(ssb * (1.0f / D) + 1e-6f); }
#pragma unroll
        for (int i = 0; i < 8; ++i) {
            const int k = i * 256 + lane * 4;
            const f32x4 g = *(const f32x4*)(gn + k), c1 = *(const f32x4*)(sc + k), h1 = *(const f32x4*)(sh + k);
            const f32x4 ha = (xa[i] * ra) * g * (c1 + 1.0f) + h1;
            if (paired) {
                const f32x4 hb = (xb[i] * rb2) * g * (c1 + 1.0f) + h1;
                store_h4(HF + (size_t)(b * SEQ + t) * D + k, ha + hb);
                store_h4(HF + (size_t)(b * SEQ + 1024 + t) * D + k, ha - hb);
            } else if (t == 0) {
                store_h4(HF + (size_t)(b * SEQ) * D + k, ha);
                store_h4(HF + (size_t)(b * SEQ + 1024) * D + k, (f32x4){0.f, 0.f, 0.f, 0.f});
            } else {
                *(f32x4*)(HNY + (size_t)b * D + k) = ha;
            }
        }
    }
}

__device__ __forceinline__ void phase_dft_c(const Params& p, char* smem, int bid, int nblk) {
    char* ws = p.ws;
    const h16* DC = (const h16*)(ws + OFF_DC);
    const h16* HF = (const h16*)(ws + OFF_H);
    h16* ZT = (h16*)(ws + OFF_ZT);
    {
        const float* HNY = (const float*)(ws + OFF_HNY);
        float* VNY = (float*)(ws + OFF_VNY);
        for (int i = bid * NT + threadIdx.x; i < NB * D; i += nblk * NT) {
            const int b = i >> 11, gg = (i >> 8) & 7, n = i & 255;
            const float* hr = HNY + (size_t)b * D + gg * 256;
            const h16* dr = DC + (size_t)n * 256;
            float a = 0.f;
#pragma unroll 8
            for (int c = 0; c < 256; ++c) a += hr[c] * (float)dr[c];
            VNY[i] = a * 0.022097086912079608f;
        }
    }
    {
        auto sched = [&](int i, g8::Unit& u) {
            const int t = bid + i * nblk;
            if (t >= 32 * 8) return false;
            const int bg = t >> 3, tn = t & 7;
            const int b = bg >> 3, g = bg & 7;
            u.a = DC + (size_t)((tn < 4) ? 0 : 256) * 256; u.b = HF + (size_t)(b * SEQ + tn * 256) * D + g * 256; u.u0 = b; u.u1 = g; u.u2 = tn; u.u3 = 0;
            return true;
        };
        gemm_phase8(smem, 256, D, 256, sched, [&](const g8::Unit& u, const f32x4 (&acc)[2][2][4][2], int wr, int wc, int fr, int fq) {
            const int b = u.u0, g = u.u1, tn = u.u2;
            acc8_foreach(acc, wr, wc, fr, fq, [&](int r, int c, f32x4 v) { store_h4(ZT + ((size_t)(b * 2048 + g * 256 + r)) * 2048 + tn * 256 + c, v); });
        });
    }
}
__device__ __forceinline__ void phase_dft_t(const Params& p, char* smem, int bid, int nblk) {
    char* ws = p.ws;
    const h16* DT = (const h16*)(ws + OFF_DT);
    const h16* ZT = (const h16*)(ws + OFF_ZT);
    const float* VNY = (const float*)(ws + OFF_VNY);
    h16* FB = (h16*)(ws + OFF_YMIX);
    auto sched = [&](int i, g8::Unit& u) {
        const int t = bid + i * nblk;
        if (t >= 4 * 64) return false;
        const int b = t >> 6, r8 = t & 63;
        int tm, tn; tile_order(r8, 8, 8, tm, tn);
        u.a = DT + (size_t)(tm * 256) * 2048; u.b = ZT + ((size_t)(b * 2048 + tn * 256)) * 2048; u.u0 = b; u.u1 = tm; u.u2 = tn; u.u3 = 0;
        return true;
    };
    gemm_phase8(smem, 2048, 2048, 2048, sched, [&](const g8::Unit& u, const f32x4 (&acc)[2][2][4][2], int wr, int wc, int fr, int fq) {
        const int b = u.u0, tm = u.u1, tn = u.u2;
        acc8_foreach(acc, wr, wc, fr, fq, [&](int r, int c, f32x4 v) {
            const f32x4 ny = *(const f32x4*)(VNY + (size_t)b * D + tn * 256 + c);
            const float sg = (r & 1) ? -1.0f : 1.0f;
            store_h4(FB + (size_t)(b * SEQ + tm * 256 + r) * D + tn * 256 + c, v + ny * sg);
        });
    });
}

__global__ void __launch_bounds__(NT, 2) mk_forward(Params p, int ph_lo, int ph_hi, int probe_k, int probe_n) {
    __shared__ __attribute__((aligned(16))) char smem[GEMM_LDS + 64];
    const int bid = blockIdx.x, nblk = gridDim.x;
    volatile LAS unsigned* bst = (volatile LAS unsigned*)(smem + GEMM_LDS);
    XcdBarrier xb;
    const bool need_bar = (ph_hi - ph_lo) > 1;
    if (need_bar) {
        if (threadIdx.x == 0) { bst[0] = 0u; bst[1] = 0u; }
        __syncthreads();
        xb = xcd_barrier_post((unsigned*)(p.ws + OFF_CTL), bst);
    }
#define PHASE(k, call) if (ph_lo <= (k) && (k) < ph_hi) { \
        if ((k) == PROBE_PHASE) { _Pragma("unroll 1") for (int rep = 0; rep < probe_n; ++rep) { call; if (rep + 1 < probe_n) xcd_barrier(xb); } } \
        else { const int rep = 0; (void)rep; call; } \
        if ((k) + 1 < ph_hi) xcd_barrier(xb); }
    PHASE(0, phase_prologue(p, smem, bid, nblk))
    PHASE(1, phase_norm0(p, bid, nblk))
    PHASE(2, phase_gemm_in(p, smem, bid, nblk))
    PHASE(3, phase_prep(p, bid, nblk))
    PHASE(4, phase_lora(p, smem, bid, nblk))
    PHASE(5, phase_chunkprep(p, smem, bid, nblk))
    PHASE(6, phase_mix(p, smem, bid, nblk, rep * 128, probe_n))
    PHASE(7, { phase_finish(p, bid, nblk); phase_conv_experts(p, smem, bid, nblk, 1); })
    PHASE(8, phase_gemm_res(p, smem, bid, nblk, (const h16*)(p.ws + OFF_YMIX), (const h16*)(p.ws + OFF_WOUT), p.in[0], 0))
    PHASE(9, phase_route(p, smem, bid, nblk, 0, 0 + 2 * rep))
    PHASE(10, phase_moe(p, smem, 0, 0 + 2 * rep))
    PHASE(11, phase_combine_fold(p, bid, nblk))
    PHASE(12, phase_dft_c(p, smem, bid, nblk))
    PHASE(13, phase_dft_t(p, smem, bid, nblk))
    PHASE(14, phase_gemm_res(p, smem, bid, nblk, (const h16*)(p.ws + OFF_YMIX), (const h16*)(p.ws + OFF_FW), p.out, 1))
    PHASE(15, phase_route(p, smem, bid, nblk, 1, 1 + 2 * rep))
    PHASE(16, phase_moe(p, smem, 1, 1 + 2 * rep))
    PHASE(17, phase_combine_final(p, bid, nblk, 1))
#undef PHASE
}

extern "C" void kernel_launch(void* const* d_in, const int* in_sizes, int n_in, void* d_out, int out_size, void* d_ws, size_t ws_size, hipStream_t stream) {
    static int grid = 0;
    if (grid == 0) {
        if (n_in != 30 || ws_size < WS_END) { fprintf(stderr, "kernel_launch: need 30 inputs and %zu bytes of workspace (got %d, %zu)\n", (size_t)WS_END, n_in, ws_size); grid = -1; return; }
        int dev = 0, cus = 0, per_cu = 0;
        hipGetDevice(&dev);
        hipDeviceGetAttribute(&cus, hipDeviceAttributeMultiprocessorCount, dev);
        hipOccupancyMaxActiveBlocksPerMultiprocessor(&per_cu, (const void*)mk_forward, NT, 0);
        if (per_cu < 1) { fprintf(stderr, "kernel_launch: occupancy query returned %d\n", per_cu); grid = -1; return; }
        if (per_cu > 1) per_cu = 1;
        grid = cus * per_cu;
    }
    if (grid < 0) return;
    hipMemsetAsync((char*)d_ws + OFF_CTL, 0, CTL_BYTES, stream);
    Params p{};
    for (int i = 0; i < 30; ++i) p.in[i] = (const float*)d_in[i];
    p.out = (float*)d_out; p.ws = (char*)d_ws;
#if MULTI_LAUNCH
    for (int ph = 0; ph < NPHASE; ++ph) hipLaunchKernelGGL(mk_forward, dim3(grid), dim3(NT), 0, stream, p, ph, ph + 1, -1, 1);
#else
    int lo = 0, hi = NPHASE, pk = PROBE_PHASE, pn = 2;
    void* args[] = {&p, &lo, &hi, &pk, &pn};
    hipError_t e = hipLaunchCooperativeKernel((const void*)mk_forward, dim3(grid), dim3(NT), args, 0, stream);
    if (e != hipSuccess) fprintf(stderr, "cooperative launch failed: %s (grid %d)\n", hipGetErrorString(e), grid);
#endif
}
```

```cpp
#include <hip/hip_runtime.h>
#include <cstdio>
#include <cstdint>

#ifndef PROBE_PHASE
#define PROBE_PHASE -1
#endif
#ifndef MULTI_LAUNCH
#define MULTI_LAUNCH 0
#endif

typedef _Float16 h16;
typedef _Float16 h16x2 __attribute__((ext_vector_type(2)));
typedef _Float16 h16x4 __attribute__((ext_vector_type(4)));
typedef _Float16 h16x8 __attribute__((ext_vector_type(8)));
typedef float f32x4 __attribute__((ext_vector_type(4)));
typedef unsigned u32x4 __attribute__((ext_vector_type(4)));
#define LAS __attribute__((address_space(3)))

constexpr int D = 2048, NB = 4, SEQ = 2048, CTXL = 256, SALL = SEQ + CTXL;
constexpr int ROWS0 = NB * SALL;
constexpr int ROWSL = NB * SEQ;
constexpr int DA = 1024, HA = 16;
constexpr int A_COLS = 3328, IN_COLS = 4864;
constexpr int NEXP = 16, DEXP = 512;
constexpr int NT = 512;
constexpr int NW = NT / 64;
constexpr int NPHASE = 18;

constexpr size_t OFF_CTL   = 0;
constexpr size_t CTL_BYTES = 65536;
constexpr size_t OFF_MODP  = OFF_CTL + CTL_BYTES;
constexpr size_t OFF_MOD   = OFF_MODP + (size_t)16 * 2 * 5 * 12288 * 4;
constexpr size_t OFF_ROPE  = OFF_MOD + (size_t)2 * 5 * 12288 * 4;
constexpr size_t OFF_WIN   = OFF_ROPE + (size_t)2048 * 64 * 2 * 4;
constexpr size_t OFF_WOUT  = OFF_WIN + (size_t)IN_COLS * D * 2;
constexpr size_t OFF_FW    = OFF_WOUT + (size_t)D * D * 2;
constexpr size_t OFF_W2T   = OFF_FW + (size_t)D * D * 2;
constexpr size_t OFF_A2T   = OFF_W2T + (size_t)2048 * 64 * 2;
constexpr size_t OFF_G2T   = OFF_A2T + (size_t)2048 * 64 * 2;
constexpr size_t OFF_EXP   = OFF_G2T + (size_t)1024 * 128 * 2;
constexpr size_t EGU_BYTES = (size_t)16 * 1024 * 2048 * 2;
constexpr size_t ED_BYTES  = (size_t)16 * 2048 * 512 * 2;
constexpr size_t EXP_L     = EGU_BYTES + ED_BYTES;
constexpr size_t OFF_DT    = OFF_EXP + 2 * EXP_L;
constexpr size_t OFF_DC    = OFF_DT + (size_t)2048 * 4096 * 2;
constexpr size_t OFF_RWH   = OFF_DC + (size_t)512 * 256 * 2;
constexpr size_t OFF_RWL   = OFF_RWH + (size_t)16 * 2048 * 2;
constexpr size_t OFF_H     = OFF_RWL + (size_t)16 * 2048 * 2;
constexpr size_t OFF_P     = OFF_H + (size_t)ROWS0 * D * 2;
constexpr size_t P_BYTES   = (size_t)ROWS0 * IN_COLS * 2;
constexpr size_t OFF_SLOT  = OFF_P;
constexpr size_t OFF_U     = OFF_P + (size_t)16384 * 2048 * 2;
constexpr size_t OFF_STR   = OFF_P + P_BYTES;
constexpr size_t STR16     = (size_t)ROWS0 * DA * 2;
constexpr size_t STR32     = (size_t)ROWS0 * DA * 4;
constexpr size_t OFF_SR    = OFF_STR;
constexpr size_t OFF_SV    = OFF_SR + STR16;
constexpr size_t OFF_SKS   = OFF_SV + STR16;
constexpr size_t OFF_SKK   = OFF_SKS + STR16;
constexpr size_t OFF_SG    = OFF_SKK + STR16;
constexpr size_t OFF_SKD0  = OFF_SG + STR16;
constexpr size_t OFF_SKD1  = OFF_SKD0 + STR16;
constexpr size_t OFF_SB0   = OFF_SKD1 + STR16;
constexpr size_t OFF_SB1   = OFF_SB0 + STR16;
constexpr size_t OFF_SW0   = OFF_SB1 + STR16;
constexpr size_t OFF_SW1   = OFF_SW0 + STR32;
constexpr size_t STR_END   = OFF_SW1 + STR32;
constexpr size_t OFF_Y0    = OFF_SW0;
constexpr size_t OFF_Y1    = OFF_SW0 + (size_t)ROWSL * DA * 4;
static_assert(OFF_Y1 + (size_t)ROWSL * DA * 4 <= STR_END, "y must fit in the decay streams");
constexpr int NCHUNK = SALL / 16;
constexpr int REC_BYTES = 10496;
constexpr size_t FRAG_DIR_BYTES = (size_t)64 * NCHUNK * REC_BYTES;
constexpr size_t OFF_FRAG0 = OFF_H;
constexpr size_t OFF_FRAG1 = OFF_EXP + EXP_L;
static_assert(OFF_FRAG0 + FRAG_DIR_BYTES <= OFF_STR, "frag0 must fit in h|p");
static_assert(FRAG_DIR_BYTES <= EXP_L, "frag1 must fit in the layer-1 expert region");
constexpr size_t OFF_ZT    = OFF_STR;
constexpr size_t OFF_F     = STR_END;
constexpr size_t OFF_Q     = OFF_F + (size_t)ROWS0 * 256 * 2;
constexpr size_t OFF_KB    = OFF_Q + (size_t)NB * 8 * SEQ * 128 * 2;
constexpr size_t OFF_VT    = OFF_KB + (size_t)NB * 2 * SALL * 128 * 2;
constexpr size_t OFF_YMIX  = OFF_VT + (size_t)NB * 2 * 128 * SALL * 2;
constexpr size_t OFF_LIST  = OFF_YMIX + (size_t)ROWSL * D * 2;
constexpr int NLIST = (PROBE_PHASE == 9 || PROBE_PHASE == 15) ? 4 : 2;
constexpr size_t OFF_GW    = OFF_LIST + (size_t)NLIST * 16 * 8192 * 4;
constexpr size_t OFF_HNY   = OFF_GW + (size_t)NLIST * 16384 * 4;
constexpr size_t OFF_VNY   = OFF_HNY + (size_t)NB * D * 4;
constexpr size_t OFF_XH    = OFF_VNY + (size_t)NB * D * 4;
constexpr size_t OFF_VB    = OFF_XH + (size_t)ROWSL * D * 2;
constexpr size_t WS_END    = OFF_VB + (size_t)NB * 2 * SALL * 128 * 2;
static_assert(WS_END <= (size_t)754818112, "workspace budget (sum of the inputs)");
static_assert(OFF_U + (size_t)16384 * 512 * 2 <= OFF_P + P_BYTES, "slot+u must fit in p");
static_assert((size_t)NB * 2048 * 2048 * 2 <= STR_END - OFF_STR, "zt must fit in streams");

constexpr int CW_QUEUE = 4000;
constexpr int CW_AQ    = 10000;
constexpr int CW_MQ    = 8192;
constexpr int CW_DEP   = 8448;
constexpr int CW_TMO   = 9600;
constexpr int CW_CNT   = 4096;

struct Params { const float* in[30]; float* out; char* ws; };

__device__ __forceinline__ float row16_sum(float v) {
    v += __int_as_float(__builtin_amdgcn_update_dpp(0, __float_as_int(v), 0xB1, 0xF, 0xF, true));
    v += __int_as_float(__builtin_amdgcn_update_dpp(0, __float_as_int(v), 0x4E, 0xF, 0xF, true));
    v += __int_as_float(__builtin_amdgcn_update_dpp(0, __float_as_int(v), 0x124, 0xF, 0xF, true));
    v += __int_as_float(__builtin_amdgcn_update_dpp(0, __float_as_int(v), 0x128, 0xF, 0xF, true));
    return v;
}
__device__ __forceinline__ float wave_sum(float v) {
    v = row16_sum(v);
    const int i = __float_as_int(v);
    return (__int_as_float(__builtin_amdgcn_readlane(i, 0)) + __int_as_float(__builtin_amdgcn_readlane(i, 16))) +
           (__int_as_float(__builtin_amdgcn_readlane(i, 32)) + __int_as_float(__builtin_amdgcn_readlane(i, 48)));
}
__device__ __forceinline__ float sigmoidf_(float x) { return 1.0f / (1.0f + expf(-x)); }
__device__ __forceinline__ float siluf_(float x) { return x / (1.0f + expf(-x)); }
__device__ __forceinline__ float fexp_(float x) { return __builtin_amdgcn_exp2f(x * 1.4426950408889634f); }
__device__ __forceinline__ float fsigmoid_(float x) { return __builtin_amdgcn_rcpf(1.0f + fexp_(-x)); }
__device__ __forceinline__ float fsilu_(float x) { return x * fsigmoid_(x); }
__device__ __forceinline__ float ftanh_(float x) { return 1.0f - 2.0f * __builtin_amdgcn_rcpf(1.0f + fexp_(2.0f * x)); }
__device__ __forceinline__ float dpp_xor1(float x) { return __int_as_float(__builtin_amdgcn_update_dpp(0, __float_as_int(x), 0xB1, 0xF, 0xF, true)); }
__device__ __forceinline__ float dpp_xor2(float x) { return __int_as_float(__builtin_amdgcn_update_dpp(0, __float_as_int(x), 0x4E, 0xF, 0xF, true)); }
__device__ __forceinline__ unsigned pack_h2(float lo, float hi) { h16x2 v = {(h16)lo, (h16)hi}; return __builtin_bit_cast(unsigned, v); }

__device__ __forceinline__ f32x4 mfma32(h16x8 a, h16x8 b, f32x4 c) { return __builtin_amdgcn_mfma_f32_16x16x32_f16(a, b, c, 0, 0, 0); }
__device__ __forceinline__ f32x4 mfma16(h16x4 a, h16x4 b, f32x4 c) { return __builtin_amdgcn_mfma_f32_16x16x16f16(a, b, c, 0, 0, 0); }
__device__ __forceinline__ h16x4 cvt4(f32x4 v) { h16x4 o = {(h16)v[0], (h16)v[1], (h16)v[2], (h16)v[3]}; return o; }
__device__ __forceinline__ h16x8 cat8(h16x4 lo, h16x4 hi) { h16x8 o = {lo[0], lo[1], lo[2], lo[3], hi[0], hi[1], hi[2], hi[3]}; return o; }

#define XB_TMO      128
#define XB_XCNT(j)  (256  + 64 * (j))
#define XB_XSUB(j)  (1280 + 64 * (j))
#define XB_XGEN(j)  (2304 + 64 * (j))
#define XB_TOP      3328
#define XB_TOPGEN   3392
#define XCD_BAR_WORDS 3456
#define XB_SPIN_CAP (1u << 27)
__device__ __forceinline__ unsigned xb_ld(unsigned* p)              { return __hip_atomic_load(p, __ATOMIC_RELAXED, __HIP_MEMORY_SCOPE_AGENT); }
__device__ __forceinline__ unsigned xb_add(unsigned* p, unsigned v) { return __hip_atomic_fetch_add(p, v, __ATOMIC_RELAXED, __HIP_MEMORY_SCOPE_AGENT); }
__device__ __forceinline__ unsigned xb_xcc_id() { return (unsigned)__builtin_amdgcn_s_getreg((3 << 11) | 20) & 0xFu; }
#define XB_SPIN(cond, bar) do { unsigned _sp = 0; while (cond) { __builtin_amdgcn_s_sleep(1); \
    if ((++_sp & 255u) == 0u) { if (xb_ld(&(bar)[XB_TMO])) break; if (_sp > XB_SPIN_CAP) { atomicAdd(&(bar)[XB_TMO], 1u); break; } } } } while (0)
struct XcdBarrier { unsigned* bar; unsigned x; volatile LAS unsigned* st; };
__device__ __forceinline__ XcdBarrier xcd_barrier_post(unsigned* bar, volatile LAS unsigned* st) {
    XcdBarrier b; b.bar = bar; b.x = xb_xcc_id(); b.st = st;
    if (threadIdx.x == 0) (void)xb_add(&bar[XB_XCNT(b.x)], 1u);
    return b;
}
__device__ __forceinline__ void xcd_barrier_complete(unsigned* bar, unsigned x, unsigned& nloc, unsigned& nx) {
    const unsigned G = gridDim.x * gridDim.y * gridDim.z;
    unsigned sum, cnt, mine, sp = 0u;
    for (;;) {
        sum = 0u; cnt = 0u; mine = 0u;
#pragma unroll
        for (unsigned j = 0; j < 16; ++j) { const unsigned c = xb_ld(&bar[XB_XCNT(j)]); sum += c; cnt += (c > 0u) ? 1u : 0u; mine = (j == x) ? c : mine; }
        if (sum == G) break;
        __builtin_amdgcn_s_sleep(1);
        if ((++sp & 255u) == 0u) { if (xb_ld(&bar[XB_TMO])) break; if (sp > XB_SPIN_CAP) { atomicAdd(&bar[XB_TMO], 1u); break; } }
    }
    nloc = mine > 0u ? mine : 1u; nx = cnt > 0u ? cnt : 1u;
}
__device__ __forceinline__ void xcd_barrier(const XcdBarrier& b) {
    asm volatile("s_waitcnt vmcnt(0)" ::: "memory");
    __syncthreads();
    if (threadIdx.x == 0) {
        unsigned* bar = b.bar;
        __builtin_amdgcn_s_waitcnt(0);
        unsigned nloc = b.st[0], nx = b.st[1];
        if (nloc == 0u) { xcd_barrier_complete(bar, b.x, nloc, nx); b.st[0] = nloc; b.st[1] = nx; }
        const unsigned old = xb_add(&bar[XB_XSUB(b.x)], 1u);
        const unsigned gen = old / nloc;
        if (old + 1u == (gen + 1u) * nloc) {
            __builtin_amdgcn_fence(__ATOMIC_RELEASE, "agent");
            asm volatile("s_waitcnt vmcnt(0)" ::: "memory");
            const unsigned og = xb_add(&bar[XB_TOP], 1u);
            const unsigned tg = og / nx;
            if (og + 1u == (tg + 1u) * nx) xb_add(&bar[XB_TOPGEN], 1u);
            else XB_SPIN(xb_ld(&bar[XB_TOPGEN]) == tg, bar);
            __builtin_amdgcn_fence(__ATOMIC_ACQUIRE, "agent");
            xb_add(&bar[XB_XGEN(b.x)], 1u);
            asm volatile("s_waitcnt vmcnt(0)" ::: "memory");
        } else {
            XB_SPIN(xb_ld(&bar[XB_XGEN(b.x)]) == gen, bar);
            __builtin_amdgcn_fence(__ATOMIC_ACQUIRE, "agent");
            asm volatile("s_waitcnt vmcnt(0)" ::: "memory");
        }
    }
    __syncthreads();
}

constexpr int GEMM_STAGE = (256 + 256) * 32 * 2;
constexpr int GEMM_LDS = 4 * GEMM_STAGE;
#define WAIT_V(n) asm volatile("s_waitcnt vmcnt(" #n ")" ::: "memory")
__device__ __forceinline__ void glds16(const h16* g, char* l) {
    __builtin_amdgcn_global_load_lds((const __attribute__((address_space(1))) unsigned*)g, (__attribute__((address_space(3))) unsigned*)l, 16, 0, 0);
}
template <typename ARow, typename BRow>
__device__ __forceinline__ void gemm_tile(char* smem, const ARow& arow, const BRow& brow, int K, f32x4 (&acc)[8][4]) {
    const int tid = threadIdx.x, lane = tid & 63, wave = tid >> 6;
    const int wm = wave >> 2, wn = wave & 3;
    const int fr = lane & 15, fq = lane >> 4;
    const int lrow = lane >> 2;
    const int schunk = (lane & 3) ^ ((0x78 >> (2 * ((lane >> 4) & 3))) & 3);
    const h16* ap[2]; const h16* bp[2];
#pragma unroll
    for (int i = 0; i < 2; ++i) { ap[i] = arow(32 * wave + 16 * i + lrow) + schunk * 8; bp[i] = brow(32 * wave + 16 * i + lrow) + schunk * 8; }
    char* ldsA = smem + (2 * wave) * 1024 + lane * 16;
    char* ldsB = smem + 16384 + (2 * wave) * 1024 + lane * 16;
    const int fsw = (0x78 >> (2 * (fr >> 2))) & 3;
    const int rdA = (128 * wm + fr) * 64 + ((fq ^ fsw) << 4);
    const int rdB = 16384 + (64 * wn + fr) * 64 + ((fq ^ fsw) << 4);
#pragma unroll
    for (int mi = 0; mi < 8; ++mi)
#pragma unroll
        for (int ni = 0; ni < 4; ++ni) acc[mi][ni] = (f32x4){0.f, 0.f, 0.f, 0.f};
    const int nk = K >> 5;
    WAIT_V(0);
    __syncthreads();
#pragma unroll
    for (int st = 0; st < 3; ++st) {
        if (st < nk) {
#pragma unroll
            for (int i = 0; i < 2; ++i) { glds16(ap[i] + st * 32, ldsA + st * GEMM_STAGE + i * 1024); glds16(bp[i] + st * 32, ldsB + st * GEMM_STAGE + i * 1024); }
        }
    }
    int cur = 0, nxt = 3 * GEMM_STAGE;
#pragma unroll 1
    for (int kt = 0; kt < nk; ++kt) {
        const int ahead = nk - 1 - kt;
        if (ahead >= 2) { WAIT_V(8); } else if (ahead == 1) { WAIT_V(4); } else { WAIT_V(0); }
        __builtin_amdgcn_s_barrier();
        const char* As = smem + cur + rdA;
        const char* Bs = smem + cur + rdB;
        h16x8 af[8], bf[4];
#pragma unroll
        for (int ni = 0; ni < 4; ++ni) bf[ni] = *(const h16x8*)(Bs + ni * 1024);
#pragma unroll
        for (int mi = 0; mi < 8; ++mi) af[mi] = *(const h16x8*)(As + mi * 1024);
        __builtin_amdgcn_sched_barrier(0);
        if (kt + 3 < nk) {
            const int ko = (kt + 3) * 32;
#pragma unroll
            for (int i = 0; i < 2; ++i) { glds16(ap[i] + ko, ldsA + nxt + i * 1024); glds16(bp[i] + ko, ldsB + nxt + i * 1024); }
        }
        __builtin_amdgcn_sched_barrier(0);
        __builtin_amdgcn_s_setprio(1);
#pragma unroll
        for (int mi = 0; mi < 8; ++mi)
#pragma unroll
            for (int ni = 0; ni < 4; ++ni)
                acc[mi][ni] = __builtin_amdgcn_mfma_f32_16x16x32_f16(bf[ni], af[mi], acc[mi][ni], 0, 0, 0);
        __builtin_amdgcn_s_setprio(0);
        cur = (cur == 3 * GEMM_STAGE) ? 0 : cur + GEMM_STAGE;
        nxt = (nxt == 3 * GEMM_STAGE) ? 0 : nxt + GEMM_STAGE;
    }
}
template <typename F>
__device__ __forceinline__ void acc_foreach(const f32x4 (&acc)[8][4], F f) {
    const int lane = threadIdx.x & 63, wave = threadIdx.x >> 6;
    const int wm = wave >> 2, wn = wave & 3;
#pragma unroll
    for (int mi = 0; mi < 8; ++mi)
#pragma unroll
        for (int ni = 0; ni < 4; ++ni)
            f(128 * wm + 16 * mi + (lane & 15), 64 * wn + 16 * ni + 4 * (lane >> 4), acc[mi][ni]);
}
__device__ __forceinline__ int perm16(int n) { return (n & ~60) | ((n & 12) << 2) | ((n & 48) >> 2); }
template <typename F>
__device__ __forceinline__ void acc_foreach16(const f32x4 (&acc)[8][4], F f) {
    const int lane = threadIdx.x & 63, wave = threadIdx.x >> 6;
    const int wm = wave >> 2, wn = wave & 3;
#pragma unroll
    for (int mi = 0; mi < 8; ++mi) f(128 * wm + 16 * mi + (lane & 15), 64 * wn + 16 * (lane >> 4), acc[mi]);
}
__device__ __forceinline__ void store_h16(h16* p, const f32x4 (&v)[4]) {
    h16x8 lo = {(h16)v[0][0], (h16)v[0][1], (h16)v[0][2], (h16)v[0][3], (h16)v[1][0], (h16)v[1][1], (h16)v[1][2], (h16)v[1][3]};
    h16x8 hi = {(h16)v[2][0], (h16)v[2][1], (h16)v[2][2], (h16)v[2][3], (h16)v[3][0], (h16)v[3][1], (h16)v[3][2], (h16)v[3][3]};
    *(h16x8*)p = lo; *(h16x8*)(p + 8) = hi;
}
namespace g8 {
constexpr int BK = 64, HALF = 128, HTB = HALF * BK * 2;
__device__ __forceinline__ int lds_byte(int r, int c) { const int st = (r >> 4) * 2 + (c >> 5), rr = r & 15, cc = c & 31, ob = rr * 64 + cc * 2; return st * 1024 + (ob ^ (((ob >> 9) & 1) << 5)); }
__device__ __forceinline__ void stage_rc(int b, int& R, int& C) { const int st = b / 1024, sb = b % 1024, swz = sb ^ (((sb >> 9) & 1) << 5); R = (st >> 1) * 16 + swz / 64; C = (st & 1) * 32 + (swz % 64) / 2; }
struct Unit { const h16* a; const h16* b; int u0, u1, u2, u3, u4; };
}
template <class Sched, class Epi>
__device__ __forceinline__ void gemm_phase8(char* smem, int lda, int ldb, int K, const Sched& S, const Epi& E) {
    using namespace g8;
    LAS unsigned char* lds = (LAS unsigned char*)smem;
    const int tid = threadIdx.x, wid = __builtin_amdgcn_readfirstlane(tid >> 6), lane = tid & 63, wr = wid >> 2, wc = wid & 3, fr = lane & 15, fq = lane >> 4;
    const int nt = K / BK;
    unsigned voffA[2], voffB[2];
#pragma unroll
    for (int i = 0; i < 2; ++i) { int R, C; stage_rc(tid * 16 + i * 8192, R, C); voffA[i] = (unsigned)(R * lda + C) * 2u; voffB[i] = (unsigned)(R * ldb + C) * 2u; }
    const size_t kstep = (size_t)(BK * 2);
    const size_t hstepA = (size_t)HALF * lda * 2, hstepB = (size_t)HALF * ldb * 2;
    const unsigned ldsw = (unsigned)wid * 1024u;
    const int aoff = lds_byte(wr * 64 + fr, fq * 8), boff = lds_byte(wc * 32 + fr, fq * 8);
#define G8_SA(b, h) (((b) * 2 + (h)) * HTB)
#define G8_SB(b, h) ((4 + (b) * 2 + (h)) * HTB)
#define G8_STAGE(bufoff, gbase, voff) do { _Pragma("unroll") for (int _i = 0; _i < 2; ++_i) \
        __builtin_amdgcn_global_load_lds((const __attribute__((address_space(1))) unsigned*)((const char*)(gbase) + (voff)[_i]), (LAS unsigned*)(lds + (bufoff) + ldsw + _i * 8192), 16, 0, 0); } while (0)
#define G8_LDA(dst, b, h) do { _Pragma("unroll") for (int m = 0; m < 4; ++m) _Pragma("unroll") for (int k = 0; k < 2; ++k) dst[m][k] = *(const LAS h16x8*)(lds + G8_SA(b, h) + aoff + m * 2048 + k * 1024); } while (0)
#define G8_LDB(dst, b, h) do { _Pragma("unroll") for (int n = 0; n < 2; ++n) _Pragma("unroll") for (int k = 0; k < 2; ++k) dst[n][k] = *(const LAS h16x8*)(lds + G8_SB(b, h) + boff + n * 2048 + k * 1024); } while (0)
#define G8_MMA(ai, bj, At, Bt) do { __builtin_amdgcn_s_setprio(1); _Pragma("unroll") for (int m = 0; m < 4; ++m) _Pragma("unroll") for (int n = 0; n < 2; ++n) _Pragma("unroll") for (int k = 0; k < 2; ++k) \
        acc[ai][bj][m][n] = __builtin_amdgcn_mfma_f32_16x16x32_f16(Bt[n][k], At[m][k], acc[ai][bj][m][n], 0, 0, 0); __builtin_amdgcn_s_setprio(0); } while (0)
#define G8_WAIT_V(n) asm volatile("s_waitcnt vmcnt(" #n ")" ::: "memory")
#define G8_WAIT_L(n) asm volatile("s_waitcnt lgkmcnt(" #n ")" ::: "memory")
#define G8_BAR __builtin_amdgcn_s_barrier()
#define G8_SCHED __builtin_amdgcn_sched_barrier(0)
    Unit cur, nxt; int ui = 0;
    G8_WAIT_V(0);
    __syncthreads();
    if (!S(0, cur)) return;
    f32x4 acc[2][2][4][2];
#pragma unroll
    for (int a = 0; a < 2; ++a)
#pragma unroll
        for (int b = 0; b < 2; ++b)
#pragma unroll
            for (int m = 0; m < 4; ++m)
#pragma unroll
                for (int n = 0; n < 2; ++n) acc[a][b][m][n] = (f32x4){0.f, 0.f, 0.f, 0.f};
    h16x8 At[4][2], B0[2][2], B1[2][2];
    const char* cA = (const char*)cur.a; const char* cB = (const char*)cur.b;
    G8_STAGE(G8_SB(0, 0), cB, voffB); G8_STAGE(G8_SA(0, 0), cA, voffA); G8_STAGE(G8_SB(0, 1), cB + hstepB, voffB); G8_STAGE(G8_SA(0, 1), cA + hstepA, voffA);
    if (wr == 1) G8_BAR;
    G8_WAIT_V(4); G8_BAR;
    G8_STAGE(G8_SB(1, 0), cB + kstep, voffB); G8_STAGE(G8_SA(1, 0), cA + kstep, voffA); G8_STAGE(G8_SB(1, 1), cB + hstepB + kstep, voffB);
    G8_WAIT_V(6); G8_BAR;
    for (;;) {
        const bool has_next = S(ui + 1, nxt);
        const char* nA = has_next ? (const char*)nxt.a : cA; const char* nB = has_next ? (const char*)nxt.b : cB;
        for (int t = 0; t < nt; t += 2) {
            const bool last = (t == nt - 2);
            const char* a1 = cA + (size_t)(t + 1) * kstep;
            const char* a2 = last ? nA : cA + (size_t)(t + 2) * kstep; const char* b2 = last ? nB : cB + (size_t)(t + 2) * kstep;
            const char* a3 = a2 + kstep; const char* b3 = b2 + kstep;
            G8_LDB(B0, 0, 0); G8_SCHED; G8_LDA(At, 0, 0); G8_STAGE(G8_SA(1, 1), a1 + hstepA, voffA);
            G8_WAIT_L(8); G8_BAR; G8_WAIT_L(0); G8_MMA(0, 0, At, B0); G8_BAR; G8_SCHED;
            G8_LDB(B1, 0, 1); G8_STAGE(G8_SB(0, 0), b2, voffB);
            G8_BAR; G8_WAIT_L(0); G8_MMA(0, 1, At, B1); G8_BAR;
            G8_LDA(At, 0, 1); G8_STAGE(G8_SA(0, 0), a2, voffA);
            G8_BAR; G8_WAIT_L(0); G8_MMA(1, 0, At, B0); G8_BAR; G8_SCHED;
            G8_STAGE(G8_SB(0, 1), b2 + hstepB, voffB);
            G8_WAIT_V(6); G8_BAR; G8_MMA(1, 1, At, B1); G8_BAR;
            G8_LDB(B0, 1, 0); G8_SCHED; G8_LDA(At, 1, 0); G8_STAGE(G8_SA(0, 1), a2 + hstepA, voffA);
            G8_WAIT_L(8); G8_BAR; G8_WAIT_L(0); G8_MMA(0, 0, At, B0); G8_BAR; G8_SCHED;
            G8_LDB(B1, 1, 1); G8_STAGE(G8_SB(1, 0), b3, voffB);
            G8_BAR; G8_WAIT_L(0); G8_MMA(0, 1, At, B1); G8_BAR;
            G8_LDA(At, 1, 1); G8_STAGE(G8_SA(1, 0), a3, voffA);
            G8_BAR; G8_WAIT_L(0); G8_MMA(1, 0, At, B0); G8_BAR; G8_SCHED;
            G8_STAGE(G8_SB(1, 1), b3 + hstepB, voffB);
            G8_WAIT_V(6); G8_BAR; G8_MMA(1, 1, At, B1); G8_BAR;
        }
        E(cur, acc, wr, wc, fr, fq);
        if (!has_next) break;
#pragma unroll
        for (int a = 0; a < 2; ++a)
#pragma unroll
            for (int b = 0; b < 2; ++b)
#pragma unroll
                for (int m = 0; m < 4; ++m)
#pragma unroll
                    for (int n = 0; n < 2; ++n) acc[a][b][m][n] = (f32x4){0.f, 0.f, 0.f, 0.f};
        cur = nxt; cA = nA; cB = nB; ++ui;
    }
    G8_WAIT_V(0);
    if (wr == 0) G8_BAR;
    G8_BAR;
#undef G8_SA
#undef G8_SB
#undef G8_STAGE
#undef G8_LDA
#undef G8_LDB
#undef G8_MMA
#undef G8_WAIT_V
#undef G8_WAIT_L
#undef G8_BAR
#undef G8_SCHED
}
template <int ACPOL, class Sched, class RowOff, class Epi>
__device__ __forceinline__ void gemm_phase8g(char* smem, const h16* baseA_, int ldb, int K, const Sched& S, const RowOff& RO, const Epi& E) {
    using namespace g8;
    LAS unsigned char* lds = (LAS unsigned char*)smem;
    const char* baseA = (const char*)baseA_;
    const int tid = threadIdx.x, wid = __builtin_amdgcn_readfirstlane(tid >> 6), lane = tid & 63, wr = wid >> 2, wc = wid & 3, fr = lane & 15, fq = lane >> 4;
    const int nt = K / BK;
    int Rl[2], Cl[2]; unsigned voffB[2];
#pragma unroll
    for (int i = 0; i < 2; ++i) { stage_rc(tid * 16 + i * 8192, Rl[i], Cl[i]); voffB[i] = (unsigned)(Rl[i] * ldb + Cl[i]) * 2u; }
    const size_t kstep = (size_t)(BK * 2);
    const size_t hstepB = (size_t)HALF * ldb * 2;
    const unsigned ldsw = (unsigned)wid * 1024u;
    const int aoff = lds_byte(wr * 64 + fr, fq * 8), boff = lds_byte(wc * 32 + fr, fq * 8);
#define G8_SA(b, h) (((b) * 2 + (h)) * HTB)
#define G8_SB(b, h) ((4 + (b) * 2 + (h)) * HTB)
#define G8_STAGE(bufoff, gbase, voff) do { _Pragma("unroll") for (int _i = 0; _i < 2; ++_i) \
        __builtin_amdgcn_global_load_lds((const __attribute__((address_space(1))) unsigned*)((const char*)(gbase) + (voff)[_i]), (LAS unsigned*)(lds + (bufoff) + ldsw + _i * 8192), 16, 0, 0); } while (0)
#define G8_STAGEA(bufoff, gbase, voff) do { _Pragma("unroll") for (int _i = 0; _i < 2; ++_i) \
        __builtin_amdgcn_global_load_lds((const __attribute__((address_space(1))) unsigned*)((const char*)(gbase) + (voff)[_i]), (LAS unsigned*)(lds + (bufoff) + ldsw + _i * 8192), 16, 0, ACPOL); } while (0)
#define G8_LDA(dst, b, h) do { _Pragma("unroll") for (int m = 0; m < 4; ++m) _Pragma("unroll") for (int k = 0; k < 2; ++k) dst[m][k] = *(const LAS h16x8*)(lds + G8_SA(b, h) + aoff + m * 2048 + k * 1024); } while (0)
#define G8_LDB(dst, b, h) do { _Pragma("unroll") for (int n = 0; n < 2; ++n) _Pragma("unroll") for (int k = 0; k < 2; ++k) dst[n][k] = *(const LAS h16x8*)(lds + G8_SB(b, h) + boff + n * 2048 + k * 1024); } while (0)
#define G8_MMA(ai, bj, At, Bt) do { __builtin_amdgcn_s_setprio(1); _Pragma("unroll") for (int m = 0; m < 4; ++m) _Pragma("unroll") for (int n = 0; n < 2; ++n) _Pragma("unroll") for (int k = 0; k < 2; ++k) \
        acc[ai][bj][m][n] = __builtin_amdgcn_mfma_f32_16x16x32_f16(Bt[n][k], At[m][k], acc[ai][bj][m][n], 0, 0, 0); __builtin_amdgcn_s_setprio(0); } while (0)
#define G8_WAIT_V(n) asm volatile("s_waitcnt vmcnt(" #n ")" ::: "memory")
#define G8_WAIT_L(n) asm volatile("s_waitcnt lgkmcnt(" #n ")" ::: "memory")
#define G8_BAR __builtin_amdgcn_s_barrier()
#define G8_SCHED __builtin_amdgcn_sched_barrier(0)
    Unit cur, nxt; int ui = 0;
    G8_WAIT_V(0);
    __syncthreads();
    if (!S(0, cur)) return;
    f32x4 acc[2][2][4][2];
#pragma unroll
    for (int a = 0; a < 2; ++a)
#pragma unroll
        for (int b = 0; b < 2; ++b)
#pragma unroll
            for (int m = 0; m < 4; ++m)
#pragma unroll
                for (int n = 0; n < 2; ++n) acc[a][b][m][n] = (f32x4){0.f, 0.f, 0.f, 0.f};
    h16x8 At[4][2], B0[2][2], B1[2][2];
    unsigned oc0[2], oc1[2], on0[2], on1[2];
#pragma unroll
    for (int i = 0; i < 2; ++i) { oc0[i] = RO(cur, Rl[i]) + (unsigned)Cl[i] * 2u; oc1[i] = RO(cur, HALF + Rl[i]) + (unsigned)Cl[i] * 2u; }
    const char* cB = (const char*)cur.b;
    G8_STAGE(G8_SB(0, 0), cB, voffB); G8_STAGEA(G8_SA(0, 0), baseA, oc0); G8_STAGE(G8_SB(0, 1), cB + hstepB, voffB); G8_STAGEA(G8_SA(0, 1), baseA, oc1);
    if (wr == 1) G8_BAR;
    G8_WAIT_V(4); G8_BAR;
    G8_STAGE(G8_SB(1, 0), cB + kstep, voffB); G8_STAGEA(G8_SA(1, 0), baseA + kstep, oc0); G8_STAGE(G8_SB(1, 1), cB + hstepB + kstep, voffB);
    G8_WAIT_V(6); G8_BAR;
    for (;;) {
        const bool has_next = S(ui + 1, nxt);
        const char* nB = has_next ? (const char*)nxt.b : cB;
#pragma unroll
        for (int i = 0; i < 2; ++i) {
            on0[i] = has_next ? RO(nxt, Rl[i]) + (unsigned)Cl[i] * 2u : oc0[i];
            on1[i] = has_next ? RO(nxt, HALF + Rl[i]) + (unsigned)Cl[i] * 2u : oc1[i];
        }
        for (int t = 0; t < nt; t += 2) {
            const bool last = (t == nt - 2);
            const char* a1 = baseA + (size_t)(t + 1) * kstep;
            const char* a2 = last ? baseA : baseA + (size_t)(t + 2) * kstep;
            const char* b2 = last ? nB : cB + (size_t)(t + 2) * kstep;
            const char* a3 = a2 + kstep; const char* b3 = b2 + kstep;
            unsigned o20[2], o21[2];
#pragma unroll
            for (int i = 0; i < 2; ++i) { o20[i] = last ? on0[i] : oc0[i]; o21[i] = last ? on1[i] : oc1[i]; }
            G8_LDB(B0, 0, 0); G8_SCHED; G8_LDA(At, 0, 0); G8_STAGEA(G8_SA(1, 1), a1, oc1);
            G8_WAIT_L(8); G8_BAR; G8_WAIT_L(0); G8_MMA(0, 0, At, B0); G8_BAR; G8_SCHED;
            G8_LDB(B1, 0, 1); G8_STAGE(G8_SB(0, 0), b2, voffB);
            G8_BAR; G8_WAIT_L(0); G8_MMA(0, 1, At, B1); G8_BAR;
            G8_LDA(At, 0, 1); G8_STAGEA(G8_SA(0, 0), a2, o20);
            G8_BAR; G8_WAIT_L(0); G8_MMA(1, 0, At, B0); G8_BAR; G8_SCHED;
            G8_STAGE(G8_SB(0, 1), b2 + hstepB, voffB);
            G8_WAIT_V(6); G8_BAR; G8_MMA(1, 1, At, B1); G8_BAR;
            G8_LDB(B0, 1, 0); G8_SCHED; G8_LDA(At, 1, 0); G8_STAGEA(G8_SA(0, 1), a2, o21);
            G8_WAIT_L(8); G8_BAR; G8_WAIT_L(0); G8_MMA(0, 0, At, B0); G8_BAR; G8_SCHED;
            G8_LDB(B1, 1, 1); G8_STAGE(G8_SB(1, 0), b3, voffB);
            G8_BAR; G8_WAIT_L(0); G8_MMA(0, 1, At, B1); G8_BAR;
            G8_LDA(At, 1, 1); G8_STAGEA(G8_SA(1, 0), a3, o20);
            G8_BAR; G8_WAIT_L(0); G8_MMA(1, 0, At, B0); G8_BAR; G8_SCHED;
            G8_STAGE(G8_SB(1, 1), b3 + hstepB, voffB);
            G8_WAIT_V(6); G8_BAR; G8_MMA(1, 1, At, B1); G8_BAR;
        }
        E(cur, acc, wr, wc, fr, fq);
        if (!has_next) break;
#pragma unroll
        for (int a = 0; a < 2; ++a)
#pragma unroll
            for (int b = 0; b < 2; ++b)
#pragma unroll
                for (int m = 0; m < 4; ++m)
#pragma unroll
                    for (int n = 0; n < 2; ++n) acc[a][b][m][n] = (f32x4){0.f, 0.f, 0.f, 0.f};
        cur = nxt; cB = nB; ++ui;
#pragma unroll
        for (int i = 0; i < 2; ++i) { oc0[i] = on0[i]; oc1[i] = on1[i]; }
    }
    G8_WAIT_V(0);
    if (wr == 0) G8_BAR;
    G8_BAR;
#undef G8_SA
#undef G8_SB
#undef G8_STAGE
#undef G8_STAGEA
#undef G8_LDA
#undef G8_LDB
#undef G8_MMA
#undef G8_WAIT_V
#undef G8_WAIT_L
#undef G8_BAR
#undef G8_SCHED
}
template <typename F>
__device__ __forceinline__ void acc8_foreach(const f32x4 (&acc)[2][2][4][2], int wr, int wc, int fr, int fq, F f) {
#pragma unroll
    for (int ai = 0; ai < 2; ++ai)
#pragma unroll
        for (int m = 0; m < 4; ++m)
#pragma unroll
            for (int bj = 0; bj < 2; ++bj)
#pragma unroll
                for (int n = 0; n < 2; ++n)
                    f(128 * ai + 64 * wr + 16 * m + fr, 128 * bj + 32 * wc + 16 * n + 4 * fq, acc[ai][bj][m][n]);
}
__device__ __forceinline__ void store_h4(h16* p, f32x4 v) { h16x4 o = {(h16)v[0], (h16)v[1], (h16)v[2], (h16)v[3]}; *(h16x4*)p = o; }
__device__ __forceinline__ void tile_order(int t, int MT, int NTl, int& tm, int& tn) {
    const int GM = 8;
    const int per = GM * NTl;
    const int g = t / per, r = t - g * per;
    const int fm = g * GM;
    const int gsz = (MT - fm) < GM ? (MT - fm) : GM;
    tm = fm + (r % gsz); tn = r / gsz;
}

struct ConvDesc { const float* src; h16* dst; int N, ldd, k0, n0, mode; };
constexpr int CONV_T0 = 2432, CONV_T1 = CONV_T0 + 1024, CONV_T2 = CONV_T1 + 1024, CONV_T3 = CONV_T2 + 32, CONV_T4 = CONV_T3 + 32, CONV_T5 = CONV_T4 + 32, CONV_T6 = CONV_T5 + 16 * 768;
__device__ __forceinline__ ConvDesc conv_desc_expert(const Params& p, int l, int u) {
    char* ws = p.ws;
    const int e = u / 768, r = u % 768;
    const int le = l * 16 + e;
    const int which = r >> 8, q = r & 255;
    ConvDesc d;
    if (which < 2) {
        d.src = p.in[27 + which] + (size_t)le * 2048 * 512; d.N = 512; d.k0 = (q >> 3) * 64; d.n0 = (q & 7) * 64;
        d.dst = (h16*)(ws + OFF_EXP + l * EXP_L) + (size_t)e * 1024 * 2048; d.ldd = 2048; d.mode = 1 + which;
    } else {
        d.src = p.in[29] + (size_t)le * 512 * 2048; d.N = 2048; d.k0 = (q >> 5) * 64; d.n0 = (q & 31) * 64;
        d.dst = (h16*)(ws + OFF_EXP + l * EXP_L + EGU_BYTES) + (size_t)e * 2048 * 512; d.ldd = 512; d.mode = 0;
    }
    return d;
}
__device__ __forceinline__ ConvDesc conv_desc_prologue(const Params& p, int t) {
    char* ws = p.ws;
    ConvDesc d; d.mode = 0;
    if (t < CONV_T0) { d.src = p.in[8]; d.N = IN_COLS; d.k0 = (t / 76) * 64; d.n0 = (t % 76) * 64; d.dst = (h16*)(ws + OFF_WIN); d.ldd = D; }
    else if (t < CONV_T1) { const int u = t - CONV_T0; d.src = p.in[23]; d.N = D; d.k0 = (u >> 5) * 64; d.n0 = (u & 31) * 64; d.dst = (h16*)(ws + OFF_WOUT); d.ldd = D; }
    else if (t < CONV_T2) { const int u = t - CONV_T1; d.src = p.in[24]; d.N = D; d.k0 = (u >> 5) * 64; d.n0 = (u & 31) * 64; d.dst = (h16*)(ws + OFF_FW); d.ldd = D; }
    else if (t < CONV_T3) { const int u = t - CONV_T2; const int dd = u >> 4; d.src = p.in[12] + (size_t)dd * 64 * 1024; d.N = 1024; d.k0 = 0; d.n0 = (u & 15) * 64; d.dst = (h16*)(ws + OFF_W2T) + (size_t)dd * 1024 * 64; d.ldd = 64; }
    else if (t < CONV_T4) { const int u = t - CONV_T3; const int dd = u >> 4; d.src = p.in[14] + (size_t)dd * 64 * 1024; d.N = 1024; d.k0 = 0; d.n0 = (u & 15) * 64; d.dst = (h16*)(ws + OFF_A2T) + (size_t)dd * 1024 * 64; d.ldd = 64; }
    else if (t < CONV_T5) { const int u = t - CONV_T4; d.src = p.in[15]; d.N = 1024; d.k0 = (u >> 4) * 64; d.n0 = (u & 15) * 64; d.dst = (h16*)(ws + OFF_G2T); d.ldd = 128; }
    else d = conv_desc_expert(p, 0, t - CONV_T5);
    return d;
}
template <typename DescFn>
__device__ __forceinline__ void conv_run(char* smem, int t_end, DescFn get) {
    const int vb = threadIdx.x >> 8, tid = threadIdx.x & 255;
    unsigned* tile = (unsigned*)(smem + vb * 17408);
    const int nc = tid & 15, kp = tid >> 4;
    const int kc = tid & 7, nr = tid >> 3;
    int tp = blockIdx.x;
    if (4 * tp >= t_end) return;
    auto clampt = [&](int tpp, int u) { const int t = 4 * tpp + 2 * vb + u; return t < t_end ? t : t_end - 1; };
    ConvDesc d[2]; f32x4 a0[2], b0[2], a1[2], b1[2];
#pragma unroll
    for (int u = 0; u < 2; ++u) {
        d[u] = get(clampt(tp, u));
        const float* s0 = d[u].src + (size_t)(d[u].k0 + 2 * kp) * d[u].N + d[u].n0 + 4 * nc;
        a0[u] = *(const f32x4*)s0; b0[u] = *(const f32x4*)(s0 + d[u].N);
        const float* s1 = s0 + (size_t)32 * d[u].N;
        a1[u] = *(const f32x4*)s1; b1[u] = *(const f32x4*)(s1 + d[u].N);
    }
    __syncthreads();
    for (;;) {
        const int tn = tp + (int)gridDim.x;
        const bool more = 4 * tn < t_end;
        ConvDesc dn[2]; f32x4 na0[2], nb0[2], na1[2], nb1[2];
#pragma unroll
        for (int u = 0; u < 2; ++u) { dn[u] = d[u]; na0[u] = a0[u]; nb0[u] = b0[u]; na1[u] = a1[u]; nb1[u] = b1[u]; }
        if (more) {
#pragma unroll
            for (int u = 0; u < 2; ++u) {
                dn[u] = get(clampt(tn, u));
                const float* s0 = dn[u].src + (size_t)(dn[u].k0 + 2 * kp) * dn[u].N + dn[u].n0 + 4 * nc;
                na0[u] = *(const f32x4*)s0; nb0[u] = *(const f32x4*)(s0 + dn[u].N);
                const float* s1 = s0 + (size_t)32 * dn[u].N;
                na1[u] = *(const f32x4*)s1; nb1[u] = *(const f32x4*)(s1 + dn[u].N);
            }
        }
#pragma unroll
        for (int u = 0; u < 2; ++u)
#pragma unroll
            for (int e = 0; e < 4; ++e) { tile[u * 2176 + (4 * nc + e) * 33 + kp] = pack_h2(a0[u][e], b0[u][e]); tile[u * 2176 + (4 * nc + e) * 33 + kp + 16] = pack_h2(a1[u][e], b1[u][e]); }
        __syncthreads();
#pragma unroll
        for (int u = 0; u < 2; ++u)
#pragma unroll
            for (int ps = 0; ps < 2; ++ps) {
                const int n = nr + 32 * ps;
                u32x4 v;
                v[0] = tile[u * 2176 + n * 33 + 4 * kc + 0]; v[1] = tile[u * 2176 + n * 33 + 4 * kc + 1]; v[2] = tile[u * 2176 + n * 33 + 4 * kc + 2]; v[3] = tile[u * 2176 + n * 33 + 4 * kc + 3];
                const int ng = d[u].n0 + n;
                int np = ng;
                if (d[u].mode == 1) np = 32 * (ng >> 4) + (ng & 15);
                else if (d[u].mode == 2) np = 32 * (ng >> 4) + 16 + (ng & 15);
                *(u32x4*)(d[u].dst + (size_t)np * d[u].ldd + d[u].k0 + 8 * kc) = v;
            }
        __syncthreads();
        if (!more) break;
#pragma unroll
        for (int u = 0; u < 2; ++u) { d[u] = dn[u]; a0[u] = na0[u]; b0[u] = nb0[u]; a1[u] = na1[u]; b1[u] = nb1[u]; }
        tp = tn;
    }
}
__device__ __forceinline__ void phase_conv_experts(const Params& p, char* smem, int bid, int nblk, int l) {
    conv_run(smem, 16 * 768, [&](int t) { return conv_desc_expert(p, l, t); });
}
__device__ __forceinline__ void phase_prologue(const Params& p, char* smem, int bid, int nblk) {
    const int tid = threadIdx.x;
    char* ws = p.ws;
#pragma unroll 1
    for (int rp = 0; rp < (PROBE_PHASE == 300 ? 3 : 1); ++rp) {
        float* sl = (float*)smem;
        float* red = sl + 5 * 2048;
        float* mod = (float*)(ws + OFF_MOD);
        for (int i = tid; i < 5 * 2048; i += NT) {
            const int v = i >> 11, kk = i & 2047;
            const float cv = (v < 4) ? p.in[1][v * D + kk] : p.in[3][kk];
            sl[i] = siluf_(cv);
        }
        __syncthreads();
        const int ks = tid >> 3, cg = tid & 7;
        for (int it = bid; it < 2 * 384; it += nblk) {
            const int l = it / 384, nc = it % 384;
            const int n0 = nc * 32 + cg * 4;
            const float* wp = p.in[4] + ((size_t)l * D + ks * 32) * 12288 + n0;
            f32x4 a0 = {0, 0, 0, 0}, a1 = a0, a2 = a0, a3 = a0, a4 = a0;
#pragma unroll 8
            for (int kk = 0; kk < 32; ++kk) {
                const f32x4 w = *(const f32x4*)(wp + (size_t)kk * 12288);
                const int k = ks * 32 + kk;
                a0 += w * sl[k]; a1 += w * sl[2048 + k]; a2 += w * sl[4096 + k]; a3 += w * sl[6144 + k]; a4 += w * sl[8192 + k];
            }
            float* r = red + ks * 160 + cg * 4;
            *(f32x4*)(r) = a0; *(f32x4*)(r + 32) = a1; *(f32x4*)(r + 64) = a2; *(f32x4*)(r + 96) = a3; *(f32x4*)(r + 128) = a4;
            __syncthreads();
            if (tid < 160) {
                const int v = tid >> 5, c = tid & 31;
                float sum = p.in[5][l * 12288 + nc * 32 + c];
#pragma unroll 8
                for (int q = 0; q < 64; ++q) sum += red[q * 160 + v * 32 + c];
                mod[(size_t)(l * 5 + v) * 12288 + nc * 32 + c] = sum;
            }
            __syncthreads();
        }
    }
#pragma unroll 1
    for (int rp = 0; rp < (PROBE_PHASE == 301 ? 3 : 1); ++rp) {
        h16* DT = (h16*)(ws + OFF_DT);
        const float sT = 0.022097086912079608f;
        for (size_t i = (size_t)bid * NT + tid; i < (size_t)2048 * 2048; i += (size_t)nblk * NT) {
            const int k = (int)(i >> 11), kp = (int)(i & 2047);
            const int t = kp & 1023;
            const int m = (k * t) & 2047;
            const float x = (float)m * (1.0f / 1024.0f);
            const float v = (kp < 1024) ? cospif(x) : -sinpif(x);
            DT[i] = (h16)(v * sT);
        }
        h16* DC = (h16*)(ws + OFF_DC);
        for (int i = bid * NT + tid; i < 512 * 256; i += nblk * NT) {
            const int n = i >> 8, c = i & 255;
            const int m = ((n & 255) * c) & 255;
            const float x = (float)m * (1.0f / 128.0f);
            const float v = (n < 256) ? cospif(x) : sinpif(x);
            DC[i] = (h16)(v * 0.0625f);
        }
        h16* RWH = (h16*)(ws + OFF_RWH); h16* RWL = (h16*)(ws + OFF_RWL);
        for (int i = bid * NT + tid; i < 16 * 2048; i += nblk * NT) {
            const int e = i >> 11, k = i & 2047;
            const float w = p.in[25][k * 16 + e];
            const h16 wh = (h16)w;
            RWH[i] = wh; RWL[i] = (h16)((w - (float)wh) * 4096.0f);
        }
        float* RP = (float*)(ws + OFF_ROPE);
        for (int i = bid * NT + tid; i < 2048 * 64; i += nblk * NT) {
            const int t = i >> 6, f = i & 63;
            const int fi = f & 31;
            const float inv = powf(10000.0f, -(float)(2 * fi) / 64.0f);
            const float pos = (f < 32) ? (float)(t >> 6) : (float)(t & 63);
            const float ang = pos * inv;
            RP[2 * i] = cosf(ang); RP[2 * i + 1] = sinf(ang);
        }
    }
    __syncthreads();
#pragma unroll 1
    for (int rp = 0; rp < (PROBE_PHASE == 302 ? 3 : 1); ++rp)
    conv_run(smem, CONV_T6, [&](int t) { return conv_desc_prologue(p, t); });
}

__device__ __forceinline__ void phase_modfin(const Params& p, int bid, int nblk) {
    const float* modp = (const float*)(p.ws + OFF_MODP);
    float* mod = (float*)(p.ws + OFF_MOD);
    for (int i = bid * NT + threadIdx.x; i < 2 * 5 * 12288; i += nblk * NT) {
        const int n = i % 12288, l = i / (5 * 12288);
        float s = p.in[5][l * 12288 + n];
#pragma unroll
        for (int ks = 0; ks < 16; ++ks) s += modp[(size_t)ks * (2 * 5 * 12288) + i];
        mod[i] = s;
    }
}
__device__ __forceinline__ const float* modv(const Params& p, int l, int v, int part) { return (const float*)(p.ws + OFF_MOD) + ((size_t)(l * 5 + v) * 6 + part) * 2048; }

__device__ __forceinline__ void phase_norm0(const Params& p, char* smem, int bid, int nblk) {
    const int tid = threadIdx.x, lane = tid & 63, wave = tid >> 6;
    h16* H = (h16*)(p.ws + OFF_H);
    float* fac = (float*)smem;
    for (int i = tid; i < 5 * 2048; i += NT) {
        const int v = i >> 11, k = i & 2047;
        fac[(v * 2) * 2048 + k] = p.in[6][k] * (modv(p, 0, v, 1)[k] + 1.0f);
        fac[(v * 2 + 1) * 2048 + k] = modv(p, 0, v, 0)[k];
    }
    __syncthreads();
    auto rowptr = [&](int R, int& v) {
        const int b = R / SALL, s = R % SALL;
        if (s < CTXL) { v = 4; return p.in[2] + ((size_t)b * CTXL + s) * D; }
        v = b; return p.in[0] + ((size_t)b * SEQ + (s - CTXL)) * D;
    };
    int R = bid * NW + wave;
    if (R >= ROWS0) return;
    int v; const float* xr = rowptr(R, v);
    f32x4 x[8];
#pragma unroll
    for (int i = 0; i < 8; ++i) x[i] = *(const f32x4*)(xr + i * 256 + lane * 4);
    for (;;) {
        const int Rn = R + nblk * NW;
        const bool more = Rn < ROWS0;
        int vn = v; f32x4 xn[8];
        if (more) {
            const float* xq = rowptr(Rn, vn);
#pragma unroll
            for (int i = 0; i < 8; ++i) xn[i] = *(const f32x4*)(xq + i * 256 + lane * 4);
        }
        float ss = 0.f;
#pragma unroll
        for (int i = 0; i < 8; ++i) ss += x[i][0] * x[i][0] + x[i][1] * x[i][1] + x[i][2] * x[i][2] + x[i][3] * x[i][3];
        ss = wave_sum(ss);
        const float rstd = rsqrtf(ss * (1.0f / D) + 1e-6f);
        const float* fm = fac + (v * 2) * 2048;
#pragma unroll
        for (int i = 0; i < 8; ++i) {
            const int k = i * 256 + lane * 4;
            const f32x4 m1 = *(const f32x4*)(fm + k), h1 = *(const f32x4*)(fm + 2048 + k);
            store_h4(H + (size_t)R * D + k, (x[i] * rstd) * m1 + h1);
        }
        if (!more) break;
#pragma unroll
        for (int i = 0; i < 8; ++i) x[i] = xn[i];
        R = Rn; v = vn;
    }
}

__device__ __forceinline__ void phase_gemm_in(const Params& p, char* smem, int bid, int nblk) {
    const h16* A = (const h16*)(p.ws + OFF_H);
    const h16* Bt = (const h16*)(p.ws + OFF_WIN);
    h16* P = (h16*)(p.ws + OFF_P);
    const int MT = ROWS0 / 256, NTl = IN_COLS / 256;
    auto sched = [&](int i, g8::Unit& u) {
        const int t = bid + i * nblk;
        if (t >= MT * NTl) return false;
        int tm, tn; tile_order(t, MT, NTl, tm, tn);
        u.a = A + (size_t)(tm * 256) * D; u.b = Bt + (size_t)(tn * 256) * D; u.u0 = tm; u.u1 = tn; u.u2 = 0; u.u3 = 0;
        return true;
    };
    gemm_phase8(smem, D, D, D, sched, [&](const g8::Unit& u, const f32x4 (&acc)[2][2][4][2], int wr, int wc, int fr, int fq) {
        const int tm = u.u0, tn = u.u1;
        acc8_foreach(acc, wr, wc, fr, fq, [&](int r, int c, f32x4 v) { store_h4(P + (size_t)(tm * 256 + r) * IN_COLS + tn * 256 + c, v); });
    });
}

__device__ __forceinline__ void phase_prep(const Params& p, char* smem, int bid, int nblk) {
    const int tid = threadIdx.x, lane = tid & 63, wave = tid >> 6;
    char* ws = p.ws;
    const h16* P = (const h16*)(ws + OFF_P);
    h16* SR = (h16*)(ws + OFF_SR); h16* SV = (h16*)(ws + OFF_SV); h16* SKS = (h16*)(ws + OFF_SKS); h16* SKK = (h16*)(ws + OFF_SKK);
    h16* F = (h16*)(ws + OFF_F);
    h16* Q = (h16*)(ws + OFF_Q); h16* KB = (h16*)(ws + OFF_KB); h16* VB = (h16*)(ws + OFF_VB);
    const float* RP = (const float*)(ws + OFF_ROPE);
    float* mu = (float*)smem;
    for (int i = tid; i < A_COLS; i += NT) { mu[i] = p.in[9][i]; mu[A_COLS + i] = p.in[10][i]; }
    for (int i = tid; i < 1024; i += NT) mu[2 * A_COLS + i] = p.in[16][i];
    const int l16 = lane & 15;
    f32x4 qg[2], kg[2];
#pragma unroll
    for (int j = 0; j < 2; ++j) { qg[j] = *(const f32x4*)(p.in[21] + 8 * l16 + 4 * j); kg[j] = *(const f32x4*)(p.in[22] + 8 * l16 + 4 * j); }
    __syncthreads();
    for (int R = bid * NW + wave; R < ROWS0; R += nblk * NW) {
        const int b = R / SALL, s = R % SALL;
        const bool has_prev = !(s == 0 || s == CTXL);
        const bool has_next = !(s == CTXL - 1 || s == SALL - 1);
        const bool lat = (s >= CTXL);
        const int t = lat ? s - CTXL : 0;
        const h16* p0 = P + (size_t)R * IN_COLS;
        const h16* pm = has_prev ? p0 - IN_COLS : p0; const h16* pn = has_next ? p0 + IN_COLS : p0;
        h16x4 a[12], am[12], an[12];
#pragma unroll
        for (int j = 0; j < 12; ++j) {
            const int col = (j >> 2) * 1024 + (j & 3) * 256 + lane * 4;
            a[j] = *(const h16x4*)(p0 + col); am[j] = *(const h16x4*)(pm + col); an[j] = *(const h16x4*)(pn + col);
        }
        const int lcol = 3072 + lane * 4;
        const h16x4 la = *(const h16x4*)(p0 + lcol), lam = *(const h16x4*)(pm + lcol), lan = *(const h16x4*)(pn + lcol);
        const h16x8 q0 = *(const h16x8*)(p0 + A_COLS + lane * 8), q1 = *(const h16x8*)(p0 + A_COLS + 512 + lane * 8);
        const h16x8 kv = *(const h16x8*)(p0 + A_COLS + 1024 + lane * 8);
        f32x4 rp0 = {1.f, 0.f, 1.f, 0.f}, rp1 = rp0;
        if (lat) { const float* rp = RP + ((size_t)t * 64 + 4 * l16) * 2; rp0 = *(const f32x4*)rp; rp1 = *(const f32x4*)(rp + 4); }
        const float fp = has_prev ? 1.f : 0.f, fn = has_next ? 1.f : 0.f;
        __builtin_amdgcn_sched_barrier(0);
#pragma unroll
        for (int j = 0; j < 12; ++j) {
            const int part = j >> 2, c = (j & 3) * 256 + lane * 4, col = part * 1024 + c;
            const f32x4 mp = *(const f32x4*)(mu + col), mn = *(const f32x4*)(mu + A_COLS + col);
            f32x4 y;
#pragma unroll
            for (int e = 0; e < 4; ++e) { const float x0 = (float)a[j][e]; y[e] = x0 + mp[e] * (fp * (float)am[j][e] - x0) + mn[e] * (fn * (float)an[j][e] - x0); }
            if (part == 0) store_h4(SR + (size_t)R * DA + c, y);
            else if (part == 2) store_h4(SV + (size_t)R * DA + c, y);
            else {
                store_h4(SKS + (size_t)R * DA + c, y);
                const f32x4 kk4 = *(const f32x4*)(mu + 2 * A_COLS + c);
                f32x4 z = y * kk4;
                float ss = z[0] * z[0] + z[1] * z[1] + z[2] * z[2] + z[3] * z[3];
                ss = row16_sum(ss);
                z = z * rsqrtf(ss + 1e-12f);
                store_h4(SKK + (size_t)R * DA + c, z);
            }
            __builtin_amdgcn_sched_barrier(0);
        }
        {
            const f32x4 mp = *(const f32x4*)(mu + lcol), mn = *(const f32x4*)(mu + A_COLS + lcol);
            f32x4 y;
#pragma unroll
            for (int e = 0; e < 4; ++e) {
                const float x0 = (float)la[e];
                const float v = x0 + mp[e] * (fp * (float)lam[e] - x0) + mn[e] * (fn * (float)lan[e] - x0);
                y[e] = (lane < 16) ? ftanh_(v) : (lane < 32) ? v : fsigmoid_(v);
            }
            store_h4(F + (size_t)R * 256 + lane * 4, y);
        }
        {
            auto normrope = [&](const h16x8& v, const f32x4 (&g)[2], float scale) {
                float x[8]; float ss = 0.f;
#pragma unroll
                for (int e = 0; e < 8; ++e) { x[e] = (float)v[e]; ss += x[e] * x[e]; }
                ss = row16_sum(ss);
                const float rstd = rsqrtf(ss * (1.0f / 128.0f) + 1e-6f);
#pragma unroll
                for (int e = 0; e < 8; ++e) x[e] = x[e] * rstd * g[e >> 2][e & 3];
                h16x8 o;
#pragma unroll
                for (int j = 0; j < 4; ++j) {
                    const float cs = (j < 2) ? rp0[2 * j] : rp1[2 * j - 4], sn = (j < 2) ? rp0[2 * j + 1] : rp1[2 * j - 3];
                    o[2 * j] = (h16)((x[2 * j] * cs - x[2 * j + 1] * sn) * scale); o[2 * j + 1] = (h16)((x[2 * j] * sn + x[2 * j + 1] * cs) * scale);
                }
                return o;
            };
            const int hh = lane >> 4;
            if (lat) {
                const float qs = 0.12751743074602897f;
                *(h16x8*)(Q + (((size_t)(b * 8 + hh) * SEQ + t) * 128 + 8 * l16)) = normrope(q0, qg, qs);
                *(h16x8*)(Q + (((size_t)(b * 8 + 4 + hh) * SEQ + t) * 128 + 8 * l16)) = normrope(q1, qg, qs);
            }
            const h16x8 ko = normrope(kv, kg, 1.0f);
            if (lane < 32) *(h16x8*)(KB + (((size_t)(b * 2 + hh) * SALL + s) * 128 + 8 * l16)) = ko;
            else *(h16x8*)(VB + (((size_t)(b * 2 + hh - 2) * SALL + s) * 128 + 8 * l16)) = kv;
        }
    }
}

__device__ __forceinline__ void phase_lora(const Params& p, char* smem, int bid, int nblk) {
    char* ws = p.ws;
    const h16* F = (const h16*)(ws + OFF_F);
    const int MT = ROWS0 / 256;
    const int T0 = MT * 8, T1 = T0 + MT * 8, T2 = T1 + MT * 4;
    for (int t = bid; t < T2; t += nblk) {
        f32x4 acc[8][4];
        if (t < T0) {
            const int tm = t % MT, tn = t / MT;
            const h16* Bt = (const h16*)(ws + OFF_W2T);
            gemm_tile(smem, [&](int r) { return F + (size_t)(tm * 256 + r) * 256; }, [&](int n) { return Bt + (size_t)(tn * 256 + perm16(n)) * 64; }, 64, acc);
            const float* w0 = p.in[11];
            f32x4 bias[4];
#pragma unroll
            for (int q = 0; q < 4; ++q) bias[q] = *(const f32x4*)(w0 + tn * 256 + 64 * ((threadIdx.x >> 6) & 3) + 16 * ((threadIdx.x & 63) >> 4) + 4 * q);
            acc_foreach16(acc, [&](int r, int c, const f32x4 (&v)[4]) {
                const int R = tm * 256 + r, n = tn * 256 + c, d = n >> 10, ch = n & 1023;
                f32x4 o[4];
#pragma unroll
                for (int q = 0; q < 4; ++q) {
                    const f32x4 b4 = bias[q];
#pragma unroll
                    for (int e = 0; e < 4; ++e) {
                        const float z = v[q][e] + b4[e];
                        o[q][e] = 0.6065306597126334f * fsigmoid_(z);
                    }
                }
                h16* W = (h16*)(ws + (d ? OFF_SW1 : OFF_SW0));
                store_h16(W + (size_t)R * DA + ch, o);
            });
        } else if (t < T1) {
            const int u = t - T0; const int tm = u % MT, tn = u / MT;
            const h16* Bt = (const h16*)(ws + OFF_A2T);
            gemm_tile(smem, [&](int r) { return F + (size_t)(tm * 256 + r) * 256 + 64; }, [&](int n) { return Bt + (size_t)(tn * 256 + perm16(n)) * 64; }, 64, acc);
            const float* a0 = p.in[13];
            f32x4 bias[4];
#pragma unroll
            for (int q = 0; q < 4; ++q) bias[q] = *(const f32x4*)(a0 + tn * 256 + 64 * ((threadIdx.x >> 6) & 3) + 16 * ((threadIdx.x & 63) >> 4) + 4 * q);
            acc_foreach16(acc, [&](int r, int c, const f32x4 (&v)[4]) {
                const int R = tm * 256 + r, n = tn * 256 + c, d = n >> 10, ch = n & 1023;
                f32x4 av[4];
#pragma unroll
                for (int q = 0; q < 4; ++q) {
                    const f32x4 b4 = bias[q];
#pragma unroll
                    for (int e = 0; e < 4; ++e) av[q][e] = fsigmoid_(v[q][e] + b4[e]);
                }
                store_h16((h16*)(ws + (d ? OFF_SKD1 : OFF_SKD0)) + (size_t)R * DA + ch, av);
            });
        } else {
            const int u = t - T1; const int tm = u % MT, tn = u / MT;
            const h16* Bt = (const h16*)(ws + OFF_G2T);
            gemm_tile(smem, [&](int r) { return F + (size_t)(tm * 256 + r) * 256 + 128; }, [&](int n) { return Bt + (size_t)(tn * 256 + perm16(n)) * 128; }, 128, acc);
            h16* SG = (h16*)(ws + OFF_SG);
            acc_foreach16(acc, [&](int r, int c, const f32x4 (&v)[4]) { store_h16(SG + (size_t)(tm * 256 + r) * DA + tn * 256 + c, v); });
        }
    }
}

__device__ __forceinline__ int srow_of(int dir, int tau) { return dir ? ((tau < CTXL) ? (CTXL - 1 - tau) : (SALL + CTXL - 1 - tau)) : tau; }

__device__ __forceinline__ void phase_chunkprep(const Params& p, char* smem, int bid, int nblk) {
    char* ws = p.ws;
    const int tid = threadIdx.x, lane = tid & 63, wave = tid >> 6;
    const int fr = lane & 15, g = lane >> 4;
    {
        const h16* VB = (const h16*)(ws + OFF_VB); h16* VT = (h16*)(ws + OFF_VT);
        h16* tl = (h16*)smem;
        for (int tile = bid; tile < 8 * (SALL / 64); tile += nblk) {
            const int pair = tile / (SALL / 64), kt = tile % (SALL / 64);
            __syncthreads();
#pragma unroll
            for (int i = 0; i < 2; ++i) {
                const int e = tid + i * NT;
                const h16x8 v = *(const h16x8*)(VB + ((size_t)pair * SALL + kt * 64 + (e >> 4)) * 128 + (e & 15) * 8);
                h16* dp = tl + (e >> 4) * 132 + (e & 15) * 8;
                *(h16x4*)dp = (h16x4){v[0], v[1], v[2], v[3]}; *(h16x4*)(dp + 4) = (h16x4){v[4], v[5], v[6], v[7]};
            }
            __syncthreads();
            const int d = tid >> 2, pc = tid & 3;
            h16x8 o0, o1;
#pragma unroll
            for (int q = 0; q < 16; ++q) {
                const int pos = pc * 16 + q, p32 = pos & 31, gq = p32 >> 3, jj = p32 & 7;
                const int key = (pos & 32) + ((jj < 4) ? (4 * gq + jj) : (16 + 4 * gq + jj - 4));
                const h16 val = tl[key * 132 + d];
                if (q < 8) o0[q] = val; else o1[q - 8] = val;
            }
            h16* dst = VT + ((size_t)pair * 128 + d) * SALL + kt * 64 + pc * 16;
            *(h16x8*)dst = o0; *(h16x8*)(dst + 8) = o1;
        }
        __syncthreads();
    }
    char* wl = smem + wave * 12288;
    h16* At = (h16*)(wl); h16* Rt = (h16*)(wl + 2048); h16* Btl = (h16*)(wl + 4096); h16* Ktl = (h16*)(wl + 6144);
    h16* Bj = (h16*)(wl + 8192); h16* Kj = (h16*)(wl + 10240);
    const h16* SKK = (const h16*)(ws + OFF_SKK); const h16* SR = (const h16*)(ws + OFF_SR);
    for (int u = bid * NW + wave; u < 128 * NCHUNK; u += nblk * NW) {
        const int item = u / NCHUNK, c = u - item * NCHUNK;
        const int dir = item & 1, h = (item >> 1) & 15, b = item >> 5;
        const h16* SW = (const h16*)(ws + (dir ? OFF_SW1 : OFF_SW0));
        const h16* SAL = (const h16*)(ws + (dir ? OFF_SKD1 : OFF_SKD0));
        const h16* SKS = (const h16*)(ws + OFF_SKS);
        const float ka = p.in[17][h * 64 + lane];
        char* rec = ws + (dir ? OFF_FRAG1 : OFF_FRAG0) + ((size_t)((b * 16 + h) * NCHUNK + c)) * REC_BYTES;
        float w[16], at[16], rt[16], bt[16], kt[16];
#pragma unroll
        for (int t = 0; t < 16; ++t) {
            const int s = srow_of(dir, 16 * c + t);
            const size_t idx = ((size_t)(b * SALL + s)) * DA + h * 64 + lane;
            const float kkv = (float)SKK[idx], al = (float)SAL[idx];
            w[t] = fexp_(-(float)SW[idx]); at[t] = -kkv; rt[t] = (float)SR[idx]; bt[t] = kkv * al; kt[t] = (float)SKS[idx] * (1.0f + (al - 1.0f) * ka);
        }
        float wn = 1.f;
        if (c + 1 < NCHUNK) {
#pragma unroll
            for (int t = 0; t < 8; ++t) { const int s = srow_of(dir, 16 * (c + 1) + t); wn *= fexp_(-(float)SW[((size_t)(b * SALL + s)) * DA + h * 64 + lane]); }
        }
        float cum[16];
        cum[0] = w[0];
#pragma unroll
        for (int t = 1; t < 16; ++t) cum[t] = cum[t - 1] * w[t];
        const float w7 = cum[7], inv7 = 1.0f / w7;
        float sigma;
        {
            float rprev = inv7;
#pragma unroll
            for (int t = 0; t < 16; ++t) {
                const float rho = cum[t] * inv7;
                const float irho = w7 / cum[t];
                at[t] *= rprev; rt[t] *= rho; bt[t] *= irho; kt[t] *= irho;
                rprev = rho;
            }
            sigma = rprev * wn;
        }
        __builtin_amdgcn_wave_barrier();
#pragma unroll
        for (int t = 0; t < 16; ++t) { At[t * 64 + lane] = (h16)at[t]; Rt[t * 64 + lane] = (h16)rt[t]; Btl[t * 64 + lane] = (h16)bt[t]; Ktl[t * 64 + lane] = (h16)kt[t]; }
        {
            h16x8 b0, b1, k0, k1;
#pragma unroll
            for (int t = 0; t < 8; ++t) { b0[t] = (h16)bt[t]; b1[t] = (h16)bt[8 + t]; k0[t] = (h16)kt[t]; k1[t] = (h16)kt[8 + t]; }
            *(h16x8*)(Bj + lane * 16) = b0; *(h16x8*)(Bj + lane * 16 + 8) = b1;
            *(h16x8*)(Kj + lane * 16) = k0; *(h16x8*)(Kj + lane * 16 + 8) = k1;
        }
        __builtin_amdgcn_wave_barrier();
#pragma unroll
        for (int ks = 0; ks < 2; ++ks) {
            const h16x4 alo = *(const h16x4*)(At + fr * 64 + 32 * ks + 4 * g), ahi = *(const h16x4*)(At + fr * 64 + 32 * ks + 16 + 4 * g);
            *(h16x8*)(rec + ks * 1024 + lane * 16) = cat8(alo, ahi);
            const h16x4 rlo = *(const h16x4*)(Rt + fr * 64 + 32 * ks + 4 * g), rhi = *(const h16x4*)(Rt + fr * 64 + 32 * ks + 16 + 4 * g);
            *(h16x8*)(rec + 2048 + ks * 1024 + lane * 16) = cat8(rlo, rhi);
        }
#pragma unroll
        for (int jt = 0; jt < 4; ++jt) {
            const h16x4 blo = *(const h16x4*)(Bj + (16 * jt + fr) * 16 + 4 * g), khi = *(const h16x4*)(Kj + (16 * jt + fr) * 16 + 4 * g);
            *(h16x8*)(rec + 4096 + jt * 1024 + lane * 16) = cat8(blo, khi);
        }
        const f32x4 z4 = {0.f, 0.f, 0.f, 0.f};
        f32x4 Nak = z4, Nab = z4, Mkr = z4, Mbr = z4, NT = z4;
#pragma unroll
        for (int ks = 0; ks < 2; ++ks) {
            const h16x8 af = *(const h16x8*)(At + fr * 64 + 32 * ks + 8 * g), rf = *(const h16x8*)(Rt + fr * 64 + 32 * ks + 8 * g);
            const h16x8 bf = *(const h16x8*)(Btl + fr * 64 + 32 * ks + 8 * g), kf = *(const h16x8*)(Ktl + fr * 64 + 32 * ks + 8 * g);
            Nak = mfma32(kf, af, Nak); Nab = mfma32(bf, af, Nab); Mkr = mfma32(kf, rf, Mkr); Mbr = mfma32(bf, rf, Mbr); NT = mfma32(af, bf, NT);
        }
        f32x4 T1;
#pragma unroll
        for (int e = 0; e < 4; ++e) {
            const int row = 4 * g + e;
            if (!(row < fr)) { Nak[e] = 0.f; Nab[e] = 0.f; }
            if (!(row <= fr)) { Mkr[e] = 0.f; Mbr[e] = 0.f; }
            if (!(fr < row)) NT[e] = 0.f;
            T1[e] = Nab[e] + ((row == fr) ? 1.0f : 0.0f);
        }
        const h16x4 n1 = cvt4(Nab), m1 = cvt4(NT);
        const f32x4 N2 = mfma16(m1, n1, z4), M2 = mfma16(n1, m1, z4);
        const h16x4 n2 = cvt4(N2), m2 = cvt4(M2);
        const f32x4 T2 = mfma16(m2, cvt4(T1), T1);
        const f32x4 N4 = mfma16(m2, n2, z4), M4 = mfma16(n2, m2, z4);
        const h16x4 n4 = cvt4(N4), m4 = cvt4(M4);
        const f32x4 T4 = mfma16(m4, cvt4(T2), T2);
        const f32x4 M8 = mfma16(n4, m4, z4);
        const f32x4 T8 = mfma16(cvt4(M8), cvt4(T4), T4);
        *(h16x8*)(rec + 8192 + lane * 16) = cat8(cvt4(Mbr), cvt4(Mkr));
        *(h16x4*)(rec + 9216 + lane * 8) = cvt4(T8);
        *(h16x4*)(rec + 9728 + lane * 8) = cvt4(Nak);
        *(float*)(rec + 10240 + lane * 4) = sigma;
        __builtin_amdgcn_wave_barrier();
    }
}

constexpr int SLOT_BYTES = REC_BYTES + 2048;
__device__ __forceinline__ void scan_item(const Params& p, char* smem, int item) {
    char* ws = p.ws;
    const int tid = threadIdx.x, lane = tid & 63;
    const int wave = __builtin_amdgcn_readfirstlane(tid >> 6);
    const int il = lane & 15, g = lane >> 4;
    const int dir = item & 1, h = (item >> 1) & 15, b = item >> 5;
    const char* rec0 = ws + (dir ? OFF_FRAG1 : OFF_FRAG0) + ((size_t)((b * 16 + h) * NCHUNK)) * REC_BYTES;
    const h16* SV = (const h16*)(ws + OFF_SV);
    h16* Y = (h16*)(ws + (dir ? OFF_Y1 : OFF_Y0));
    const f32x4 z4 = {0.f, 0.f, 0.f, 0.f};
    f32x4 P[4];
#pragma unroll
    for (int jt = 0; jt < 4; ++jt) P[jt] = z4;
    u32x4 lr[11], lv[2];
    auto issue = [&](int c) {
        const char* rec = rec0 + (size_t)c * REC_BYTES;
#pragma unroll
        for (int m = 0; m < 10; ++m) lr[m] = *(const u32x4*)(rec + m * 1024 + lane * 16);
        lr[10] = *(const u32x4*)(rec + 10240 + (lane & 15) * 16);
        const int s = srow_of(dir, 16 * c + (lane >> 2));
        const h16* vp = SV + ((size_t)(b * SALL + s)) * DA + h * 64 + (lane & 3) * 16;
        lv[0] = *(const u32x4*)vp; lv[1] = *(const u32x4*)(vp + 8);
    };
    auto writeslot = [&](int c) {
        char* sl = smem + (c & 3) * SLOT_BYTES;
#pragma unroll
        for (int m = 0; m < 10; ++m) *(u32x4*)(sl + m * 1024 + lane * 16) = lr[m];
        if (lane < 16) *(u32x4*)(sl + 10240 + lane * 16) = lr[10];
        *(u32x4*)(sl + REC_BYTES + (lane >> 2) * 128 + (lane & 3) * 32) = lv[0];
        *(u32x4*)(sl + REC_BYTES + (lane >> 2) * 128 + (lane & 3) * 32 + 16) = lv[1];
    };
    __syncthreads();
    if (wave >= 4) issue(wave - 4);
#pragma unroll 1
    for (int n = 0; n <= NCHUNK; ++n) {
        if (wave >= 4) {
            if (n < NCHUNK && (n & 3) == wave - 4) { writeslot(n); if (n + 4 < NCHUNK) issue(n + 4); }
        } else if (n >= 1) {
            const int c = n - 1;
            const char* sl = smem + (c & 3) * SLOT_BYTES;
            h16x8 a1[2], a3r[2], a4[4];
#pragma unroll
            for (int ks = 0; ks < 2; ++ks) { a1[ks] = *(const h16x8*)(sl + ks * 1024 + lane * 16); a3r[ks] = *(const h16x8*)(sl + 2048 + ks * 1024 + lane * 16); }
#pragma unroll
            for (int jt = 0; jt < 4; ++jt) a4[jt] = *(const h16x8*)(sl + 4096 + jt * 1024 + lane * 16);
            const h16x8 a3m = *(const h16x8*)(sl + 8192 + lane * 16);
            const h16x4 a2 = *(const h16x4*)(sl + 9216 + lane * 8);
            const h16x4 a1v = *(const h16x4*)(sl + 9728 + lane * 8);
            f32x4 sg[4];
#pragma unroll
            for (int jt = 0; jt < 4; ++jt) sg[jt] = *(const f32x4*)(sl + 10240 + (16 * jt + 4 * g) * 4);
            const h16* Vl = (const h16*)(sl + REC_BYTES);
            const h16x4 zh = {0, 0, 0, 0};
            const h16x8 A1V = cat8(zh, a1v);
            const bool lat = (c >= CTXL / 16);
            {
                const int it = wave;
                h16x4 vq;
#pragma unroll
                for (int e = 0; e < 4; ++e) vq[e] = Vl[(4 * g + e) * 64 + 16 * it + il];
                const h16x8 bp0 = cat8(cvt4(P[0]), cvt4(P[1])), bp1 = cat8(cvt4(P[2]), cvt4(P[3]));
                f32x4 G = mfma32(A1V, cat8(zh, vq), z4);
                G = mfma32(a1[0], bp0, G); G = mfma32(a1[1], bp1, G);
                const f32x4 U = mfma16(a2, cvt4(G), z4);
                const h16x8 buv = cat8(cvt4(U), vq);
                if (lat) {
                    f32x4 Yv = mfma32(a3r[0], bp0, z4); Yv = mfma32(a3r[1], bp1, Yv); Yv = mfma32(a3m, buv, Yv);
#pragma unroll
                    for (int e = 0; e < 4; ++e) {
                        const int s = srow_of(dir, 16 * c + 4 * g + e);
                        Y[((size_t)(b * SEQ + s - CTXL)) * DA + h * 64 + 16 * it + il] = (h16)Yv[e];
                    }
                }
#pragma unroll
                for (int jt = 0; jt < 4; ++jt) P[jt] = mfma32(a4[jt], buv, P[jt]) * sg[jt];
            }
        }
        __syncthreads();
    }
}

__device__ __forceinline__ void attn_item(const Params& p, char* smem, int item) {
    char* ws = p.ws;
    const int tid = threadIdx.x, lane = tid & 63, wave = tid >> 6;
    const int fr = lane & 15, fq = lane >> 4;
    const int pair = item >> 6, j = item & 63;
    const int b = pair >> 1, kvh = pair & 1, hq = kvh * 4 + (j >> 4), qt = j & 15;
    const h16* Qp = (const h16*)(ws + OFF_Q) + (((size_t)(b * 8 + hq) * SEQ) + qt * 128 + wave * 16) * 128;
    const h16* Kp = (const h16*)(ws + OFF_KB) + ((size_t)(b * 2 + kvh) * SALL) * 128;
    const h16* Vp = (const h16*)(ws + OFF_VT) + ((size_t)(b * 2 + kvh) * 128) * SALL;
    h16x8 qf[4];
#pragma unroll
    for (int ds = 0; ds < 4; ++ds) qf[ds] = *(const h16x8*)(Qp + (size_t)fr * 128 + 32 * ds + 8 * fq);
    const f32x4 zero4 = {0.f, 0.f, 0.f, 0.f};
    f32x4 o[8];
#pragma unroll
    for (int dt = 0; dt < 8; ++dt) o[dt] = zero4;
    float mrun = -1e30f, lrun = 0.f;
    int ksrc[2], vsrc[2];
#pragma unroll
    for (int i = 0; i < 2; ++i) {
        const int krow = 4 * (2 * wave + i) + (lane >> 4);
        ksrc[i] = krow * 128 + (((lane & 15) ^ (krow & 15)) << 3);
        const int vrow = 8 * (2 * wave + i) + (lane >> 3);
        vsrc[i] = vrow * SALL + (((lane & 7) ^ ((vrow >> 1) & 7)) << 3);
    }
    char* ldsK = smem + (2 * wave) * 1024 + lane * 16;
    char* ldsV = smem + 16384 + (2 * wave) * 1024 + lane * 16;
    const int kfo = fr * 256, vfo = fr * 128, vsw = (fr >> 1) & 7;
    const int NKT = SALL / 64;
    WAIT_V(0);
    __syncthreads();
#pragma unroll
    for (int st0 = 0; st0 < 3; ++st0) {
#pragma unroll
        for (int i = 0; i < 2; ++i) { glds16(Kp + (ksrc[i] + st0 * 64 * 128), ldsK + st0 * 32768 + i * 1024); glds16(Vp + (vsrc[i] + st0 * 64), ldsV + st0 * 32768 + i * 1024); }
    }
#define ATT_S(ST, kbuf) { \
        _Pragma("unroll") for (int k4 = 0; k4 < 4; ++k4) _Pragma("unroll") for (int ds = 0; ds < 4; ++ds) { \
            const h16x8 kf = *(const h16x8*)((kbuf) + k4 * 4096 + kfo + (((4 * ds + fq) ^ fr) << 4)); \
            ST[k4] = __builtin_amdgcn_mfma_f32_16x16x32_f16(kf, qf[ds], ds == 0 ? zero4 : ST[k4], 0, 0, 0); } }
#define ATT_SOFTMAX_PV(ST, vbuf) { \
        float mx = fmaxf(fmaxf(fmaxf(ST[0][0], ST[0][1]), fmaxf(ST[0][2], ST[0][3])), fmaxf(fmaxf(ST[1][0], ST[1][1]), fmaxf(ST[1][2], ST[1][3]))); \
        mx = fmaxf(mx, fmaxf(fmaxf(fmaxf(ST[2][0], ST[2][1]), fmaxf(ST[2][2], ST[2][3])), fmaxf(fmaxf(ST[3][0], ST[3][1]), fmaxf(ST[3][2], ST[3][3])))); \
        mx = fmaxf(mx, __shfl_xor(mx, 16)); mx = fmaxf(mx, __shfl_xor(mx, 32)); \
        const float mnew = fmaxf(mrun, mx); \
        const float alpha = __builtin_amdgcn_exp2f(mrun - mnew); \
        mrun = mnew; \
        float ps = 0.f; \
        _Pragma("unroll") for (int k4 = 0; k4 < 4; ++k4) _Pragma("unroll") for (int e = 0; e < 4; ++e) { const float pe = __builtin_amdgcn_exp2f(ST[k4][e] - mnew); ST[k4][e] = pe; ps += pe; } \
        lrun = lrun * alpha + ps; \
        _Pragma("unroll") for (int dt = 0; dt < 8; ++dt) o[dt] = o[dt] * alpha; \
        const h16x8 pf0 = cat8(cvt4(ST[0]), cvt4(ST[1])), pf1 = cat8(cvt4(ST[2]), cvt4(ST[3])); \
        _Pragma("unroll") for (int dt = 0; dt < 8; ++dt) { \
            const h16x8 v0 = *(const h16x8*)((vbuf) + dt * 2048 + vfo + (((0 + fq) ^ vsw) << 4)); \
            const h16x8 v1 = *(const h16x8*)((vbuf) + dt * 2048 + vfo + (((4 + fq) ^ vsw) << 4)); \
            o[dt] = __builtin_amdgcn_mfma_f32_16x16x32_f16(v0, pf0, o[dt], 0, 0, 0); \
            o[dt] = __builtin_amdgcn_mfma_f32_16x16x32_f16(v1, pf1, o[dt], 0, 0, 0); } }
#define ATT_STEP(kt, STC, STN) { \
        if ((kt) + 2 < NKT) { WAIT_V(4); } else { WAIT_V(0); }        \
        __builtin_amdgcn_s_barrier(); \
        if ((kt) + 3 < NKT) { const int so = (((kt) + 3) & 3) * 32768; \
            _Pragma("unroll") for (int i = 0; i < 2; ++i) { glds16(Kp + (ksrc[i] + ((kt) + 3) * 64 * 128), ldsK + so + i * 1024); glds16(Vp + (vsrc[i] + ((kt) + 3) * 64), ldsV + so + i * 1024); } } \
        if ((kt) + 1 < NKT) ATT_S(STN, smem + (((kt) + 1) & 3) * 32768) \
        ATT_SOFTMAX_PV(STC, smem + ((kt) & 3) * 32768 + 16384) }
    f32x4 stA[4], stB[4];
    WAIT_V(8);
    __builtin_amdgcn_s_barrier();
    ATT_S(stA, smem)
#pragma unroll 1
    for (int kt = 0; kt < NKT; kt += 2) {
        ATT_STEP(kt, stA, stB)
        ATT_STEP(kt + 1, stB, stA)
    }
#undef ATT_STEP
#undef ATT_SOFTMAX_PV
#undef ATT_S
    h16* YM = (h16*)(ws + OFF_YMIX);
    float l = lrun;
    l += __shfl_xor(l, 16); l += __shfl_xor(l, 32);
    const float inv = 1.0f / l;
    const int tok = qt * 128 + wave * 16 + fr;
    h16* dst = YM + ((size_t)(b * SEQ + tok)) * D + 1024 + hq * 128;
#pragma unroll
    for (int dt = 0; dt < 8; ++dt) store_h4(dst + 16 * dt + 4 * fq, o[dt] * inv);
}

__device__ __forceinline__ void phase_mix(const Params& p, char* smem, int bid, int nblk, int qoff, int probe_n) {
    unsigned* ctl = (unsigned*)(p.ws + OFF_CTL);
    volatile LAS int* sitem = (volatile LAS int*)(smem + GEMM_LDS + 16);
    for (;;) {
        __syncthreads();
        if (threadIdx.x == 0) *sitem = (int)atomicAdd(&ctl[CW_QUEUE + qoff], 1u);
        __syncthreads();
        const int item = *sitem;
        if (item >= 128) break;
        scan_item(p, smem, item);
    }
    const int x0 = (int)(xb_xcc_id() & 7u);
    for (int q = 0; q < 8; ++q) {
        const int pair = (x0 + q) & 7;
        for (;;) {
            __syncthreads();
            if (threadIdx.x == 0) *sitem = (int)atomicAdd(&ctl[CW_AQ + qoff + 16 * pair], 1u);
            __syncthreads();
            const int jj = *sitem;
            if (jj >= 64) break;
            const int item = pair * 64 + jj;
            if (PROBE_PHASE == 61) { _Pragma("unroll 1") for (int r = 0; r < probe_n; ++r) attn_item(p, smem, item); }
            else attn_item(p, smem, item);
        }
    }
}

__device__ __forceinline__ void phase_finish(const Params& p, int bid, int nblk) {
    char* ws = p.ws;
    const int lane = threadIdx.x & 63, wave = threadIdx.x >> 6;
    const h16* Y0 = (const h16*)(ws + OFF_Y0); const h16* Y1 = (const h16*)(ws + OFF_Y1);
    const h16* SR = (const h16*)(ws + OFF_SR); const h16* SV = (const h16*)(ws + OFF_SV); const h16* SG = (const h16*)(ws + OFF_SG);
    const h16* KD0 = (const h16*)(ws + OFF_SKD0); const h16* KD1 = (const h16*)(ws + OFF_SKD1);
    const h16* SKS = (const h16*)(ws + OFF_SKS); const float* k_a = p.in[17];
    h16* YM = (h16*)(ws + OFF_YMIX);
    const float* r_k = p.in[18]; const float* ln_g = p.in[19]; const float* ln_b = p.in[20];
    const int c0 = (lane >> 2) * 64 + (lane & 3) * 16;
    for (int tl = bid * NW + wave; tl < ROWSL; tl += nblk * NW) {
        const int b = tl >> 11, t = tl & 2047;
        const size_t R = (size_t)b * SALL + CTXL + t;
        float y[16], r[16], kb[16], v[16], g[16];
#pragma unroll
        for (int u = 0; u < 4; ++u) {
            const h16x4 a = *(const h16x4*)(Y0 + (size_t)tl * DA + c0 + 4 * u), bb = *(const h16x4*)(Y1 + (size_t)tl * DA + c0 + 4 * u);
            const h16x4 rr = *(const h16x4*)(SR + R * DA + c0 + 4 * u), vv = *(const h16x4*)(SV + R * DA + c0 + 4 * u), gg = *(const h16x4*)(SG + R * DA + c0 + 4 * u);
            const h16x4 k0 = *(const h16x4*)(KD0 + R * DA + c0 + 4 * u), k1 = *(const h16x4*)(KD1 + R * DA + c0 + 4 * u), ksv = *(const h16x4*)(SKS + R * DA + c0 + 4 * u);
            const f32x4 ka4 = *(const f32x4*)(k_a + c0 + 4 * u);
#pragma unroll
            for (int e = 0; e < 4; ++e) { y[4 * u + e] = (float)a[e] + (float)bb[e]; r[4 * u + e] = (float)rr[e]; v[4 * u + e] = (float)vv[e]; g[4 * u + e] = (float)gg[e]; kb[4 * u + e] = (float)ksv[e] * (2.0f + ((float)k0[e] + (float)k1[e] - 2.0f) * ka4[e]); }
        }
        float sm = 0.f, bo = 0.f;
#pragma unroll
        for (int j = 0; j < 16; ++j) { sm += y[j]; bo += r[j] * kb[j] * r_k[c0 + j]; }
        sm += __shfl_xor(sm, 1); sm += __shfl_xor(sm, 2);
        bo += __shfl_xor(bo, 1); bo += __shfl_xor(bo, 2);
        const float mu = sm * (1.0f / 64.0f);
        float vs = 0.f;
#pragma unroll
        for (int j = 0; j < 16; ++j) { const float d = y[j] - mu; vs += d * d; }
        vs += __shfl_xor(vs, 1); vs += __shfl_xor(vs, 2);
        const float rstd = rsqrtf(vs * (1.0f / 64.0f) + 64e-5f);
#pragma unroll
        for (int u = 0; u < 4; ++u) {
            f32x4 ov;
#pragma unroll
            for (int e = 0; e < 4; ++e) { const int j = 4 * u + e; const float yn = (y[j] - mu) * rstd * ln_g[c0 + j] + ln_b[c0 + j]; ov[e] = (yn + bo * v[j]) * g[j]; }
            store_h4(YM + (size_t)tl * D + c0 + 4 * u, ov);
        }
    }
}

__device__ __forceinline__ void phase_gemm_res(const Params& p, char* smem, int bid, int nblk, const h16* A, const h16* Bt, const float* base, int layer) {
    const int MT = ROWSL / 256, NTl = D / 256;
    h16* XH = (h16*)(p.ws + OFF_XH);
    auto sched = [&](int i, g8::Unit& u) {
        const int t = bid + i * nblk;
        if (t >= MT * NTl) return false;
        int tm, tn; tile_order(t, MT, NTl, tm, tn);
        u.a = A + (size_t)(tm * 256) * D; u.b = Bt + (size_t)(tn * 256) * D; u.u0 = tm; u.u1 = tn; u.u2 = 0; u.u3 = 0;
        return true;
    };
    gemm_phase8(smem, D, D, D, sched, [&](const g8::Unit& u, const f32x4 (&acc)[2][2][4][2], int wr, int wc, int fr, int fq) {
        const int tm = u.u0, tn = u.u1;
        const int b = (tm * 256) >> 11;
        const float* gt = modv(p, layer, b, 2);
        f32x4 g4[2][2];
#pragma unroll
        for (int bj = 0; bj < 2; ++bj)
#pragma unroll
            for (int n = 0; n < 2; ++n) g4[bj][n] = *(const f32x4*)(gt + tn * 256 + 128 * bj + 32 * wc + 16 * n + 4 * fq);
#pragma unroll
        for (int ai = 0; ai < 2; ++ai)
#pragma unroll
            for (int m0 = 0; m0 < 4; m0 += 2) {
                f32x4 x[2][2][2];
#pragma unroll
                for (int mm = 0; mm < 2; ++mm)
#pragma unroll
                    for (int bj = 0; bj < 2; ++bj)
#pragma unroll
                        for (int n = 0; n < 2; ++n) {
                            const size_t o = (size_t)(tm * 256 + 128 * ai + 64 * wr + 16 * (m0 + mm) + fr) * D + tn * 256 + 128 * bj + 32 * wc + 16 * n + 4 * fq;
                            if (layer == 0) x[mm][bj][n] = *(const f32x4*)(base + o);
                            else { const h16x4 xh = *(const h16x4*)(XH + o); x[mm][bj][n] = (f32x4){(float)xh[0], (float)xh[1], (float)xh[2], (float)xh[3]}; }
                        }
#pragma unroll
                for (int mm = 0; mm < 2; ++mm)
#pragma unroll
                    for (int bj = 0; bj < 2; ++bj)
#pragma unroll
                        for (int n = 0; n < 2; ++n) {
                            const size_t o = (size_t)(tm * 256 + 128 * ai + 64 * wr + 16 * (m0 + mm) + fr) * D + tn * 256 + 128 * bj + 32 * wc + 16 * n + 4 * fq;
                            store_h4(XH + o, x[mm][bj][n] + g4[bj][n] * acc[ai][bj][m0 + mm][n]);
                        }
            }
    });
}

__device__ __forceinline__ void phase_route(const Params& p, char* smem, int bid, int nblk, int layer, int slot) {
    char* ws = p.ws;
    const int lane = threadIdx.x & 63, wave = threadIdx.x >> 6;
    const int fr = lane & 15, g = lane >> 4;
    h16* TOK = (h16*)(ws + OFF_H);
    unsigned* cnt = (unsigned*)(ws + OFF_CTL) + CW_CNT + slot * 1024;
    int* LIST = (int*)(ws + OFF_LIST) + (size_t)slot * 16 * 8192;
    float* GW = (float*)(ws + OFF_GW) + (size_t)slot * 16384;
    const int vb = wave >> 2, w4 = wave & 3;
    const int kq = w4 * 512 + 8 * g;
    const float* gn = p.in[7] + layer * D + kq;
    const float* rb = p.in[26];
    const h16* RWH = (const h16*)(ws + OFF_RWH) + fr * 2048 + kq;
    const h16* RWL = (const h16*)(ws + OFF_RWL) + fr * 2048 + kq;
    float* red = (float*)smem + vb * (4 * 64 * 8 + 64);
    float* ssp = red + 4 * 64 * 8;
    for (int u0 = bid * 2; u0 < ROWSL / 16; u0 += nblk * 2) {
        const int unit = u0 + vb;
        const int tl = unit * 16 + fr;
        const int b = tl >> 11;
        const h16* xr = (const h16*)(p.ws + OFF_XH) + (size_t)tl * D + kq;
        const float* sh = modv(p, layer, b, 3) + kq; const float* sc = modv(p, layer, b, 4) + kq;
        float ss = 0.f;
#pragma unroll
        for (int i = 0; i < 16; ++i) {
            const h16x8 a = *(const h16x8*)(xr + 32 * i);
#pragma unroll
            for (int e = 0; e < 8; ++e) { const float f = (float)a[e]; ss += f * f; }
        }
        ss += __shfl_xor(ss, 16); ss += __shfl_xor(ss, 32);
        __syncthreads();
        if (g == 0) ssp[w4 * 16 + fr] = ss;
        __syncthreads();
        const float tot = ssp[fr] + ssp[16 + fr] + ssp[32 + fr] + ssp[48 + fr];
        const float rstd = rsqrtf(tot * (1.0f / D) + 1e-6f);
        f32x4 am = {0.f, 0.f, 0.f, 0.f}, ac = {0.f, 0.f, 0.f, 0.f};
        h16* trow = TOK + (size_t)tl * D + kq;
        h16x8 px[3]; f32x4 pg[3][2], pc[3][2], ph[3][2]; h16x8 pwh[3], pwl[3];
#define ROUTE_LOAD(slot, it) { const int k_ = 32 * (it); px[slot] = *(const h16x8*)(xr + k_); \
            pg[slot][0] = *(const f32x4*)(gn + k_); pg[slot][1] = *(const f32x4*)(gn + k_ + 4); \
            pc[slot][0] = *(const f32x4*)(sc + k_); pc[slot][1] = *(const f32x4*)(sc + k_ + 4); ph[slot][0] = *(const f32x4*)(sh + k_); ph[slot][1] = *(const f32x4*)(sh + k_ + 4); \
            pwh[slot] = *(const h16x8*)(RWH + k_); pwl[slot] = *(const h16x8*)(RWL + k_); }
        ROUTE_LOAD(0, 0) ROUTE_LOAD(1, 1)
#pragma unroll
        for (int i = 0; i < 16; ++i) {
            if (i + 2 < 16) ROUTE_LOAD((i + 2) % 3, i + 2)
            const int cs = i % 3;
            h16x8 yh, yl;
#pragma unroll
            for (int hh = 0; hh < 2; ++hh) {
                const f32x4 xq = {(float)px[cs][4 * hh], (float)px[cs][4 * hh + 1], (float)px[cs][4 * hh + 2], (float)px[cs][4 * hh + 3]};
                const f32x4 y = (xq * rstd) * pg[cs][hh] * (pc[cs][hh] + 1.0f) + ph[cs][hh];
#pragma unroll
                for (int e = 0; e < 4; ++e) { const h16 hv = (h16)y[e]; yh[4 * hh + e] = hv; yl[4 * hh + e] = (h16)((y[e] - (float)hv) * 4096.0f); }
            }
            *(h16x8*)(trow + 32 * i) = yh;
            am = mfma32(pwh[cs], yh, am); ac = mfma32(pwl[cs], yh, ac); ac = mfma32(pwh[cs], yl, ac);
        }
#undef ROUTE_LOAD
        *(f32x4*)(red + (w4 * 64 + lane) * 8) = am; *(f32x4*)(red + (w4 * 64 + lane) * 8 + 4) = ac;
        __syncthreads();
        if (w4 == 0) {
            f32x4 sm = {0.f, 0.f, 0.f, 0.f}, scn = {0.f, 0.f, 0.f, 0.f};
#pragma unroll
            for (int w = 0; w < 4; ++w) { sm += *(const f32x4*)(red + (w * 64 + lane) * 8); scn += *(const f32x4*)(red + (w * 64 + lane) * 8 + 4); }
            float sv[4], sel[4];
#pragma unroll
            for (int e = 0; e < 4; ++e) { sv[e] = sigmoidf_(sm[e] + scn[e] * (1.0f / 4096.0f)); sel[e] = sv[e] + rb[4 * g + e]; }
            float m1 = -1e30f, m2 = -1e30f;
#pragma unroll
            for (int e = 0; e < 4; ++e) { const float v = sel[e]; if (v > m1) { m2 = m1; m1 = v; } else if (v > m2) m2 = v; }
            float bs = m1 + m2; int bg = g;
#pragma unroll
            for (int o = 16; o <= 32; o <<= 1) {
                const float os = __shfl_xor(bs, o); const int og = __shfl_xor(bg, o);
                if (os > bs || (os == bs && og < bg)) { bs = os; bg = og; }
            }
            int e0 = -1, e1 = -1; float w0 = 0.f, w1 = 0.f;
            if (bg == g) {
                int i0 = 0, i1 = 0; float v0 = -1e30f, v1 = -1e30f, s0 = 0.f, s1 = 0.f;
#pragma unroll
                for (int e = 0; e < 4; ++e) { if (sel[e] > v0) { v0 = sel[e]; i0 = e; s0 = sv[e]; } }
#pragma unroll
                for (int e = 0; e < 4; ++e) { if (e != i0 && sel[e] > v1) { v1 = sel[e]; i1 = e; s1 = sv[e]; } }
                const float inv = 1.0f / (s0 + s1);
                e0 = 4 * g + i0; e1 = 4 * g + i1; w0 = s0 * inv; w1 = s1 * inv;
            }
            const unsigned long long lt = (1ull << lane) - 1ull;
            int mycount = 0, rank0 = 0, rank1 = 0;
#pragma unroll
            for (int e = 0; e < 16; ++e) {
                const unsigned long long m0 = __ballot(e0 == e), m1 = __ballot(e1 == e);
                const int c0 = __popcll(m0), c1 = __popcll(m1);
                if (lane == e) mycount = c0 + c1;
                if (e0 == e) rank0 = __popcll(m0 & lt);
                if (e1 == e) rank1 = c0 + __popcll(m1 & lt);
            }
            unsigned base = 0;
            if (lane < 16 && mycount > 0) base = atomicAdd(&cnt[lane * 64], (unsigned)mycount);
            const unsigned b0 = __shfl(base, e0 < 0 ? 0 : e0), b1 = __shfl(base, e1 < 0 ? 0 : e1);
            if (e0 >= 0) {
                LIST[e0 * 8192 + b0 + rank0] = tl * 2;
                GW[tl * 2] = w0;
                LIST[e1 * 8192 + b1 + rank1] = tl * 2 + 1;
                GW[tl * 2 + 1] = w1;
            }
        }
    }
    __syncthreads();
}

__device__ __forceinline__ void phase_moe(const Params& p, char* smem, int layer, int dslot) {
    char* ws = p.ws;
    const int tid = threadIdx.x;
    unsigned* ctl = (unsigned*)(ws + OFF_CTL);
    const unsigned* cntp = ctl + CW_CNT + layer * 1024;
    unsigned* queue = ctl + CW_MQ + layer * 64;
    unsigned* dep = ctl + CW_DEP + dslot * 256;
    const int* LIST = (const int*)(ws + OFF_LIST) + (size_t)layer * 16 * 8192;
    const float* GW = (const float*)(ws + OFF_GW) + (size_t)layer * 16384;
    const h16* TOK = (const h16*)(ws + OFF_H);
    h16* U = (h16*)(ws + OFF_U);
    h16* SLOT = (h16*)(ws + OFF_SLOT);
    volatile LAS int* sitem = (volatile LAS int*)(smem + GEMM_LDS + 16);
    int MT = 0;
    int cn[16];
#pragma unroll
    for (int e = 0; e < 16; ++e) cn[e] = __builtin_amdgcn_readfirstlane((int)cntp[e * 64]);
#pragma unroll
    for (int e = 0; e < 16; ++e) MT += (cn[e] + 255) >> 8;
    const int n1 = MT * 4, n2 = MT * 8;
    (void)queue; (void)sitem;
    const int G = (int)gridDim.x, bidx = (int)blockIdx.x;
    const int r1 = (n1 > G) ? (n1 % G) : 0;
    const int nlight = G - r1;
    const int my2 = (bidx >= r1) ? (n2 - (bidx - r1) + nlight - 1) / nlight : 0;
    auto locate = [&](int m, int& e, int& tm, int& off, int& c) {
        int mb = 0; e = 0; off = 0; c = 0;
        bool found = false;
#pragma unroll
        for (int ee = 0; ee < 16; ++ee) {
            const int cc = cn[ee]; const int mt = (cc + 255) >> 8;
            if (!found) { if (m >= mb + mt) { mb += mt; off += cc; } else { e = ee; c = cc; found = true; } }
        }
        tm = m - mb;
    };
    {
        auto sched = [&](int i, g8::Unit& u) {
            const int item = bidx + i * G;
            if (item >= n1) return false;
            const int m = item >> 2, tn = item & 3;
            int e, tm, off, c; locate(m, e, tm, off, c);
            u.a = nullptr; u.b = (const h16*)(ws + OFF_EXP + layer * EXP_L) + ((size_t)e * 1024 + tn * 256) * 2048;
            u.u0 = e; u.u1 = tm; u.u2 = tn | (m << 8); u.u3 = off; u.u4 = c;
            return true;
        };
        auto rowoff = [&](const g8::Unit& u, int r) {
            const int c = u.u4;
            int idx = u.u1 * 256 + r; idx = idx < c ? idx : c - 1;
            return (unsigned)(LIST[u.u0 * 8192 + idx] >> 1) * (unsigned)(D * 2);
        };
        gemm_phase8g<0>(smem, TOK, 2048, D, sched, rowoff, [&](const g8::Unit& u, const f32x4 (&acc)[2][2][4][2], int wr, int wc, int fr, int fq) {
            const int e = u.u0, tm = u.u1, tn = u.u2 & 255, m = u.u2 >> 8, off = u.u3;
            const int c = u.u4;
#pragma unroll
            for (int ai = 0; ai < 2; ++ai)
#pragma unroll
                for (int mm = 0; mm < 4; ++mm) {
                    const int idx = tm * 256 + 128 * ai + 64 * wr + 16 * mm + fr;
                    if (idx < c) {
#pragma unroll
                        for (int bj = 0; bj < 2; ++bj) {
                            const f32x4 g = acc[ai][bj][mm][0], up = acc[ai][bj][mm][1];
                            f32x4 o;
#pragma unroll
                            for (int q = 0; q < 4; ++q) o[q] = fsilu_(g[q]) * up[q];
                            const int col = 16 * (8 * tn + 4 * bj + wc) + 4 * fq;
                            const h16x4 oh = cvt4(o);
                            __hip_atomic_store((unsigned long long*)(U + (size_t)(off + idx) * DEXP + col), __builtin_bit_cast(unsigned long long, oh), __ATOMIC_RELAXED, __HIP_MEMORY_SCOPE_AGENT);
                        }
                    }
                }
            asm volatile("s_waitcnt vmcnt(0)" ::: "memory");
            if ((threadIdx.x & 63) == 0) __hip_atomic_fetch_add(&dep[m], 1u, __ATOMIC_RELAXED, __HIP_MEMORY_SCOPE_AGENT);
        });
    }
    const int mearly = (n1 > G) ? (G >> 2) : MT;
    const int nearly_all = (mearly * 8 < n2) ? mearly * 8 : n2;
    const int iearly = (bidx >= r1 && nearly_all > bidx - r1) ? (nearly_all - (bidx - r1) + nlight - 1) / nlight : 0;
    auto wait_dep = [&](int m) {
        if ((tid & 63) == 0) {
            unsigned sp = 0;
            while (__hip_atomic_load(&dep[m], __ATOMIC_RELAXED, __HIP_MEMORY_SCOPE_AGENT) < 32u) {
                __builtin_amdgcn_s_sleep(2);
                if (++sp > (1u << 24)) { atomicAdd(&ctl[CW_TMO], 1u); break; }
            }
        }
    };
    auto rowoff2 = [&](const g8::Unit& u, int r) {
        int idx = u.u1 * 256 + r; idx = idx < u.u4 ? idx : u.u4 - 1;
        return (unsigned)(u.u3 + idx) * (unsigned)(DEXP * 2);
    };
    auto epi2 = [&](const g8::Unit& u, const f32x4 (&acc)[2][2][4][2], int wr, int wc, int fr, int fq) {
        const int e = u.u0, tm = u.u1, tn = u.u2, c = u.u4;
        const int* lst = LIST + e * 8192;
        int entry[8]; float gw[8];
#pragma unroll
        for (int q = 0; q < 8; ++q) { int idx = tm * 256 + 128 * (q >> 2) + 64 * wr + 16 * (q & 3) + fr; idx = idx < c ? idx : c - 1; entry[q] = lst[idx]; }
#pragma unroll
        for (int q = 0; q < 8; ++q) gw[q] = GW[entry[q]];
#pragma unroll
        for (int ai = 0; ai < 2; ++ai)
#pragma unroll
            for (int mm = 0; mm < 4; ++mm) {
                const int idx = tm * 256 + 128 * ai + 64 * wr + 16 * mm + fr;
                if (idx < c) {
                    h16* dst = SLOT + (size_t)entry[ai * 4 + mm] * D + tn * 256 + 32 * wc + 4 * fq;
#pragma unroll
                    for (int bj = 0; bj < 2; ++bj)
#pragma unroll
                        for (int n = 0; n < 2; ++n) store_h4(dst + 128 * bj + 16 * n, acc[ai][bj][mm][n] * gw[ai * 4 + mm]);
                }
            }
    };
#pragma unroll 1
    for (int pass = 0; pass < 2; ++pass) {
        const int ibeg = pass ? iearly : 0, iend = pass ? my2 : iearly;
        auto sched2 = [&](int i, g8::Unit& u) {
            const int it = ibeg + i;
            if (it >= iend) return false;
            const int item = (bidx - r1) + it * nlight;
            const int m = item >> 3, tn = item & 7;
            int e, tm, off, c; locate(m, e, tm, off, c);
            wait_dep(m);
            u.a = nullptr; u.b = (const h16*)(ws + OFF_EXP + layer * EXP_L + EGU_BYTES) + ((size_t)e * 2048 + tn * 256) * 512;
            u.u0 = e; u.u1 = tm; u.u2 = tn; u.u3 = off; u.u4 = c;
            return true;
        };
        gemm_phase8g<0>(smem, U, 512, DEXP, sched2, rowoff2, epi2);
    }
}

template <bool FINAL>
__device__ __forceinline__ float combine_row(const Params& p, int layer, int tl, f32x4 (&x)[8]) {
    const int lane = threadIdx.x & 63;
    const h16* SLOT = (const h16*)(p.ws + OFF_SLOT);
    const int b = tl >> 11;
    h16* xr = (h16*)(p.ws + OFF_XH) + (size_t)tl * D;
    float* outr = p.out + (size_t)tl * D;
    const float* gt2 = modv(p, layer, b, 5);
    float ss = 0.f;
#pragma unroll
    for (int i = 0; i < 8; ++i) {
        const int k = i * 256 + lane * 4;
        const h16x4 xh = *(const h16x4*)(xr + k);
        const f32x4 xv = {(float)xh[0], (float)xh[1], (float)xh[2], (float)xh[3]}, g = *(const f32x4*)(gt2 + k);
        const h16x4 s0 = *(const h16x4*)(SLOT + (size_t)(2 * tl) * D + k), s1 = *(const h16x4*)(SLOT + (size_t)(2 * tl + 1) * D + k);
        f32x4 f;
#pragma unroll
        for (int e = 0; e < 4; ++e) f[e] = (float)s0[e] + (float)s1[e];
        x[i] = xv + g * f;
        if (FINAL) *(f32x4*)(outr + k) = x[i]; else store_h4(xr + k, x[i]);
        ss += x[i][0] * x[i][0] + x[i][1] * x[i][1] + x[i][2] * x[i][2] + x[i][3] * x[i][3];
    }
    return wave_sum(ss);
}
__device__ __forceinline__ void phase_combine_final(const Params& p, int bid, int nblk, int layer) {
    const int wave = threadIdx.x >> 6;
    for (int tl = bid * NW + wave; tl < ROWSL; tl += nblk * NW) { f32x4 x[8]; (void)combine_row<true>(p, layer, tl, x); }
}
__device__ __forceinline__ void phase_combine_fold(const Params& p, int bid, int nblk) {
    char* ws = p.ws;
    const int lane = threadIdx.x & 63, wave = threadIdx.x >> 6;
    h16* HF = (h16*)(ws + OFF_H);
    float* HNY = (float*)(ws + OFF_HNY);
    const float* gn = p.in[6] + D;
    for (int u = bid * NW + wave; u < NB * 1025; u += nblk * NW) {
        const int b = u / 1025, t = u - b * 1025;
        const float* sh = modv(p, 1, b, 0); const float* sc = modv(p, 1, b, 1);
        f32x4 xa[8];
        const float ssa = combine_row<false>(p, 0, b * SEQ + t, xa);
        const float ra = rsqrtf(ssa * (1.0f / D) + 1e-6f);
        const bool paired = (t >= 1 && t <= 1023);
        f32x4 xb[8]; float rb2 = 0.f;
        if (paired) { const float ssb = combine_row<false>(p, 0, b * SEQ + (SEQ - t), xb); rb2 = rsqrtf(ssb * (1.0f / D) + 1e-6f); }
#pragma unroll
        for (int i = 0; i < 8; ++i) {
            const int k = i * 256 + lane * 4;
            const f32x4 g = *(const f32x4*)(gn + k), c1 = *(const f32x4*)(sc + k), h1 = *(const f32x4*)(sh + k);
            const f32x4 ha = (xa[i] * ra) * g * (c1 + 1.0f) + h1;
            if (paired) {
                const f32x4 hb = (xb[i] * rb2) * g * (c1 + 1.0f) + h1;
                store_h4(HF + (size_t)(b * SEQ + t) * D + k, ha + hb);
                store_h4(HF + (size_t)(b * SEQ + 1024 + t) * D + k, ha - hb);
            } else if (t == 0) {
                store_h4(HF + (size_t)(b * SEQ) * D + k, ha);
                store_h4(HF + (size_t)(b * SEQ + 1024) * D + k, (f32x4){0.f, 0.f, 0.f, 0.f});
            } else {
                *(f32x4*)(HNY + (size_t)b * D + k) = ha;
            }
        }
    }
}

__device__ __forceinline__ void phase_dft_c(const Params& p, char* smem, int bid, int nblk) {
    char* ws = p.ws;
    const h16* DC = (const h16*)(ws + OFF_DC);
    const h16* HF = (const h16*)(ws + OFF_H);
    h16* ZT = (h16*)(ws + OFF_ZT);
    {
        const float* HNY = (const float*)(ws + OFF_HNY);
        float* VNY = (float*)(ws + OFF_VNY);
        for (int i = bid * NT + threadIdx.x; i < NB * D; i += nblk * NT) {
            const int b = i >> 11, gg = (i >> 8) & 7, n = i & 255;
            const float* hr = HNY + (size_t)b * D + gg * 256;
            const h16* dr = DC + (size_t)n * 256;
            float a = 0.f;
#pragma unroll 8
            for (int c = 0; c < 256; ++c) a += hr[c] * (float)dr[c];
            VNY[i] = a * 0.022097086912079608f;
        }
    }
    {
        auto sched = [&](int i, g8::Unit& u) {
            const int t = bid + i * nblk;
            if (t >= 32 * 8) return false;
            const int bg = t >> 3, tn = t & 7;
            const int b = bg >> 3, g = bg & 7;
            u.a = DC + (size_t)((tn < 4) ? 0 : 256) * 256; u.b = HF + (size_t)(b * SEQ + tn * 256) * D + g * 256; u.u0 = b; u.u1 = g; u.u2 = tn; u.u3 = 0;
            return true;
        };
        gemm_phase8(smem, 256, D, 256, sched, [&](const g8::Unit& u, const f32x4 (&acc)[2][2][4][2], int wr, int wc, int fr, int fq) {
            const int b = u.u0, g = u.u1, tn = u.u2;
            acc8_foreach(acc, wr, wc, fr, fq, [&](int r, int c, f32x4 v) { store_h4(ZT + ((size_t)(b * 2048 + g * 256 + r)) * 2048 + tn * 256 + c, v); });
        });
    }
}
__device__ __forceinline__ void phase_dft_t(const Params& p, char* smem, int bid, int nblk) {
    char* ws = p.ws;
    const h16* DT = (const h16*)(ws + OFF_DT);
    const h16* ZT = (const h16*)(ws + OFF_ZT);
    const float* VNY = (const float*)(ws + OFF_VNY);
    h16* FB = (h16*)(ws + OFF_YMIX);
    auto sched = [&](int i, g8::Unit& u) {
        const int t = bid + i * nblk;
        if (t >= 4 * 64) return false;
        const int b = t >> 6, r8 = t & 63;
        int tm, tn; tile_order(r8, 8, 8, tm, tn);
        u.a = DT + (size_t)(tm * 256) * 2048; u.b = ZT + ((size_t)(b * 2048 + tn * 256)) * 2048; u.u0 = b; u.u1 = tm; u.u2 = tn; u.u3 = 0;
        return true;
    };
    gemm_phase8(smem, 2048, 2048, 2048, sched, [&](const g8::Unit& u, const f32x4 (&acc)[2][2][4][2], int wr, int wc, int fr, int fq) {
        const int b = u.u0, tm = u.u1, tn = u.u2;
        f32x4 ny4[2][2];
#pragma unroll
        for (int bj = 0; bj < 2; ++bj)
#pragma unroll
            for (int n = 0; n < 2; ++n) ny4[bj][n] = *(const f32x4*)(VNY + (size_t)b * D + tn * 256 + 128 * bj + 32 * wc + 16 * n + 4 * fq);
#pragma unroll
        for (int ai = 0; ai < 2; ++ai)
#pragma unroll
            for (int bj = 0; bj < 2; ++bj)
#pragma unroll
                for (int m = 0; m < 4; ++m)
#pragma unroll
                    for (int n = 0; n < 2; ++n) {
                        const int r = 128 * ai + 64 * wr + 16 * m + fr, c = 128 * bj + 32 * wc + 16 * n + 4 * fq;
                        const float sg = (r & 1) ? -1.0f : 1.0f;
                        store_h4(FB + (size_t)(b * SEQ + tm * 256 + r) * D + tn * 256 + c, acc[ai][bj][m][n] + ny4[bj][n] * sg);
                    }
    });
}

__global__ void __launch_bounds__(NT, 2) mk_forward(Params p, int ph_lo, int ph_hi, int probe_k, int probe_n) {
    __shared__ __attribute__((aligned(16))) char smem[GEMM_LDS + 64];
    const int bid = blockIdx.x, nblk = gridDim.x;
    volatile LAS unsigned* bst = (volatile LAS unsigned*)(smem + GEMM_LDS);
    XcdBarrier xb;
    const bool need_bar = (ph_hi - ph_lo) > 1;
    if (need_bar) {
        if (threadIdx.x == 0) { bst[0] = 0u; bst[1] = 0u; }
        __syncthreads();
        xb = xcd_barrier_post((unsigned*)(p.ws + OFF_CTL), bst);
    }
#define PHASE(k, call) if (ph_lo <= (k) && (k) < ph_hi) { \
        if ((k) == PROBE_PHASE) { _Pragma("unroll 1") for (int rep = 0; rep < probe_n; ++rep) { call; if (rep + 1 < probe_n) xcd_barrier(xb); } } \
        else { const int rep = 0; (void)rep; call; } \
        if ((k) + 1 < ph_hi) xcd_barrier(xb); }
    PHASE(0, phase_prologue(p, smem, bid, nblk))
    PHASE(1, phase_norm0(p, smem, bid, nblk))
    PHASE(2, phase_gemm_in(p, smem, bid, nblk))
    PHASE(3, phase_prep(p, smem, bid, nblk))
    PHASE(4, phase_lora(p, smem, bid, nblk))
    PHASE(5, phase_chunkprep(p, smem, bid, nblk))
    PHASE(6, phase_mix(p, smem, bid, nblk, rep * 128, probe_n))
    PHASE(7, { phase_finish(p, bid, nblk); phase_conv_experts(p, smem, bid, nblk, 1); })
    PHASE(8, phase_gemm_res(p, smem, bid, nblk, (const h16*)(p.ws + OFF_YMIX), (const h16*)(p.ws + OFF_WOUT), p.in[0], 0))
    PHASE(9, phase_route(p, smem, bid, nblk, 0, 0 + 2 * rep))
    PHASE(10, phase_moe(p, smem, 0, 0 + 2 * rep))
    PHASE(11, phase_combine_fold(p, bid, nblk))
    PHASE(12, phase_dft_c(p, smem, bid, nblk))
    PHASE(13, phase_dft_t(p, smem, bid, nblk))
    PHASE(14, phase_gemm_res(p, smem, bid, nblk, (const h16*)(p.ws + OFF_YMIX), (const h16*)(p.ws + OFF_FW), p.out, 1))
    PHASE(15, phase_route(p, smem, bid, nblk, 1, 1 + 2 * rep))
    PHASE(16, phase_moe(p, smem, 1, 1 + 2 * rep))
    PHASE(17, phase_combine_final(p, bid, nblk, 1))
#undef PHASE
}

extern "C" void kernel_launch(void* const* d_in, const int* in_sizes, int n_in, void* d_out, int out_size, void* d_ws, size_t ws_size, hipStream_t stream) {
    static int grid = 0;
    if (grid == 0) {
        if (n_in != 30 || ws_size < WS_END) { fprintf(stderr, "kernel_launch: need 30 inputs and %zu bytes of workspace (got %d, %zu)\n", (size_t)WS_END, n_in, ws_size); grid = -1; return; }
        int dev = 0, cus = 0, per_cu = 0;
        hipGetDevice(&dev);
        hipDeviceGetAttribute(&cus, hipDeviceAttributeMultiprocessorCount, dev);
        hipOccupancyMaxActiveBlocksPerMultiprocessor(&per_cu, (const void*)mk_forward, NT, 0);
        if (per_cu < 1) { fprintf(stderr, "kernel_launch: occupancy query returned %d\n", per_cu); grid = -1; return; }
        if (per_cu > 1) per_cu = 1;
        grid = cus * per_cu;
    }
    if (grid < 0) return;
    hipMemsetAsync((char*)d_ws + OFF_CTL, 0, CTL_BYTES, stream);
    Params p{};
    for (int i = 0; i < 30; ++i) p.in[i] = (const float*)d_in[i];
    p.out = (float*)d_out; p.ws = (char*)d_ws;
#if MULTI_LAUNCH
    for (int ph = 0; ph < NPHASE; ++ph) hipLaunchKernelGGL(mk_forward, dim3(grid), dim3(NT), 0, stream, p, ph, ph + 1, -1, 1);
#else
    int lo = 0, hi = NPHASE, pk = PROBE_PHASE, pn = 2;
    void* args[] = {&p, &lo, &hi, &pk, &pn};
    hipError_t e = hipLaunchCooperativeKernel((const void*)mk_forward, dim3(grid), dim3(NT), args, 0, stream);
    if (e != hipSuccess) fprintf(stderr, "cooperative launch failed: %s (grid %d)\n", hipGetErrorString(e), grid);
#endif
}
```

```cpp
#include <hip/hip_runtime.h>
#include <cstdio>
#include <cstdint>

#ifndef PROBE_PHASE
#define PROBE_PHASE -1
#endif
#ifndef MULTI_LAUNCH
#define MULTI_LAUNCH 0
#endif

typedef _Float16 h16;
typedef _Float16 h16x2 __attribute__((ext_vector_type(2)));
typedef _Float16 h16x4 __attribute__((ext_vector_type(4)));
typedef _Float16 h16x8 __attribute__((ext_vector_type(8)));
typedef float f32x4 __attribute__((ext_vector_type(4)));
typedef unsigned u32x4 __attribute__((ext_vector_type(4)));
typedef __bf16 b16x8 __attribute__((ext_vector_type(8)));
#define LAS __attribute__((address_space(3)))

constexpr int D = 2048, NB = 4, SEQ = 2048, CTXL = 256, SALL = SEQ + CTXL;
constexpr int ROWS0 = NB * SALL;
constexpr int ROWSL = NB * SEQ;
constexpr int DA = 1024, HA = 16;
constexpr int A_COLS = 3328, IN_COLS = 4864;
constexpr int NEXP = 16, DEXP = 512;
constexpr int NT = 512;
constexpr int NW = NT / 64;
constexpr int NPHASE = 18;

constexpr size_t OFF_CTL   = 0;
constexpr size_t CTL_BYTES = 65536;
constexpr size_t OFF_MODP  = OFF_CTL + CTL_BYTES;
constexpr size_t OFF_MOD   = OFF_MODP + (size_t)16 * 2 * 5 * 12288 * 4;
constexpr size_t OFF_ROPE  = OFF_MOD + (size_t)2 * 5 * 12288 * 4;
constexpr size_t OFF_WIN   = OFF_ROPE + (size_t)2048 * 64 * 2 * 4;
constexpr size_t OFF_WOUT  = OFF_WIN + (size_t)IN_COLS * D * 2;
constexpr size_t OFF_FW    = OFF_WOUT + (size_t)D * D * 2;
constexpr size_t OFF_W2T   = OFF_FW + (size_t)D * D * 2;
constexpr size_t OFF_A2T   = OFF_W2T + (size_t)2048 * 64 * 2;
constexpr size_t OFF_G2T   = OFF_A2T + (size_t)2048 * 64 * 2;
constexpr size_t OFF_EXP   = OFF_G2T + (size_t)1024 * 128 * 2;
constexpr size_t EGU_BYTES = (size_t)16 * 1024 * 2048 * 2;
constexpr size_t ED_BYTES  = (size_t)16 * 2048 * 512 * 2;
constexpr size_t EXP_L     = EGU_BYTES + ED_BYTES;
constexpr size_t OFF_DT    = OFF_EXP + 2 * EXP_L;
constexpr size_t OFF_DC    = OFF_DT + (size_t)2048 * 4096 * 2;
constexpr size_t OFF_RWH   = OFF_DC + (size_t)512 * 256 * 2;
constexpr size_t OFF_RWL   = OFF_RWH + (size_t)16 * 2048 * 2;
constexpr size_t OFF_H     = OFF_RWL + (size_t)16 * 2048 * 2;
constexpr size_t OFF_P     = OFF_H + (size_t)ROWS0 * D * 2;
constexpr size_t P_BYTES   = (size_t)ROWS0 * IN_COLS * 2;
constexpr size_t OFF_SLOT  = OFF_P;
constexpr size_t OFF_U     = OFF_P + (size_t)16384 * 2048 * 2;
constexpr size_t OFF_STR   = OFF_P + P_BYTES;
constexpr size_t STR16     = (size_t)ROWS0 * DA * 2;
constexpr size_t STR32     = (size_t)ROWS0 * DA * 4;
constexpr size_t OFF_SR    = OFF_STR;
constexpr size_t OFF_SV    = OFF_SR + STR16;
constexpr size_t OFF_SKS   = OFF_SV + STR16;
constexpr size_t OFF_SKK   = OFF_SKS + STR16;
constexpr size_t OFF_SG    = OFF_SKK + STR16;
constexpr size_t OFF_SKD0  = OFF_SG + STR16;
constexpr size_t OFF_SKD1  = OFF_SKD0 + STR16;
constexpr size_t OFF_SB0   = OFF_SKD1 + STR16;
constexpr size_t OFF_SB1   = OFF_SB0 + STR16;
constexpr size_t OFF_SW0   = OFF_SB1 + STR16;
constexpr size_t OFF_SW1   = OFF_SW0 + STR32;
constexpr size_t STR_END   = OFF_SW1 + STR32;
constexpr size_t OFF_Y0    = OFF_SW0;
constexpr size_t OFF_Y1    = OFF_SW0 + (size_t)ROWSL * DA * 4;
static_assert(OFF_Y1 + (size_t)ROWSL * DA * 4 <= STR_END, "y must fit in the decay streams");
constexpr int NCHUNK = SALL / 16;
constexpr int REC_BYTES = 10496;
constexpr size_t FRAG_DIR_BYTES = (size_t)64 * NCHUNK * REC_BYTES;
constexpr size_t OFF_FRAG0 = OFF_H;
constexpr size_t OFF_FRAG1 = OFF_EXP + EXP_L;
static_assert(OFF_FRAG0 + FRAG_DIR_BYTES <= OFF_STR, "frag0 must fit in h|p");
static_assert(FRAG_DIR_BYTES <= EXP_L, "frag1 must fit in the layer-1 expert region");
constexpr size_t OFF_ZT    = OFF_STR;
constexpr size_t OFF_F     = STR_END;
constexpr size_t OFF_Q     = OFF_F + (size_t)ROWS0 * 256 * 2;
constexpr size_t OFF_KB    = OFF_Q + (size_t)NB * 8 * SEQ * 128 * 2;
constexpr size_t OFF_VT    = OFF_KB + (size_t)NB * 2 * SALL * 128 * 2;
constexpr size_t OFF_YMIX  = OFF_VT + (size_t)NB * 2 * 128 * SALL * 2;
constexpr size_t OFF_LIST  = OFF_YMIX + (size_t)ROWSL * D * 2;
constexpr int NLIST = (PROBE_PHASE == 9 || PROBE_PHASE == 15) ? 4 : 2;
constexpr size_t OFF_GW    = OFF_LIST + (size_t)NLIST * 16 * 8192 * 4;
constexpr size_t OFF_HNY   = OFF_GW + (size_t)NLIST * 16384 * 4;
constexpr size_t OFF_VNY   = OFF_HNY + (size_t)NB * D * 4;
constexpr size_t OFF_XH    = OFF_VNY + (size_t)NB * D * 4;
constexpr size_t OFF_VB    = OFF_XH + (size_t)ROWSL * D * 2;
constexpr size_t WS_END    = OFF_VB + (size_t)NB * 2 * SALL * 128 * 2;
static_assert(WS_END <= (size_t)754818112, "workspace budget (sum of the inputs)");
static_assert(OFF_U + (size_t)16384 * 512 * 2 <= OFF_P + P_BYTES, "slot+u must fit in p");
static_assert((size_t)NB * 2048 * 2048 * 2 <= STR_END - OFF_STR, "zt must fit in streams");

constexpr int CW_QUEUE = 4000;
constexpr int CW_AQ    = 10000;
constexpr int CW_ADONE = 10200;
constexpr int CW_POOL  = 10264;
constexpr int CW_GDONE = 10296;
constexpr int CW_MDONE = 10328;
constexpr int CW_POOL2 = 10392;
constexpr int CW_MQ    = 8192;
constexpr int CW_DEP   = 8448;
constexpr int CW_TMO   = 9600;
constexpr int CW_CNT   = 4096;

struct Params { const float* in[30]; float* out; char* ws; };

__device__ __forceinline__ float row16_sum(float v) {
    v += __int_as_float(__builtin_amdgcn_update_dpp(0, __float_as_int(v), 0xB1, 0xF, 0xF, true));
    v += __int_as_float(__builtin_amdgcn_update_dpp(0, __float_as_int(v), 0x4E, 0xF, 0xF, true));
    v += __int_as_float(__builtin_amdgcn_update_dpp(0, __float_as_int(v), 0x124, 0xF, 0xF, true));
    v += __int_as_float(__builtin_amdgcn_update_dpp(0, __float_as_int(v), 0x128, 0xF, 0xF, true));
    return v;
}
__device__ __forceinline__ float wave_sum(float v) {
    v = row16_sum(v);
    const int i = __float_as_int(v);
    return (__int_as_float(__builtin_amdgcn_readlane(i, 0)) + __int_as_float(__builtin_amdgcn_readlane(i, 16))) +
           (__int_as_float(__builtin_amdgcn_readlane(i, 32)) + __int_as_float(__builtin_amdgcn_readlane(i, 48)));
}
__device__ __forceinline__ float sigmoidf_(float x) { return 1.0f / (1.0f + expf(-x)); }
__device__ __forceinline__ float siluf_(float x) { return x / (1.0f + expf(-x)); }
__device__ __forceinline__ float fexp_(float x) { return __builtin_amdgcn_exp2f(x * 1.4426950408889634f); }
__device__ __forceinline__ float fsigmoid_(float x) { return __builtin_amdgcn_rcpf(1.0f + fexp_(-x)); }
__device__ __forceinline__ float fsilu_(float x) { return x * fsigmoid_(x); }
__device__ __forceinline__ float ftanh_(float x) { return 1.0f - 2.0f * __builtin_amdgcn_rcpf(1.0f + fexp_(2.0f * x)); }
__device__ __forceinline__ float dpp_xor1(float x) { return __int_as_float(__builtin_amdgcn_update_dpp(0, __float_as_int(x), 0xB1, 0xF, 0xF, true)); }
__device__ __forceinline__ float dpp_xor2(float x) { return __int_as_float(__builtin_amdgcn_update_dpp(0, __float_as_int(x), 0x4E, 0xF, 0xF, true)); }
__device__ __forceinline__ unsigned pack_h2(float lo, float hi) { h16x2 v = {(h16)lo, (h16)hi}; return __builtin_bit_cast(unsigned, v); }

__device__ __forceinline__ f32x4 mfma32(h16x8 a, h16x8 b, f32x4 c) { return __builtin_amdgcn_mfma_f32_16x16x32_f16(a, b, c, 0, 0, 0); }
__device__ __forceinline__ f32x4 mfma16(h16x4 a, h16x4 b, f32x4 c) { return __builtin_amdgcn_mfma_f32_16x16x16f16(a, b, c, 0, 0, 0); }
__device__ __forceinline__ h16x4 cvt4(f32x4 v) { h16x4 o = {(h16)v[0], (h16)v[1], (h16)v[2], (h16)v[3]}; return o; }
__device__ __forceinline__ h16x8 cat8(h16x4 lo, h16x4 hi) { h16x8 o = {lo[0], lo[1], lo[2], lo[3], hi[0], hi[1], hi[2], hi[3]}; return o; }

#define XB_TMO      128
#define XB_XCNT(j)  (256  + 64 * (j))
#define XB_XSUB(j)  (1280 + 64 * (j))
#define XB_XGEN(j)  (2304 + 64 * (j))
#define XB_TOP      3328
#define XB_TOPGEN   3392
#define XCD_BAR_WORDS 3456
#define XB_SPIN_CAP (1u << 27)
__device__ __forceinline__ unsigned xb_ld(unsigned* p)              { return __hip_atomic_load(p, __ATOMIC_RELAXED, __HIP_MEMORY_SCOPE_AGENT); }
__device__ __forceinline__ unsigned xb_add(unsigned* p, unsigned v) { return __hip_atomic_fetch_add(p, v, __ATOMIC_RELAXED, __HIP_MEMORY_SCOPE_AGENT); }
__device__ __forceinline__ unsigned xb_xcc_id() { return (unsigned)__builtin_amdgcn_s_getreg((3 << 11) | 20) & 0xFu; }
#define XB_SPIN(cond, bar) do { unsigned _sp = 0; while (cond) { __builtin_amdgcn_s_sleep(1); \
    if ((++_sp & 255u) == 0u) { if (xb_ld(&(bar)[XB_TMO])) break; if (_sp > XB_SPIN_CAP) { atomicAdd(&(bar)[XB_TMO], 1u); break; } } } } while (0)
struct XcdBarrier { unsigned* bar; unsigned x; volatile LAS unsigned* st; };
__device__ __forceinline__ XcdBarrier xcd_barrier_post(unsigned* bar, volatile LAS unsigned* st) {
    XcdBarrier b; b.bar = bar; b.x = xb_xcc_id(); b.st = st;
    if (threadIdx.x == 0) (void)xb_add(&bar[XB_XCNT(b.x)], 1u);
    return b;
}
__device__ __forceinline__ void xcd_barrier_complete(unsigned* bar, unsigned x, unsigned& nloc, unsigned& nx) {
    const unsigned G = gridDim.x * gridDim.y * gridDim.z;
    unsigned sum, cnt, mine, sp = 0u;
    for (;;) {
        sum = 0u; cnt = 0u; mine = 0u;
#pragma unroll
        for (unsigned j = 0; j < 16; ++j) { const unsigned c = xb_ld(&bar[XB_XCNT(j)]); sum += c; cnt += (c > 0u) ? 1u : 0u; mine = (j == x) ? c : mine; }
        if (sum == G) break;
        __builtin_amdgcn_s_sleep(1);
        if ((++sp & 255u) == 0u) { if (xb_ld(&bar[XB_TMO])) break; if (sp > XB_SPIN_CAP) { atomicAdd(&bar[XB_TMO], 1u); break; } }
    }
    nloc = mine > 0u ? mine : 1u; nx = cnt > 0u ? cnt : 1u;
}
__device__ __forceinline__ void xcd_barrier(const XcdBarrier& b) {
    asm volatile("s_waitcnt vmcnt(0)" ::: "memory");
    __syncthreads();
    if (threadIdx.x == 0) {
        unsigned* bar = b.bar;
        __builtin_amdgcn_s_waitcnt(0);
        unsigned nloc = b.st[0], nx = b.st[1];
        if (nloc == 0u) { xcd_barrier_complete(bar, b.x, nloc, nx); b.st[0] = nloc; b.st[1] = nx; }
        const unsigned old = xb_add(&bar[XB_XSUB(b.x)], 1u);
        const unsigned gen = old / nloc;
        if (old + 1u == (gen + 1u) * nloc) {
            __builtin_amdgcn_fence(__ATOMIC_RELEASE, "agent");
            asm volatile("s_waitcnt vmcnt(0)" ::: "memory");
            const unsigned og = xb_add(&bar[XB_TOP], 1u);
            const unsigned tg = og / nx;
            if (og + 1u == (tg + 1u) * nx) xb_add(&bar[XB_TOPGEN], 1u);
            else XB_SPIN(xb_ld(&bar[XB_TOPGEN]) == tg, bar);
            __builtin_amdgcn_fence(__ATOMIC_ACQUIRE, "agent");
            xb_add(&bar[XB_XGEN(b.x)], 1u);
            asm volatile("s_waitcnt vmcnt(0)" ::: "memory");
        } else {
            XB_SPIN(xb_ld(&bar[XB_XGEN(b.x)]) == gen, bar);
            __builtin_amdgcn_fence(__ATOMIC_ACQUIRE, "agent");
            asm volatile("s_waitcnt vmcnt(0)" ::: "memory");
        }
    }
    __syncthreads();
}

constexpr int GEMM_STAGE = (256 + 256) * 32 * 2;
constexpr int GEMM_LDS = 4 * GEMM_STAGE;
#define WAIT_V(n) asm volatile("s_waitcnt vmcnt(" #n ")" ::: "memory")
__device__ __forceinline__ void glds16(const h16* g, char* l) {
    __builtin_amdgcn_global_load_lds((const __attribute__((address_space(1))) unsigned*)g, (__attribute__((address_space(3))) unsigned*)l, 16, 0, 0);
}
template <typename ARow, typename BRow>
__device__ __forceinline__ void gemm_tile(char* smem, const ARow& arow, const BRow& brow, int K, f32x4 (&acc)[8][4]) {
    const int tid = threadIdx.x, lane = tid & 63, wave = tid >> 6;
    const int wm = wave >> 2, wn = wave & 3;
    const int fr = lane & 15, fq = lane >> 4;
    const int lrow = lane >> 2;
    const int schunk = (lane & 3) ^ ((0x78 >> (2 * ((lane >> 4) & 3))) & 3);
    const h16* ap[2]; const h16* bp[2];
#pragma unroll
    for (int i = 0; i < 2; ++i) { ap[i] = arow(32 * wave + 16 * i + lrow) + schunk * 8; bp[i] = brow(32 * wave + 16 * i + lrow) + schunk * 8; }
    char* ldsA = smem + (2 * wave) * 1024 + lane * 16;
    char* ldsB = smem + 16384 + (2 * wave) * 1024 + lane * 16;
    const int fsw = (0x78 >> (2 * (fr >> 2))) & 3;
    const int rdA = (128 * wm + fr) * 64 + ((fq ^ fsw) << 4);
    const int rdB = 16384 + (64 * wn + fr) * 64 + ((fq ^ fsw) << 4);
#pragma unroll
    for (int mi = 0; mi < 8; ++mi)
#pragma unroll
        for (int ni = 0; ni < 4; ++ni) acc[mi][ni] = (f32x4){0.f, 0.f, 0.f, 0.f};
    const int nk = K >> 5;
    WAIT_V(0);
    __syncthreads();
#pragma unroll
    for (int st = 0; st < 3; ++st) {
        if (st < nk) {
#pragma unroll
            for (int i = 0; i < 2; ++i) { glds16(ap[i] + st * 32, ldsA + st * GEMM_STAGE + i * 1024); glds16(bp[i] + st * 32, ldsB + st * GEMM_STAGE + i * 1024); }
        }
    }
    int cur = 0, nxt = 3 * GEMM_STAGE;
#pragma unroll 1
    for (int kt = 0; kt < nk; ++kt) {
        const int ahead = nk - 1 - kt;
        if (ahead >= 2) { WAIT_V(8); } else if (ahead == 1) { WAIT_V(4); } else { WAIT_V(0); }
        __builtin_amdgcn_s_barrier();
        const char* As = smem + cur + rdA;
        const char* Bs = smem + cur + rdB;
        h16x8 af[8], bf[4];
#pragma unroll
        for (int ni = 0; ni < 4; ++ni) bf[ni] = *(const h16x8*)(Bs + ni * 1024);
#pragma unroll
        for (int mi = 0; mi < 8; ++mi) af[mi] = *(const h16x8*)(As + mi * 1024);
        __builtin_amdgcn_sched_barrier(0);
        if (kt + 3 < nk) {
            const int ko = (kt + 3) * 32;
#pragma unroll
            for (int i = 0; i < 2; ++i) { glds16(ap[i] + ko, ldsA + nxt + i * 1024); glds16(bp[i] + ko, ldsB + nxt + i * 1024); }
        }
        __builtin_amdgcn_sched_barrier(0);
        __builtin_amdgcn_s_setprio(1);
#pragma unroll
        for (int mi = 0; mi < 8; ++mi)
#pragma unroll
            for (int ni = 0; ni < 4; ++ni)
                acc[mi][ni] = __builtin_amdgcn_mfma_f32_16x16x32_f16(bf[ni], af[mi], acc[mi][ni], 0, 0, 0);
        __builtin_amdgcn_s_setprio(0);
        cur = (cur == 3 * GEMM_STAGE) ? 0 : cur + GEMM_STAGE;
        nxt = (nxt == 3 * GEMM_STAGE) ? 0 : nxt + GEMM_STAGE;
    }
}
template <typename F>
__device__ __forceinline__ void acc_foreach(const f32x4 (&acc)[8][4], F f) {
    const int lane = threadIdx.x & 63, wave = threadIdx.x >> 6;
    const int wm = wave >> 2, wn = wave & 3;
#pragma unroll
    for (int mi = 0; mi < 8; ++mi)
#pragma unroll
        for (int ni = 0; ni < 4; ++ni)
            f(128 * wm + 16 * mi + (lane & 15), 64 * wn + 16 * ni + 4 * (lane >> 4), acc[mi][ni]);
}
__device__ __forceinline__ int perm16(int n) { return (n & ~60) | ((n & 12) << 2) | ((n & 48) >> 2); }
template <typename F>
__device__ __forceinline__ void acc_foreach16(const f32x4 (&acc)[8][4], F f) {
    const int lane = threadIdx.x & 63, wave = threadIdx.x >> 6;
    const int wm = wave >> 2, wn = wave & 3;
#pragma unroll
    for (int mi = 0; mi < 8; ++mi) f(128 * wm + 16 * mi + (lane & 15), 64 * wn + 16 * (lane >> 4), acc[mi]);
}
__device__ __forceinline__ void store_h16(h16* p, const f32x4 (&v)[4]) {
    h16x8 lo = {(h16)v[0][0], (h16)v[0][1], (h16)v[0][2], (h16)v[0][3], (h16)v[1][0], (h16)v[1][1], (h16)v[1][2], (h16)v[1][3]};
    h16x8 hi = {(h16)v[2][0], (h16)v[2][1], (h16)v[2][2], (h16)v[2][3], (h16)v[3][0], (h16)v[3][1], (h16)v[3][2], (h16)v[3][3]};
    *(h16x8*)p = lo; *(h16x8*)(p + 8) = hi;
}
namespace g8 {
constexpr int BK = 64, HALF = 128, HTB = HALF * BK * 2;
__device__ __forceinline__ int lds_byte(int r, int c) { const int st = (r >> 4) * 2 + (c >> 5), rr = r & 15, cc = c & 31, ob = rr * 64 + cc * 2; return st * 1024 + (ob ^ (((ob >> 9) & 1) << 5)); }
__device__ __forceinline__ void stage_rc(int b, int& R, int& C) { const int st = b / 1024, sb = b % 1024, swz = sb ^ (((sb >> 9) & 1) << 5); R = (st >> 1) * 16 + swz / 64; C = (st & 1) * 32 + (swz % 64) / 2; }
struct Unit { const h16* a; const h16* b; int u0, u1, u2, u3, u4; };
}
template <class Sched, class Epi>
__device__ __forceinline__ void gemm_phase8(char* smem, int lda, int ldb, int K, const Sched& S, const Epi& E) {
    using namespace g8;
    LAS unsigned char* lds = (LAS unsigned char*)smem;
    const int tid = threadIdx.x, wid = __builtin_amdgcn_readfirstlane(tid >> 6), lane = tid & 63, wr = wid >> 2, wc = wid & 3, fr = lane & 15, fq = lane >> 4;
    const int nt = K / BK;
    unsigned voffA[2], voffB[2];
#pragma unroll
    for (int i = 0; i < 2; ++i) { int R, C; stage_rc(tid * 16 + i * 8192, R, C); voffA[i] = (unsigned)(R * lda + C) * 2u; voffB[i] = (unsigned)(R * ldb + C) * 2u; }
    const size_t kstep = (size_t)(BK * 2);
    const size_t hstepA = (size_t)HALF * lda * 2, hstepB = (size_t)HALF * ldb * 2;
    const unsigned ldsw = (unsigned)wid * 1024u;
    const int aoff = lds_byte(wr * 64 + fr, fq * 8), boff = lds_byte(wc * 32 + fr, fq * 8);
#define G8_SA(b, h) (((b) * 2 + (h)) * HTB)
#define G8_SB(b, h) ((4 + (b) * 2 + (h)) * HTB)
#define G8_STAGE(bufoff, gbase, voff) do { _Pragma("unroll") for (int _i = 0; _i < 2; ++_i) \
        __builtin_amdgcn_global_load_lds((const __attribute__((address_space(1))) unsigned*)((const char*)(gbase) + (voff)[_i]), (LAS unsigned*)(lds + (bufoff) + ldsw + _i * 8192), 16, 0, 0); } while (0)
#define G8_LDA(dst, b, h) do { _Pragma("unroll") for (int m = 0; m < 4; ++m) _Pragma("unroll") for (int k = 0; k < 2; ++k) dst[m][k] = *(const LAS h16x8*)(lds + G8_SA(b, h) + aoff + m * 2048 + k * 1024); } while (0)
#define G8_LDB(dst, b, h) do { _Pragma("unroll") for (int n = 0; n < 2; ++n) _Pragma("unroll") for (int k = 0; k < 2; ++k) dst[n][k] = *(const LAS h16x8*)(lds + G8_SB(b, h) + boff + n * 2048 + k * 1024); } while (0)
#define G8_MMA(ai, bj, At, Bt) do { __builtin_amdgcn_s_setprio(1); _Pragma("unroll") for (int m = 0; m < 4; ++m) _Pragma("unroll") for (int n = 0; n < 2; ++n) _Pragma("unroll") for (int k = 0; k < 2; ++k) \
        acc[ai][bj][m][n] = __builtin_amdgcn_mfma_f32_16x16x32_f16(Bt[n][k], At[m][k], acc[ai][bj][m][n], 0, 0, 0); __builtin_amdgcn_s_setprio(0); } while (0)
#define G8_WAIT_V(n) asm volatile("s_waitcnt vmcnt(" #n ")" ::: "memory")
#define G8_WAIT_L(n) asm volatile("s_waitcnt lgkmcnt(" #n ")" ::: "memory")
#define G8_BAR __builtin_amdgcn_s_barrier()
#define G8_SCHED __builtin_amdgcn_sched_barrier(0)
    Unit cur, nxt; int ui = 0;
    G8_WAIT_V(0);
    __syncthreads();
    if (!S(0, cur)) return;
    f32x4 acc[2][2][4][2];
#pragma unroll
    for (int a = 0; a < 2; ++a)
#pragma unroll
        for (int b = 0; b < 2; ++b)
#pragma unroll
            for (int m = 0; m < 4; ++m)
#pragma unroll
                for (int n = 0; n < 2; ++n) acc[a][b][m][n] = (f32x4){0.f, 0.f, 0.f, 0.f};
    h16x8 At[4][2], B0[2][2], B1[2][2];
    const char* cA = (const char*)cur.a; const char* cB = (const char*)cur.b;
    G8_STAGE(G8_SB(0, 0), cB, voffB); G8_STAGE(G8_SA(0, 0), cA, voffA); G8_STAGE(G8_SB(0, 1), cB + hstepB, voffB); G8_STAGE(G8_SA(0, 1), cA + hstepA, voffA);
    if (wr == 1) G8_BAR;
    G8_WAIT_V(4); G8_BAR;
    G8_STAGE(G8_SB(1, 0), cB + kstep, voffB); G8_STAGE(G8_SA(1, 0), cA + kstep, voffA); G8_STAGE(G8_SB(1, 1), cB + hstepB + kstep, voffB);
    G8_WAIT_V(6); G8_BAR;
    for (;;) {
        const bool has_next = S(ui + 1, nxt);
        const char* nA = has_next ? (const char*)nxt.a : cA; const char* nB = has_next ? (const char*)nxt.b : cB;
        for (int t = 0; t < nt; t += 2) {
            const bool last = (t == nt - 2);
            const char* a1 = cA + (size_t)(t + 1) * kstep;
            const char* a2 = last ? nA : cA + (size_t)(t + 2) * kstep; const char* b2 = last ? nB : cB + (size_t)(t + 2) * kstep;
            const char* a3 = a2 + kstep; const char* b3 = b2 + kstep;
            G8_LDB(B0, 0, 0); G8_SCHED; G8_LDA(At, 0, 0); G8_STAGE(G8_SA(1, 1), a1 + hstepA, voffA);
            G8_WAIT_L(8); G8_BAR; G8_WAIT_L(0); G8_MMA(0, 0, At, B0); G8_BAR; G8_SCHED;
            G8_LDB(B1, 0, 1); G8_STAGE(G8_SB(0, 0), b2, voffB);
            G8_BAR; G8_WAIT_L(0); G8_MMA(0, 1, At, B1); G8_BAR;
            G8_LDA(At, 0, 1); G8_STAGE(G8_SA(0, 0), a2, voffA);
            G8_BAR; G8_WAIT_L(0); G8_MMA(1, 0, At, B0); G8_BAR; G8_SCHED;
            G8_STAGE(G8_SB(0, 1), b2 + hstepB, voffB);
            G8_WAIT_V(6); G8_BAR; G8_MMA(1, 1, At, B1); G8_BAR;
            G8_LDB(B0, 1, 0); G8_SCHED; G8_LDA(At, 1, 0); G8_STAGE(G8_SA(0, 1), a2 + hstepA, voffA);
            G8_WAIT_L(8); G8_BAR; G8_WAIT_L(0); G8_MMA(0, 0, At, B0); G8_BAR; G8_SCHED;
            G8_LDB(B1, 1, 1); G8_STAGE(G8_SB(1, 0), b3, voffB);
            G8_BAR; G8_WAIT_L(0); G8_MMA(0, 1, At, B1); G8_BAR;
            G8_LDA(At, 1, 1); G8_STAGE(G8_SA(1, 0), a3, voffA);
            G8_BAR; G8_WAIT_L(0); G8_MMA(1, 0, At, B0); G8_BAR; G8_SCHED;
            G8_STAGE(G8_SB(1, 1), b3 + hstepB, voffB);
            G8_WAIT_V(6); G8_BAR; G8_MMA(1, 1, At, B1); G8_BAR;
        }
        E(cur, acc, wr, wc, fr, fq);
        if (!has_next) break;
#pragma unroll
        for (int a = 0; a < 2; ++a)
#pragma unroll
            for (int b = 0; b < 2; ++b)
#pragma unroll
                for (int m = 0; m < 4; ++m)
#pragma unroll
                    for (int n = 0; n < 2; ++n) acc[a][b][m][n] = (f32x4){0.f, 0.f, 0.f, 0.f};
        cur = nxt; cA = nA; cB = nB; ++ui;
    }
    G8_WAIT_V(0);
    if (wr == 0) G8_BAR;
    G8_BAR;
#undef G8_SA
#undef G8_SB
#undef G8_STAGE
#undef G8_LDA
#undef G8_LDB
#undef G8_MMA
#undef G8_WAIT_V
#undef G8_WAIT_L
#undef G8_BAR
#undef G8_SCHED
}
template <int ACPOL, class Sched, class RowOff, class Epi>
__device__ __forceinline__ void gemm_phase8g(char* smem, const h16* baseA_, int ldb, int K, const Sched& S, const RowOff& RO, const Epi& E) {
    using namespace g8;
    LAS unsigned char* lds = (LAS unsigned char*)smem;
    const char* baseA = (const char*)baseA_;
    const int tid = threadIdx.x, wid = __builtin_amdgcn_readfirstlane(tid >> 6), lane = tid & 63, wr = wid >> 2, wc = wid & 3, fr = lane & 15, fq = lane >> 4;
    const int nt = K / BK;
    int Rl[2], Cl[2]; unsigned voffB[2];
#pragma unroll
    for (int i = 0; i < 2; ++i) { stage_rc(tid * 16 + i * 8192, Rl[i], Cl[i]); voffB[i] = (unsigned)(Rl[i] * ldb + Cl[i]) * 2u; }
    const size_t kstep = (size_t)(BK * 2);
    const size_t hstepB = (size_t)HALF * ldb * 2;
    const unsigned ldsw = (unsigned)wid * 1024u;
    const int aoff = lds_byte(wr * 64 + fr, fq * 8), boff = lds_byte(wc * 32 + fr, fq * 8);
#define G8_SA(b, h) (((b) * 2 + (h)) * HTB)
#define G8_SB(b, h) ((4 + (b) * 2 + (h)) * HTB)
#define G8_STAGE(bufoff, gbase, voff) do { _Pragma("unroll") for (int _i = 0; _i < 2; ++_i) \
        __builtin_amdgcn_global_load_lds((const __attribute__((address_space(1))) unsigned*)((const char*)(gbase) + (voff)[_i]), (LAS unsigned*)(lds + (bufoff) + ldsw + _i * 8192), 16, 0, 0); } while (0)
#define G8_STAGEA(bufoff, gbase, voff) do { _Pragma("unroll") for (int _i = 0; _i < 2; ++_i) \
        __builtin_amdgcn_global_load_lds((const __attribute__((address_space(1))) unsigned*)((const char*)(gbase) + (voff)[_i]), (LAS unsigned*)(lds + (bufoff) + ldsw + _i * 8192), 16, 0, ACPOL); } while (0)
#define G8_LDA(dst, b, h) do { _Pragma("unroll") for (int m = 0; m < 4; ++m) _Pragma("unroll") for (int k = 0; k < 2; ++k) dst[m][k] = *(const LAS h16x8*)(lds + G8_SA(b, h) + aoff + m * 2048 + k * 1024); } while (0)
#define G8_LDB(dst, b, h) do { _Pragma("unroll") for (int n = 0; n < 2; ++n) _Pragma("unroll") for (int k = 0; k < 2; ++k) dst[n][k] = *(const LAS h16x8*)(lds + G8_SB(b, h) + boff + n * 2048 + k * 1024); } while (0)
#define G8_MMA(ai, bj, At, Bt) do { __builtin_amdgcn_s_setprio(1); _Pragma("unroll") for (int m = 0; m < 4; ++m) _Pragma("unroll") for (int n = 0; n < 2; ++n) _Pragma("unroll") for (int k = 0; k < 2; ++k) \
        acc[ai][bj][m][n] = __builtin_amdgcn_mfma_f32_16x16x32_f16(Bt[n][k], At[m][k], acc[ai][bj][m][n], 0, 0, 0); __builtin_amdgcn_s_setprio(0); } while (0)
#define G8_WAIT_V(n) asm volatile("s_waitcnt vmcnt(" #n ")" ::: "memory")
#define G8_WAIT_L(n) asm volatile("s_waitcnt lgkmcnt(" #n ")" ::: "memory")
#define G8_BAR __builtin_amdgcn_s_barrier()
#define G8_SCHED __builtin_amdgcn_sched_barrier(0)
    Unit cur, nxt; int ui = 0;
    G8_WAIT_V(0);
    __syncthreads();
    if (!S(0, cur)) return;
    f32x4 acc[2][2][4][2];
#pragma unroll
    for (int a = 0; a < 2; ++a)
#pragma unroll
        for (int b = 0; b < 2; ++b)
#pragma unroll
            for (int m = 0; m < 4; ++m)
#pragma unroll
                for (int n = 0; n < 2; ++n) acc[a][b][m][n] = (f32x4){0.f, 0.f, 0.f, 0.f};
    h16x8 At[4][2], B0[2][2], B1[2][2];
    unsigned oc0[2], oc1[2], on0[2], on1[2];
#pragma unroll
    for (int i = 0; i < 2; ++i) { oc0[i] = RO(cur, Rl[i]) + (unsigned)Cl[i] * 2u; oc1[i] = RO(cur, HALF + Rl[i]) + (unsigned)Cl[i] * 2u; }
    const char* cB = (const char*)cur.b;
    G8_STAGE(G8_SB(0, 0), cB, voffB); G8_STAGEA(G8_SA(0, 0), baseA, oc0); G8_STAGE(G8_SB(0, 1), cB + hstepB, voffB); G8_STAGEA(G8_SA(0, 1), baseA, oc1);
    if (wr == 1) G8_BAR;
    G8_WAIT_V(4); G8_BAR;
    G8_STAGE(G8_SB(1, 0), cB + kstep, voffB); G8_STAGEA(G8_SA(1, 0), baseA + kstep, oc0); G8_STAGE(G8_SB(1, 1), cB + hstepB + kstep, voffB);
    G8_WAIT_V(6); G8_BAR;
    for (;;) {
        const bool has_next = S(ui + 1, nxt);
        const char* nB = has_next ? (const char*)nxt.b : cB;
#pragma unroll
        for (int i = 0; i < 2; ++i) {
            on0[i] = has_next ? RO(nxt, Rl[i]) + (unsigned)Cl[i] * 2u : oc0[i];
            on1[i] = has_next ? RO(nxt, HALF + Rl[i]) + (unsigned)Cl[i] * 2u : oc1[i];
        }
        for (int t = 0; t < nt; t += 2) {
            const bool last = (t == nt - 2);
            const char* a1 = baseA + (size_t)(t + 1) * kstep;
            const char* a2 = last ? baseA : baseA + (size_t)(t + 2) * kstep;
            const char* b2 = last ? nB : cB + (size_t)(t + 2) * kstep;
            const char* a3 = a2 + kstep; const char* b3 = b2 + kstep;
            unsigned o20[2], o21[2];
#pragma unroll
            for (int i = 0; i < 2; ++i) { o20[i] = last ? on0[i] : oc0[i]; o21[i] = last ? on1[i] : oc1[i]; }
            G8_LDB(B0, 0, 0); G8_SCHED; G8_LDA(At, 0, 0); G8_STAGEA(G8_SA(1, 1), a1, oc1);
            G8_WAIT_L(8); G8_BAR; G8_WAIT_L(0); G8_MMA(0, 0, At, B0); G8_BAR; G8_SCHED;
            G8_LDB(B1, 0, 1); G8_STAGE(G8_SB(0, 0), b2, voffB);
            G8_BAR; G8_WAIT_L(0); G8_MMA(0, 1, At, B1); G8_BAR;
            G8_LDA(At, 0, 1); G8_STAGEA(G8_SA(0, 0), a2, o20);
            G8_BAR; G8_WAIT_L(0); G8_MMA(1, 0, At, B0); G8_BAR; G8_SCHED;
            G8_STAGE(G8_SB(0, 1), b2 + hstepB, voffB);
            G8_WAIT_V(6); G8_BAR; G8_MMA(1, 1, At, B1); G8_BAR;
            G8_LDB(B0, 1, 0); G8_SCHED; G8_LDA(At, 1, 0); G8_STAGEA(G8_SA(0, 1), a2, o21);
            G8_WAIT_L(8); G8_BAR; G8_WAIT_L(0); G8_MMA(0, 0, At, B0); G8_BAR; G8_SCHED;
            G8_LDB(B1, 1, 1); G8_STAGE(G8_SB(1, 0), b3, voffB);
            G8_BAR; G8_WAIT_L(0); G8_MMA(0, 1, At, B1); G8_BAR;
            G8_LDA(At, 1, 1); G8_STAGEA(G8_SA(1, 0), a3, o20);
            G8_BAR; G8_WAIT_L(0); G8_MMA(1, 0, At, B0); G8_BAR; G8_SCHED;
            G8_STAGE(G8_SB(1, 1), b3 + hstepB, voffB);
            G8_WAIT_V(6); G8_BAR; G8_MMA(1, 1, At, B1); G8_BAR;
        }
        E(cur, acc, wr, wc, fr, fq);
        if (!has_next) break;
#pragma unroll
        for (int a = 0; a < 2; ++a)
#pragma unroll
            for (int b = 0; b < 2; ++b)
#pragma unroll
                for (int m = 0; m < 4; ++m)
#pragma unroll
                    for (int n = 0; n < 2; ++n) acc[a][b][m][n] = (f32x4){0.f, 0.f, 0.f, 0.f};
        cur = nxt; cB = nB; ++ui;
#pragma unroll
        for (int i = 0; i < 2; ++i) { oc0[i] = on0[i]; oc1[i] = on1[i]; }
    }
    G8_WAIT_V(0);
    if (wr == 0) G8_BAR;
    G8_BAR;
#undef G8_SA
#undef G8_SB
#undef G8_STAGE
#undef G8_STAGEA
#undef G8_LDA
#undef G8_LDB
#undef G8_MMA
#undef G8_WAIT_V
#undef G8_WAIT_L
#undef G8_BAR
#undef G8_SCHED
}
template <typename F>
__device__ __forceinline__ void acc8_foreach(const f32x4 (&acc)[2][2][4][2], int wr, int wc, int fr, int fq, F f) {
#pragma unroll
    for (int ai = 0; ai < 2; ++ai)
#pragma unroll
        for (int m = 0; m < 4; ++m)
#pragma unroll
            for (int bj = 0; bj < 2; ++bj)
#pragma unroll
                for (int n = 0; n < 2; ++n)
                    f(128 * ai + 64 * wr + 16 * m + fr, 128 * bj + 32 * wc + 16 * n + 4 * fq, acc[ai][bj][m][n]);
}
__device__ __forceinline__ void store_h4(h16* p, f32x4 v) { h16x4 o = {(h16)v[0], (h16)v[1], (h16)v[2], (h16)v[3]}; *(h16x4*)p = o; }
__device__ __forceinline__ void tile_order(int t, int MT, int NTl, int& tm, int& tn) {
    const int GM = 8;
    const int per = GM * NTl;
    const int g = t / per, r = t - g * per;
    const int fm = g * GM;
    const int gsz = (MT - fm) < GM ? (MT - fm) : GM;
    tm = fm + (r % gsz); tn = r / gsz;
}

struct ConvDesc { const float* src; h16* dst; int N, ldd, k0, n0, mode; };
constexpr int POOL2_STEPS = 1800;
constexpr int POOL_STEPS = 2400;
constexpr int CONV_T0 = 2432, CONV_T1 = CONV_T0 + 1024, CONV_T2 = CONV_T1 + 1024, CONV_T3 = CONV_T2 + 32, CONV_T4 = CONV_T3 + 32, CONV_T5 = CONV_T4 + 32, CONV_T6 = CONV_T5 + 16 * 768;
__device__ __forceinline__ ConvDesc conv_desc_expert(const Params& p, int l, int u) {
    char* ws = p.ws;
    const int e = u / 768, r = u % 768;
    const int le = l * 16 + e;
    const int which = r >> 8, q = r & 255;
    ConvDesc d;
    if (which < 2) {
        d.src = p.in[27 + which] + (size_t)le * 2048 * 512; d.N = 512; d.k0 = (q >> 3) * 64; d.n0 = (q & 7) * 64;
        d.dst = (h16*)(ws + OFF_EXP + l * EXP_L) + (size_t)e * 1024 * 2048; d.ldd = 2048; d.mode = 1 + which;
    } else {
        d.src = p.in[29] + (size_t)le * 512 * 2048; d.N = 2048; d.k0 = (q >> 5) * 64; d.n0 = (q & 31) * 64;
        d.dst = (h16*)(ws + OFF_EXP + l * EXP_L + EGU_BYTES) + (size_t)e * 2048 * 512; d.ldd = 512; d.mode = 0;
    }
    return d;
}
__device__ __forceinline__ ConvDesc conv_desc_prologue(const Params& p, int t) {
    char* ws = p.ws;
    ConvDesc d; d.mode = 0;
    if (t < CONV_T0) { d.src = p.in[8]; d.N = IN_COLS; d.k0 = (t / 76) * 64; d.n0 = (t % 76) * 64; d.dst = (h16*)(ws + OFF_WIN); d.ldd = D; }
    else if (t < CONV_T1) { const int u = t - CONV_T0; d.src = p.in[23]; d.N = D; d.k0 = (u >> 5) * 64; d.n0 = (u & 31) * 64; d.dst = (h16*)(ws + OFF_WOUT); d.ldd = D; }
    else if (t < CONV_T2) { const int u = t - CONV_T1; d.src = p.in[24]; d.N = D; d.k0 = (u >> 5) * 64; d.n0 = (u & 31) * 64; d.dst = (h16*)(ws + OFF_FW); d.ldd = D; }
    else if (t < CONV_T3) { const int u = t - CONV_T2; const int dd = u >> 4; d.src = p.in[12] + (size_t)dd * 64 * 1024; d.N = 1024; d.k0 = 0; d.n0 = (u & 15) * 64; d.dst = (h16*)(ws + OFF_W2T) + (size_t)dd * 1024 * 64; d.ldd = 64; }
    else if (t < CONV_T4) { const int u = t - CONV_T3; const int dd = u >> 4; d.src = p.in[14] + (size_t)dd * 64 * 1024; d.N = 1024; d.k0 = 0; d.n0 = (u & 15) * 64; d.dst = (h16*)(ws + OFF_A2T) + (size_t)dd * 1024 * 64; d.ldd = 64; }
    else if (t < CONV_T5) { const int u = t - CONV_T4; d.src = p.in[15]; d.N = 1024; d.k0 = (u >> 4) * 64; d.n0 = (u & 15) * 64; d.dst = (h16*)(ws + OFF_G2T); d.ldd = 128; }
    else d = conv_desc_expert(p, 0, t - CONV_T5);
    return d;
}
template <typename DescFn>
__device__ __forceinline__ void conv_run(char* smem, int t_end, int gb, int gn, DescFn get) {
    const int vb = threadIdx.x >> 8, tid = threadIdx.x & 255;
    unsigned* tile = (unsigned*)(smem + vb * 17408);
    const int nc = tid & 15, kp = tid >> 4;
    const int kc = tid & 7, nr = tid >> 3;
    int tp = gb;
    if (4 * tp >= t_end) return;
    auto clampt = [&](int tpp, int u) { const int t = 4 * tpp + 2 * vb + u; return t < t_end ? t : t_end - 1; };
    ConvDesc d[2]; f32x4 a0[2], b0[2], a1[2], b1[2];
#pragma unroll
    for (int u = 0; u < 2; ++u) {
        d[u] = get(clampt(tp, u));
        const float* s0 = d[u].src + (size_t)(d[u].k0 + 2 * kp) * d[u].N + d[u].n0 + 4 * nc;
        a0[u] = *(const f32x4*)s0; b0[u] = *(const f32x4*)(s0 + d[u].N);
        const float* s1 = s0 + (size_t)32 * d[u].N;
        a1[u] = *(const f32x4*)s1; b1[u] = *(const f32x4*)(s1 + d[u].N);
    }
    __syncthreads();
    for (;;) {
        const int tn = tp + gn;
        const bool more = 4 * tn < t_end;
        ConvDesc dn[2]; f32x4 na0[2], nb0[2], na1[2], nb1[2];
#pragma unroll
        for (int u = 0; u < 2; ++u) { dn[u] = d[u]; na0[u] = a0[u]; nb0[u] = b0[u]; na1[u] = a1[u]; nb1[u] = b1[u]; }
        if (more) {
#pragma unroll
            for (int u = 0; u < 2; ++u) {
                dn[u] = get(clampt(tn, u));
                const float* s0 = dn[u].src + (size_t)(dn[u].k0 + 2 * kp) * dn[u].N + dn[u].n0 + 4 * nc;
                na0[u] = *(const f32x4*)s0; nb0[u] = *(const f32x4*)(s0 + dn[u].N);
                const float* s1 = s0 + (size_t)32 * dn[u].N;
                na1[u] = *(const f32x4*)s1; nb1[u] = *(const f32x4*)(s1 + dn[u].N);
            }
        }
#pragma unroll
        for (int u = 0; u < 2; ++u)
#pragma unroll
            for (int e = 0; e < 4; ++e) { tile[u * 2176 + (4 * nc + e) * 33 + kp] = pack_h2(a0[u][e], b0[u][e]); tile[u * 2176 + (4 * nc + e) * 33 + kp + 16] = pack_h2(a1[u][e], b1[u][e]); }
        __syncthreads();
#pragma unroll
        for (int u = 0; u < 2; ++u)
#pragma unroll
            for (int ps = 0; ps < 2; ++ps) {
                const int n = nr + 32 * ps;
                u32x4 v;
                v[0] = tile[u * 2176 + n * 33 + 4 * kc + 0]; v[1] = tile[u * 2176 + n * 33 + 4 * kc + 1]; v[2] = tile[u * 2176 + n * 33 + 4 * kc + 2]; v[3] = tile[u * 2176 + n * 33 + 4 * kc + 3];
                const int ng = d[u].n0 + n;
                int np = ng;
                if (d[u].mode == 1) np = 32 * (ng >> 4) + (ng & 15);
                else if (d[u].mode == 2) np = 32 * (ng >> 4) + 16 + (ng & 15);
                *(u32x4*)(d[u].dst + (size_t)np * d[u].ldd + d[u].k0 + 8 * kc) = v;
            }
        __syncthreads();
        if (!more) break;
#pragma unroll
        for (int u = 0; u < 2; ++u) { d[u] = dn[u]; a0[u] = na0[u]; b0[u] = nb0[u]; a1[u] = na1[u]; b1[u] = nb1[u]; }
        tp = tn;
    }
}
__device__ __forceinline__ void phase_conv_experts(const Params& p, char* smem, int bid, int nblk, int l) {
    conv_run(smem, 16 * 768 - 4 * POOL2_STEPS, bid, nblk, [&](int t) { return conv_desc_expert(p, l, t); });
}
__device__ __forceinline__ void conv_pool2_step(const Params& p, char* smem, int s) {
    conv_run(smem, 8 * s + 8, 2 * s, 1, [&](int t) { return conv_desc_expert(p, 1, 16 * 768 - 4 * POOL2_STEPS + t); });
}
__device__ __forceinline__ void phase_conv_pool2_rest(const Params& p, char* smem, int bid, int nblk) {
    const unsigned* ctl = (const unsigned*)(p.ws + OFF_CTL);
    unsigned taken = __hip_atomic_load(&ctl[CW_POOL2], __ATOMIC_RELAXED, __HIP_MEMORY_SCOPE_AGENT);
    const int start = 2 * __builtin_amdgcn_readfirstlane((int)(taken < (unsigned)(POOL2_STEPS / 2) ? taken : (unsigned)(POOL2_STEPS / 2)));
    conv_run(smem, 4 * POOL2_STEPS, start + bid, nblk, [&](int t) { return conv_desc_expert(p, 1, 16 * 768 - 4 * POOL2_STEPS + t); });
}
__device__ __forceinline__ void conv_pool_step(const Params& p, char* smem, int s) {
    conv_run(smem, 8 * s + 8, 2 * s, 1, [&](int t) { return conv_desc_expert(p, 0, 16 * 768 - 4 * POOL_STEPS + t); });
}
__device__ __forceinline__ void phase_conv_pool_rest(const Params& p, char* smem, int bid, int nblk) {
    const unsigned* ctl = (const unsigned*)(p.ws + OFF_CTL);
    unsigned taken = __hip_atomic_load(&ctl[CW_POOL], __ATOMIC_RELAXED, __HIP_MEMORY_SCOPE_AGENT);
    const int start = 2 * __builtin_amdgcn_readfirstlane((int)(taken < (unsigned)(POOL_STEPS / 2) ? taken : (unsigned)(POOL_STEPS / 2)));
    conv_run(smem, 4 * POOL_STEPS, start + bid, nblk, [&](int t) { return conv_desc_expert(p, 0, 16 * 768 - 4 * POOL_STEPS + t); });
}
__device__ __forceinline__ void mod_gemv(const Params& p, char* smem, int l, int vb, int vn) {
    const int tid = threadIdx.x;
    float* sl = (float*)smem;
    float* red = sl + 5 * 2048;
    float* mod = (float*)(p.ws + OFF_MOD);
    for (int i = tid; i < 5 * 2048; i += NT) {
        const int v = i >> 11, kk = i & 2047;
        const float cv = (v < 4) ? p.in[1][v * D + kk] : p.in[3][kk];
        sl[i] = siluf_(cv);
    }
    __syncthreads();
    const int ks = tid >> 3, cg = tid & 7;
    for (int nc = vb; nc < 384; nc += vn) {
        const int n0 = nc * 32 + cg * 4;
        const float* wp = p.in[4] + ((size_t)l * D + ks * 32) * 12288 + n0;
        f32x4 a0 = {0, 0, 0, 0}, a1 = a0, a2 = a0, a3 = a0, a4 = a0;
#pragma unroll 8
        for (int kk = 0; kk < 32; ++kk) {
            const f32x4 w = *(const f32x4*)(wp + (size_t)kk * 12288);
            const int k = ks * 32 + kk;
            a0 += w * sl[k]; a1 += w * sl[2048 + k]; a2 += w * sl[4096 + k]; a3 += w * sl[6144 + k]; a4 += w * sl[8192 + k];
        }
        float* r = red + ks * 160 + cg * 4;
        *(f32x4*)(r) = a0; *(f32x4*)(r + 32) = a1; *(f32x4*)(r + 64) = a2; *(f32x4*)(r + 96) = a3; *(f32x4*)(r + 128) = a4;
        __syncthreads();
        if (tid < 160) {
            const int v = tid >> 5, c = tid & 31;
            float sum = p.in[5][l * 12288 + nc * 32 + c];
#pragma unroll 8
            for (int q = 0; q < 64; ++q) sum += red[q * 160 + v * 32 + c];
            mod[(size_t)(l * 5 + v) * 12288 + nc * 32 + c] = sum;
        }
        __syncthreads();
    }
}
__device__ __forceinline__ void phase_tables(const Params& p, int bid, int nblk) {
    const int tid = threadIdx.x;
    char* ws = p.ws;
    {
        h16* DT = (h16*)(ws + OFF_DT);
        const float sT = 0.022097086912079608f;
        for (size_t i = (size_t)bid * NT + tid; i < (size_t)2048 * 2048; i += (size_t)nblk * NT) {
            const int k = (int)(i >> 11), kp = (int)(i & 2047);
            const int t = kp & 1023;
            const int m = (k * t) & 2047;
            const float x = (float)m * (1.0f / 1024.0f);
            const float v = (kp < 1024) ? cospif(x) : -sinpif(x);
            DT[i] = (h16)(v * sT);
        }
        h16* DC = (h16*)(ws + OFF_DC);
        for (int i = bid * NT + tid; i < 512 * 256; i += nblk * NT) {
            const int n = i >> 8, c = i & 255;
            const int m = ((n & 255) * c) & 255;
            const float x = (float)m * (1.0f / 128.0f);
            const float v = (n < 256) ? cospif(x) : sinpif(x);
            DC[i] = (h16)(v * 0.0625f);
        }
        h16* RWH = (h16*)(ws + OFF_RWH); h16* RWL = (h16*)(ws + OFF_RWL);
        for (int i = bid * NT + tid; i < 16 * 2048; i += nblk * NT) {
            const int e = i >> 11, k = i & 2047;
            const float w = p.in[25][k * 16 + e];
            const h16 wh = (h16)w;
            RWH[i] = wh; RWL[i] = (h16)((w - (float)wh) * 4096.0f);
        }
        float* RP = (float*)(ws + OFF_ROPE);
        for (int i = bid * NT + tid; i < 2048 * 64; i += nblk * NT) {
            const int t = i >> 6, f = i & 63;
            const int fi = f & 31;
            const float inv = powf(10000.0f, -(float)(2 * fi) / 64.0f);
            const float pos = (f < 32) ? (float)(t >> 6) : (float)(t & 63);
            const float ang = pos * inv;
            RP[2 * i] = cosf(ang); RP[2 * i + 1] = sinf(ang);
        }
    }
}
__device__ __forceinline__ void phase_prologue(const Params& p, char* smem, int bid, int nblk) {
    mod_gemv(p, smem, 0, bid, nblk);
    const int extra = 384 % nblk;
    if (extra == 0) phase_tables(p, bid, nblk);
    else if (bid >= extra) phase_tables(p, bid - extra, nblk - extra);
    __syncthreads();
#pragma unroll 1
    for (int rp = 0; rp < (PROBE_PHASE == 302 ? 3 : 1); ++rp)
    conv_run(smem, CONV_T6 - 4 * POOL_STEPS, bid, nblk, [&](int t) { return conv_desc_prologue(p, t); });
}

__device__ __forceinline__ void phase_modfin(const Params& p, int bid, int nblk) {
    const float* modp = (const float*)(p.ws + OFF_MODP);
    float* mod = (float*)(p.ws + OFF_MOD);
    for (int i = bid * NT + threadIdx.x; i < 2 * 5 * 12288; i += nblk * NT) {
        const int n = i % 12288, l = i / (5 * 12288);
        float s = p.in[5][l * 12288 + n];
#pragma unroll
        for (int ks = 0; ks < 16; ++ks) s += modp[(size_t)ks * (2 * 5 * 12288) + i];
        mod[i] = s;
    }
}
__device__ __forceinline__ const float* modv(const Params& p, int l, int v, int part) { return (const float*)(p.ws + OFF_MOD) + ((size_t)(l * 5 + v) * 6 + part) * 2048; }

__device__ __forceinline__ void phase_norm0(const Params& p, char* smem, int bid, int nblk) {
    const int tid = threadIdx.x, lane = tid & 63, wave = tid >> 6;
    h16* H = (h16*)(p.ws + OFF_H);
    float* fac = (float*)smem;
    for (int i = tid; i < 5 * 2048; i += NT) {
        const int v = i >> 11, k = i & 2047;
        fac[(v * 2) * 2048 + k] = p.in[6][k] * (modv(p, 0, v, 1)[k] + 1.0f);
        fac[(v * 2 + 1) * 2048 + k] = modv(p, 0, v, 0)[k];
    }
    __syncthreads();
    auto rowptr = [&](int R, int& v) {
        const int b = R / SALL, s = R % SALL;
        if (s < CTXL) { v = 4; return p.in[2] + ((size_t)b * CTXL + s) * D; }
        v = b; return p.in[0] + ((size_t)b * SEQ + (s - CTXL)) * D;
    };
    int R = bid * NW + wave;
    if (R >= ROWS0) return;
    int v; const float* xr = rowptr(R, v);
    f32x4 x[8];
#pragma unroll
    for (int i = 0; i < 8; ++i) x[i] = *(const f32x4*)(xr + i * 256 + lane * 4);
    for (;;) {
        const int Rn = R + nblk * NW;
        const bool more = Rn < ROWS0;
        int vn = v; f32x4 xn[8];
        if (more) {
            const float* xq = rowptr(Rn, vn);
#pragma unroll
            for (int i = 0; i < 8; ++i) xn[i] = *(const f32x4*)(xq + i * 256 + lane * 4);
        }
        float ss = 0.f;
#pragma unroll
        for (int i = 0; i < 8; ++i) ss += x[i][0] * x[i][0] + x[i][1] * x[i][1] + x[i][2] * x[i][2] + x[i][3] * x[i][3];
        ss = wave_sum(ss);
        const float rstd = rsqrtf(ss * (1.0f / D) + 1e-6f);
        const float* fm = fac + (v * 2) * 2048;
#pragma unroll
        for (int i = 0; i < 8; ++i) {
            const int k = i * 256 + lane * 4;
            const f32x4 m1 = *(const f32x4*)(fm + k), h1 = *(const f32x4*)(fm + 2048 + k);
            store_h4(H + (size_t)R * D + k, (x[i] * rstd) * m1 + h1);
        }
        if (!more) break;
#pragma unroll
        for (int i = 0; i < 8; ++i) x[i] = xn[i];
        R = Rn; v = vn;
    }
}

__device__ __forceinline__ void phase_gemm_in(const Params& p, char* smem, int bid, int nblk) {
    const h16* A = (const h16*)(p.ws + OFF_H);
    const h16* Bt = (const h16*)(p.ws + OFF_WIN);
    h16* P = (h16*)(p.ws + OFF_P);
    const int MT = ROWS0 / 256, NTl = IN_COLS / 256;
    const int T = MT * NTl, rounds = (T + nblk - 1) / nblk, ngemm = (T + rounds - 1) / rounds, nfree = nblk - ngemm;
    auto sched = [&](int i, g8::Unit& u) {
        const int t = bid + i * ngemm;
        if (bid >= ngemm || t >= T) return false;
        int tm, tn; tile_order(t, MT, NTl, tm, tn);
        u.a = A + (size_t)(tm * 256) * D; u.b = Bt + (size_t)(tn * 256) * D; u.u0 = tm; u.u1 = tn; u.u2 = 0; u.u3 = 0;
        return true;
    };
    gemm_phase8(smem, D, D, D, sched, [&](const g8::Unit& u, const f32x4 (&acc)[2][2][4][2], int wr, int wc, int fr, int fq) {
        const int tm = u.u0, tn = u.u1;
        acc8_foreach(acc, wr, wc, fr, fq, [&](int r, int c, f32x4 v) { store_h4(P + (size_t)(tm * 256 + r) * IN_COLS + tn * 256 + c, v); });
    });
    unsigned* ctl = (unsigned*)(p.ws + OFF_CTL);
    if (nfree == 0) mod_gemv(p, smem, 1, bid, nblk);
    else if (bid >= ngemm) {
        mod_gemv(p, smem, 1, bid - ngemm, nfree);
        volatile LAS int* sitem = (volatile LAS int*)(smem + GEMM_LDS + 16);
        for (;;) {
            __syncthreads();
            if (threadIdx.x == 0) {
                int s = -1;
                if (__hip_atomic_load(&ctl[CW_GDONE], __ATOMIC_RELAXED, __HIP_MEMORY_SCOPE_AGENT) < (unsigned)ngemm) {
                    const unsigned t = atomicAdd(&ctl[CW_POOL], 1u);
                    if (t < (unsigned)(POOL_STEPS / 2)) s = (int)t;
                }
                *sitem = s;
            }
            __syncthreads();
            const int s = *sitem;
            if (s < 0) break;
            conv_pool_step(p, smem, s);
        }
    } else if (threadIdx.x == 0) atomicAdd(&ctl[CW_GDONE], 1u);
}

__device__ __forceinline__ void phase_prep(const Params& p, char* smem, int bid, int nblk) {
    const int tid = threadIdx.x, lane = tid & 63, wave = tid >> 6;
    char* ws = p.ws;
    const h16* P = (const h16*)(ws + OFF_P);
    h16* SR = (h16*)(ws + OFF_SR); h16* SV = (h16*)(ws + OFF_SV); h16* SKS = (h16*)(ws + OFF_SKS); h16* SKK = (h16*)(ws + OFF_SKK);
    h16* F = (h16*)(ws + OFF_F);
    h16* Q = (h16*)(ws + OFF_Q); h16* KB = (h16*)(ws + OFF_KB); h16* VB = (h16*)(ws + OFF_VB);
    const float* RP = (const float*)(ws + OFF_ROPE);
    float* mu = (float*)smem;
    for (int i = tid; i < A_COLS; i += NT) { mu[i] = p.in[9][i]; mu[A_COLS + i] = p.in[10][i]; }
    for (int i = tid; i < 1024; i += NT) mu[2 * A_COLS + i] = p.in[16][i];
    const int l16 = lane & 15;
    f32x4 qg[2], kg[2];
#pragma unroll
    for (int j = 0; j < 2; ++j) { qg[j] = *(const f32x4*)(p.in[21] + 8 * l16 + 4 * j); kg[j] = *(const f32x4*)(p.in[22] + 8 * l16 + 4 * j); }
    __syncthreads();
    for (int R = bid * NW + wave; R < ROWS0; R += nblk * NW) {
        const int b = R / SALL, s = R % SALL;
        const bool has_prev = !(s == 0 || s == CTXL);
        const bool has_next = !(s == CTXL - 1 || s == SALL - 1);
        const bool lat = (s >= CTXL);
        const int t = lat ? s - CTXL : 0;
        const h16* p0 = P + (size_t)R * IN_COLS;
        const h16* pm = has_prev ? p0 - IN_COLS : p0; const h16* pn = has_next ? p0 + IN_COLS : p0;
        h16x4 a[12], am[12], an[12];
#pragma unroll
        for (int j = 0; j < 12; ++j) {
            const int col = (j >> 2) * 1024 + (j & 3) * 256 + lane * 4;
            a[j] = *(const h16x4*)(p0 + col); am[j] = *(const h16x4*)(pm + col); an[j] = *(const h16x4*)(pn + col);
        }
        const int lcol = 3072 + lane * 4;
        const h16x4 la = *(const h16x4*)(p0 + lcol), lam = *(const h16x4*)(pm + lcol), lan = *(const h16x4*)(pn + lcol);
        const h16x8 q0 = *(const h16x8*)(p0 + A_COLS + lane * 8), q1 = *(const h16x8*)(p0 + A_COLS + 512 + lane * 8);
        const h16x8 kv = *(const h16x8*)(p0 + A_COLS + 1024 + lane * 8);
        f32x4 rp0 = {1.f, 0.f, 1.f, 0.f}, rp1 = rp0;
        if (lat) { const float* rp = RP + ((size_t)t * 64 + 4 * l16) * 2; rp0 = *(const f32x4*)rp; rp1 = *(const f32x4*)(rp + 4); }
        const float fp = has_prev ? 1.f : 0.f, fn = has_next ? 1.f : 0.f;
        __builtin_amdgcn_sched_barrier(0);
#pragma unroll
        for (int j = 0; j < 12; ++j) {
            const int part = j >> 2, c = (j & 3) * 256 + lane * 4, col = part * 1024 + c;
            const f32x4 mp = *(const f32x4*)(mu + col), mn = *(const f32x4*)(mu + A_COLS + col);
            f32x4 y;
#pragma unroll
            for (int e = 0; e < 4; ++e) { const float x0 = (float)a[j][e]; y[e] = x0 + mp[e] * (fp * (float)am[j][e] - x0) + mn[e] * (fn * (float)an[j][e] - x0); }
            if (part == 0) store_h4(SR + (size_t)R * DA + c, y);
            else if (part == 2) store_h4(SV + (size_t)R * DA + c, y);
            else {
                store_h4(SKS + (size_t)R * DA + c, y);
                const f32x4 kk4 = *(const f32x4*)(mu + 2 * A_COLS + c);
                f32x4 z = y * kk4;
                float ss = z[0] * z[0] + z[1] * z[1] + z[2] * z[2] + z[3] * z[3];
                ss = row16_sum(ss);
                z = z * rsqrtf(ss + 1e-12f);
                store_h4(SKK + (size_t)R * DA + c, z);
            }
            __builtin_amdgcn_sched_barrier(0);
        }
        {
            const f32x4 mp = *(const f32x4*)(mu + lcol), mn = *(const f32x4*)(mu + A_COLS + lcol);
            f32x4 y;
#pragma unroll
            for (int e = 0; e < 4; ++e) {
                const float x0 = (float)la[e];
                const float v = x0 + mp[e] * (fp * (float)lam[e] - x0) + mn[e] * (fn * (float)lan[e] - x0);
                y[e] = (lane < 16) ? ftanh_(v) : (lane < 32) ? v : fsigmoid_(v);
            }
            store_h4(F + (size_t)R * 256 + lane * 4, y);
        }
        {
            auto normrope = [&](const h16x8& v, const f32x4 (&g)[2], float scale) {
                float x[8]; float ss = 0.f;
#pragma unroll
                for (int e = 0; e < 8; ++e) { x[e] = (float)v[e]; ss += x[e] * x[e]; }
                ss = row16_sum(ss);
                const float rstd = rsqrtf(ss * (1.0f / 128.0f) + 1e-6f);
#pragma unroll
                for (int e = 0; e < 8; ++e) x[e] = x[e] * rstd * g[e >> 2][e & 3];
                h16x8 o;
#pragma unroll
                for (int j = 0; j < 4; ++j) {
                    const float cs = (j < 2) ? rp0[2 * j] : rp1[2 * j - 4], sn = (j < 2) ? rp0[2 * j + 1] : rp1[2 * j - 3];
                    o[2 * j] = (h16)((x[2 * j] * cs - x[2 * j + 1] * sn) * scale); o[2 * j + 1] = (h16)((x[2 * j] * sn + x[2 * j + 1] * cs) * scale);
                }
                return o;
            };
            const int hh = lane >> 4;
            if (lat) {
                const float qs = 0.12751743074602897f;
                *(h16x8*)(Q + (((size_t)(b * 8 + hh) * SEQ + t) * 128 + 8 * l16)) = normrope(q0, qg, qs);
                *(h16x8*)(Q + (((size_t)(b * 8 + 4 + hh) * SEQ + t) * 128 + 8 * l16)) = normrope(q1, qg, qs);
            }
            const h16x8 ko = normrope(kv, kg, 1.0f);
            if (lane < 32) *(h16x8*)(KB + (((size_t)(b * 2 + hh) * SALL + s) * 128 + 8 * l16)) = ko;
            else *(h16x8*)(VB + (((size_t)(b * 2 + hh - 2) * SALL + s) * 128 + 8 * l16)) = kv;
        }
    }
}

__device__ __forceinline__ void phase_lora(const Params& p, char* smem, int bid, int nblk) {
    char* ws = p.ws;
    const h16* F = (const h16*)(ws + OFF_F);
    const int MT = ROWS0 / 256;
    const int T0 = MT * 8, T1 = T0 + MT * 8, T2 = T1 + MT * 4;
    for (int t = bid; t < T2; t += nblk) {
        f32x4 acc[8][4];
        if (t < T0) {
            const int tm = t % MT, tn = t / MT;
            const h16* Bt = (const h16*)(ws + OFF_W2T);
            gemm_tile(smem, [&](int r) { return F + (size_t)(tm * 256 + r) * 256; }, [&](int n) { return Bt + (size_t)(tn * 256 + perm16(n)) * 64; }, 64, acc);
            const float* w0 = p.in[11];
            f32x4 bias[4];
#pragma unroll
            for (int q = 0; q < 4; ++q) bias[q] = *(const f32x4*)(w0 + tn * 256 + 64 * ((threadIdx.x >> 6) & 3) + 16 * ((threadIdx.x & 63) >> 4) + 4 * q);
            acc_foreach16(acc, [&](int r, int c, const f32x4 (&v)[4]) {
                const int R = tm * 256 + r, n = tn * 256 + c, d = n >> 10, ch = n & 1023;
                f32x4 o[4];
#pragma unroll
                for (int q = 0; q < 4; ++q) {
                    const f32x4 b4 = bias[q];
#pragma unroll
                    for (int e = 0; e < 4; ++e) {
                        const float z = v[q][e] + b4[e];
                        o[q][e] = 0.6065306597126334f * fsigmoid_(z);
                    }
                }
                h16* W = (h16*)(ws + (d ? OFF_SW1 : OFF_SW0));
                store_h16(W + (size_t)R * DA + ch, o);
            });
        } else if (t < T1) {
            const int u = t - T0; const int tm = u % MT, tn = u / MT;
            const h16* Bt = (const h16*)(ws + OFF_A2T);
            gemm_tile(smem, [&](int r) { return F + (size_t)(tm * 256 + r) * 256 + 64; }, [&](int n) { return Bt + (size_t)(tn * 256 + perm16(n)) * 64; }, 64, acc);
            const float* a0 = p.in[13];
            f32x4 bias[4];
#pragma unroll
            for (int q = 0; q < 4; ++q) bias[q] = *(const f32x4*)(a0 + tn * 256 + 64 * ((threadIdx.x >> 6) & 3) + 16 * ((threadIdx.x & 63) >> 4) + 4 * q);
            acc_foreach16(acc, [&](int r, int c, const f32x4 (&v)[4]) {
                const int R = tm * 256 + r, n = tn * 256 + c, d = n >> 10, ch = n & 1023;
                f32x4 av[4];
#pragma unroll
                for (int q = 0; q < 4; ++q) {
                    const f32x4 b4 = bias[q];
#pragma unroll
                    for (int e = 0; e < 4; ++e) av[q][e] = fsigmoid_(v[q][e] + b4[e]);
                }
                store_h16((h16*)(ws + (d ? OFF_SKD1 : OFF_SKD0)) + (size_t)R * DA + ch, av);
            });
        } else {
            const int u = t - T1; const int tm = u % MT, tn = u / MT;
            const h16* Bt = (const h16*)(ws + OFF_G2T);
            gemm_tile(smem, [&](int r) { return F + (size_t)(tm * 256 + r) * 256 + 128; }, [&](int n) { return Bt + (size_t)(tn * 256 + perm16(n)) * 128; }, 128, acc);
            h16* SG = (h16*)(ws + OFF_SG);
            acc_foreach16(acc, [&](int r, int c, const f32x4 (&v)[4]) { store_h16(SG + (size_t)(tm * 256 + r) * DA + tn * 256 + c, v); });
        }
    }
}

__device__ __forceinline__ int srow_of(int dir, int tau) { return dir ? ((tau < CTXL) ? (CTXL - 1 - tau) : (SALL + CTXL - 1 - tau)) : tau; }

__device__ __forceinline__ void phase_chunkprep(const Params& p, char* smem, int bid, int nblk) {
    char* ws = p.ws;
    const int tid = threadIdx.x, lane = tid & 63, wave = tid >> 6;
    const int fr = lane & 15, g = lane >> 4;
    {
        const h16* VB = (const h16*)(ws + OFF_VB); h16* VT = (h16*)(ws + OFF_VT);
        h16* tl = (h16*)smem;
        for (int tile = bid; tile < 8 * (SALL / 64); tile += nblk) {
            const int pair = tile / (SALL / 64), kt = tile % (SALL / 64);
            __syncthreads();
#pragma unroll
            for (int i = 0; i < 2; ++i) {
                const int e = tid + i * NT;
                const h16x8 v = *(const h16x8*)(VB + ((size_t)pair * SALL + kt * 64 + (e >> 4)) * 128 + (e & 15) * 8);
                h16* dp = tl + (e >> 4) * 132 + (e & 15) * 8;
                *(h16x4*)dp = (h16x4){v[0], v[1], v[2], v[3]}; *(h16x4*)(dp + 4) = (h16x4){v[4], v[5], v[6], v[7]};
            }
            __syncthreads();
            const int d = tid >> 2, pc = tid & 3;
            b16x8 o0, o1;
#pragma unroll
            for (int q = 0; q < 16; ++q) {
                const int pos = pc * 16 + q, p32 = pos & 31, gq = p32 >> 3, jj = p32 & 7;
                const int key = (pos & 32) + ((jj < 4) ? (4 * gq + jj) : (16 + 4 * gq + jj - 4));
                const __bf16 val = (__bf16)(float)tl[key * 132 + d];
                if (q < 8) o0[q] = val; else o1[q - 8] = val;
            }
            h16* dst = VT + ((size_t)pair * 128 + d) * SALL + kt * 64 + pc * 16;
            *(b16x8*)dst = o0; *(b16x8*)(dst + 8) = o1;
        }
        __syncthreads();
    }
    char* wl = smem + wave * 12288;
    h16* At = (h16*)(wl); h16* Rt = (h16*)(wl + 2048); h16* Btl = (h16*)(wl + 4096); h16* Ktl = (h16*)(wl + 6144);
    h16* Bj = (h16*)(wl + 8192); h16* Kj = (h16*)(wl + 10240);
    const h16* SKK = (const h16*)(ws + OFF_SKK); const h16* SR = (const h16*)(ws + OFF_SR);
    h16 rkk[16], ral[16], rsw[16], rsr[16], rks[16], rwn[8]; float rka = 0.f;
    auto load_unit = [&](int uu) {
        const int item = uu / NCHUNK, c = uu - item * NCHUNK;
        const int dir = item & 1, h = (item >> 1) & 15, b = item >> 5;
        const h16* SW = (const h16*)(ws + (dir ? OFF_SW1 : OFF_SW0));
        const h16* SAL = (const h16*)(ws + (dir ? OFF_SKD1 : OFF_SKD0));
        const h16* SKS = (const h16*)(ws + OFF_SKS);
        rka = p.in[17][h * 64 + lane];
#pragma unroll
        for (int t = 0; t < 16; ++t) {
            const int s = srow_of(dir, 16 * c + t);
            const size_t idx = ((size_t)(b * SALL + s)) * DA + h * 64 + lane;
            rkk[t] = SKK[idx]; ral[t] = SAL[idx]; rsw[t] = SW[idx]; rsr[t] = SR[idx]; rks[t] = SKS[idx];
        }
        const bool hasn = (c + 1 < NCHUNK);
#pragma unroll
        for (int t = 0; t < 8; ++t) {
            const int s = srow_of(dir, 16 * (hasn ? c + 1 : c) + t);
            const h16 v = SW[((size_t)(b * SALL + s)) * DA + h * 64 + lane];
            rwn[t] = hasn ? v : (h16)0.f;
        }
    };
    const int u_first = bid * NW + wave, u_stride = nblk * NW;
    if (u_first < 128 * NCHUNK) load_unit(u_first);
    for (int u = u_first; u < 128 * NCHUNK; u += u_stride) {
        const int item = u / NCHUNK, c = u - item * NCHUNK;
        const int dir = item & 1, h = (item >> 1) & 15, b = item >> 5;
        (void)h; (void)b;
        char* rec = ws + (dir ? OFF_FRAG1 : OFF_FRAG0) + ((size_t)(((item >> 5) * 16 + ((item >> 1) & 15)) * NCHUNK + c)) * REC_BYTES;
        float w[16], at[16], rt[16], bt[16], kt[16];
        const float ka = rka;
#pragma unroll
        for (int t = 0; t < 16; ++t) {
            const float kkv = (float)rkk[t], al = (float)ral[t];
            w[t] = fexp_(-(float)rsw[t]); at[t] = -kkv; rt[t] = (float)rsr[t]; bt[t] = kkv * al; kt[t] = (float)rks[t] * (1.0f + (al - 1.0f) * ka);
        }
        float wn = 1.f;
#pragma unroll
        for (int t = 0; t < 8; ++t) wn *= fexp_(-(float)rwn[t]);
        if (u + u_stride < 128 * NCHUNK) load_unit(u + u_stride);
        float cum[16];
        cum[0] = w[0];
#pragma unroll
        for (int t = 1; t < 16; ++t) cum[t] = cum[t - 1] * w[t];
        const float w7 = cum[7], inv7 = 1.0f / w7;
        float sigma;
        {
            float rprev = inv7;
#pragma unroll
            for (int t = 0; t < 16; ++t) {
                const float rho = cum[t] * inv7;
                const float irho = w7 / cum[t];
                at[t] *= rprev; rt[t] *= rho; bt[t] *= irho; kt[t] *= irho;
                rprev = rho;
            }
            sigma = rprev * wn;
        }
        __builtin_amdgcn_wave_barrier();
#pragma unroll
        for (int t = 0; t < 16; ++t) { At[t * 64 + lane] = (h16)at[t]; Rt[t * 64 + lane] = (h16)rt[t]; Btl[t * 64 + lane] = (h16)bt[t]; Ktl[t * 64 + lane] = (h16)kt[t]; }
        {
            h16x8 b0, b1, k0, k1;
#pragma unroll
            for (int t = 0; t < 8; ++t) { b0[t] = (h16)bt[t]; b1[t] = (h16)bt[8 + t]; k0[t] = (h16)kt[t]; k1[t] = (h16)kt[8 + t]; }
            *(h16x8*)(Bj + lane * 16) = b0; *(h16x8*)(Bj + lane * 16 + 8) = b1;
            *(h16x8*)(Kj + lane * 16) = k0; *(h16x8*)(Kj + lane * 16 + 8) = k1;
        }
        __builtin_amdgcn_wave_barrier();
#pragma unroll
        for (int ks = 0; ks < 2; ++ks) {
            const h16x4 alo = *(const h16x4*)(At + fr * 64 + 32 * ks + 4 * g), ahi = *(const h16x4*)(At + fr * 64 + 32 * ks + 16 + 4 * g);
            *(h16x8*)(rec + ks * 1024 + lane * 16) = cat8(alo, ahi);
            const h16x4 rlo = *(const h16x4*)(Rt + fr * 64 + 32 * ks + 4 * g), rhi = *(const h16x4*)(Rt + fr * 64 + 32 * ks + 16 + 4 * g);
            *(h16x8*)(rec + 2048 + ks * 1024 + lane * 16) = cat8(rlo, rhi);
        }
#pragma unroll
        for (int jt = 0; jt < 4; ++jt) {
            const h16x4 blo = *(const h16x4*)(Bj + (16 * jt + fr) * 16 + 4 * g), khi = *(const h16x4*)(Kj + (16 * jt + fr) * 16 + 4 * g);
            *(h16x8*)(rec + 4096 + jt * 1024 + lane * 16) = cat8(blo, khi);
        }
        const f32x4 z4 = {0.f, 0.f, 0.f, 0.f};
        f32x4 Nak = z4, Nab = z4, Mkr = z4, Mbr = z4, NT = z4;
#pragma unroll
        for (int ks = 0; ks < 2; ++ks) {
            const h16x8 af = *(const h16x8*)(At + fr * 64 + 32 * ks + 8 * g), rf = *(const h16x8*)(Rt + fr * 64 + 32 * ks + 8 * g);
            const h16x8 bf = *(const h16x8*)(Btl + fr * 64 + 32 * ks + 8 * g), kf = *(const h16x8*)(Ktl + fr * 64 + 32 * ks + 8 * g);
            Nak = mfma32(kf, af, Nak); Nab = mfma32(bf, af, Nab); Mkr = mfma32(kf, rf, Mkr); Mbr = mfma32(bf, rf, Mbr); NT = mfma32(af, bf, NT);
        }
        f32x4 T1;
#pragma unroll
        for (int e = 0; e < 4; ++e) {
            const int row = 4 * g + e;
            if (!(row < fr)) { Nak[e] = 0.f; Nab[e] = 0.f; }
            if (!(row <= fr)) { Mkr[e] = 0.f; Mbr[e] = 0.f; }
            if (!(fr < row)) NT[e] = 0.f;
            T1[e] = Nab[e] + ((row == fr) ? 1.0f : 0.0f);
        }
        const h16x4 n1 = cvt4(Nab), m1 = cvt4(NT);
        const f32x4 N2 = mfma16(m1, n1, z4), M2 = mfma16(n1, m1, z4);
        const h16x4 n2 = cvt4(N2), m2 = cvt4(M2);
        const f32x4 T2 = mfma16(m2, cvt4(T1), T1);
        const f32x4 N4 = mfma16(m2, n2, z4), M4 = mfma16(n2, m2, z4);
        const h16x4 n4 = cvt4(N4), m4 = cvt4(M4);
        const f32x4 T4 = mfma16(m4, cvt4(T2), T2);
        const f32x4 M8 = mfma16(n4, m4, z4);
        const f32x4 T8 = mfma16(cvt4(M8), cvt4(T4), T4);
        *(h16x8*)(rec + 8192 + lane * 16) = cat8(cvt4(Mbr), cvt4(Mkr));
        *(h16x4*)(rec + 9216 + lane * 8) = cvt4(T8);
        *(h16x4*)(rec + 9728 + lane * 8) = cvt4(Nak);
        *(float*)(rec + 10240 + lane * 4) = sigma;
        __builtin_amdgcn_wave_barrier();
    }
}

constexpr int SLOT_BYTES = REC_BYTES + 2048;
__device__ __forceinline__ void scan_item(const Params& p, char* smem, int item) {
    char* ws = p.ws;
    const int tid = threadIdx.x, lane = tid & 63;
    const int wave = __builtin_amdgcn_readfirstlane(tid >> 6);
    const int il = lane & 15, g = lane >> 4;
    const int dir = item & 1, h = (item >> 1) & 15, b = item >> 5;
    const char* rec0 = ws + (dir ? OFF_FRAG1 : OFF_FRAG0) + ((size_t)((b * 16 + h) * NCHUNK)) * REC_BYTES;
    const h16* SV = (const h16*)(ws + OFF_SV);
    h16* Y = (h16*)(ws + (dir ? OFF_Y1 : OFF_Y0));
    const f32x4 z4 = {0.f, 0.f, 0.f, 0.f};
    f32x4 P[4];
#pragma unroll
    for (int jt = 0; jt < 4; ++jt) P[jt] = z4;
    u32x4 lr[11], lv[2];
    auto issue = [&](int c) {
        const char* rec = rec0 + (size_t)c * REC_BYTES;
#pragma unroll
        for (int m = 0; m < 10; ++m) lr[m] = *(const u32x4*)(rec + m * 1024 + lane * 16);
        lr[10] = *(const u32x4*)(rec + 10240 + (lane & 15) * 16);
        const int s = srow_of(dir, 16 * c + (lane >> 2));
        const h16* vp = SV + ((size_t)(b * SALL + s)) * DA + h * 64 + (lane & 3) * 16;
        lv[0] = *(const u32x4*)vp; lv[1] = *(const u32x4*)(vp + 8);
    };
    auto writeslot = [&](int c) {
        char* sl = smem + (c & 3) * SLOT_BYTES;
#pragma unroll
        for (int m = 0; m < 10; ++m) *(u32x4*)(sl + m * 1024 + lane * 16) = lr[m];
        if (lane < 16) *(u32x4*)(sl + 10240 + lane * 16) = lr[10];
        *(u32x4*)(sl + REC_BYTES + (lane >> 2) * 128 + (lane & 3) * 32) = lv[0];
        *(u32x4*)(sl + REC_BYTES + (lane >> 2) * 128 + (lane & 3) * 32 + 16) = lv[1];
    };
    __syncthreads();
    if (wave >= 4) issue(wave - 4);
#pragma unroll 1
    for (int n = 0; n <= NCHUNK; ++n) {
        if (wave >= 4) {
            if (n < NCHUNK && (n & 3) == wave - 4) { writeslot(n); if (n + 4 < NCHUNK) issue(n + 4); }
        } else if (n >= 1) {
            const int c = n - 1;
            const char* sl = smem + (c & 3) * SLOT_BYTES;
            h16x8 a1[2], a3r[2], a4[4];
#pragma unroll
            for (int ks = 0; ks < 2; ++ks) { a1[ks] = *(const h16x8*)(sl + ks * 1024 + lane * 16); a3r[ks] = *(const h16x8*)(sl + 2048 + ks * 1024 + lane * 16); }
#pragma unroll
            for (int jt = 0; jt < 4; ++jt) a4[jt] = *(const h16x8*)(sl + 4096 + jt * 1024 + lane * 16);
            const h16x8 a3m = *(const h16x8*)(sl + 8192 + lane * 16);
            const h16x4 a2 = *(const h16x4*)(sl + 9216 + lane * 8);
            const h16x4 a1v = *(const h16x4*)(sl + 9728 + lane * 8);
            f32x4 sg[4];
#pragma unroll
            for (int jt = 0; jt < 4; ++jt) sg[jt] = *(const f32x4*)(sl + 10240 + (16 * jt + 4 * g) * 4);
            const h16* Vl = (const h16*)(sl + REC_BYTES);
            const h16x4 zh = {0, 0, 0, 0};
            const h16x8 A1V = cat8(zh, a1v);
            const bool lat = (c >= CTXL / 16);
            {
                const int it = wave;
                h16x4 vq;
#pragma unroll
                for (int e = 0; e < 4; ++e) vq[e] = Vl[(4 * g + e) * 64 + 16 * it + il];
                const h16x8 bp0 = cat8(cvt4(P[0]), cvt4(P[1])), bp1 = cat8(cvt4(P[2]), cvt4(P[3]));
                f32x4 G = mfma32(A1V, cat8(zh, vq), z4);
                G = mfma32(a1[0], bp0, G); G = mfma32(a1[1], bp1, G);
                const f32x4 U = mfma16(a2, cvt4(G), z4);
                const h16x8 buv = cat8(cvt4(U), vq);
                if (lat) {
                    f32x4 Yv = mfma32(a3r[0], bp0, z4); Yv = mfma32(a3r[1], bp1, Yv); Yv = mfma32(a3m, buv, Yv);
#pragma unroll
                    for (int e = 0; e < 4; ++e) {
                        const int s = srow_of(dir, 16 * c + 4 * g + e);
                        Y[((size_t)(b * SEQ + s - CTXL)) * DA + h * 64 + 16 * it + il] = (h16)Yv[e];
                    }
                }
#pragma unroll
                for (int jt = 0; jt < 4; ++jt) P[jt] = mfma32(a4[jt], buv, P[jt]) * sg[jt];
            }
        }
        __syncthreads();
    }
}

__device__ __forceinline__ void attn_item(const Params& p, char* smem, int item, float negB) {
    char* ws = p.ws;
    const int tid = threadIdx.x, lane = tid & 63, wave = tid >> 6;
    const int fr = lane & 15, fq = lane >> 4;
    const int pair = item >> 5, j = item & 31;
    const int b = pair >> 1, kvh = pair & 1, hq = kvh * 4 + (j >> 3), qt = j & 7;
    const h16* Qp = (const h16*)(ws + OFF_Q) + (((size_t)(b * 8 + hq) * SEQ) + qt * 256 + wave * 32) * 128;
    const h16* Kp = (const h16*)(ws + OFF_KB) + ((size_t)(b * 2 + kvh) * SALL) * 128;
    const h16* Vp = (const h16*)(ws + OFF_VT) + ((size_t)(b * 2 + kvh) * 128) * SALL;
    h16x8 qf[2][4];
#pragma unroll
    for (int qi = 0; qi < 2; ++qi)
#pragma unroll
        for (int ds = 0; ds < 4; ++ds) qf[qi][ds] = *(const h16x8*)(Qp + (size_t)(16 * qi + fr) * 128 + 32 * ds + 8 * fq);
    const f32x4 zero4 = {0.f, 0.f, 0.f, 0.f};
    f32x4 o[2][8];
#pragma unroll
    for (int qi = 0; qi < 2; ++qi)
#pragma unroll
        for (int dt = 0; dt < 8; ++dt) o[qi][dt] = zero4;
    float lrun[2] = {0.f, 0.f};
    const f32x4 negB4 = {negB, negB, negB, negB};
    int ksrc[2], vsrc[2];
#pragma unroll
    for (int i = 0; i < 2; ++i) {
        const int krow = 4 * (2 * wave + i) + (lane >> 4);
        ksrc[i] = krow * 128 + (((lane & 15) ^ (krow & 15)) << 3);
        const int vrow = 8 * (2 * wave + i) + (lane >> 3);
        vsrc[i] = vrow * SALL + (((lane & 7) ^ ((vrow >> 1) & 7)) << 3);
    }
    char* ldsK = smem + (2 * wave) * 1024 + lane * 16;
    char* ldsV = smem + 16384 + (2 * wave) * 1024 + lane * 16;
    const int kfo = fr * 256, vfo = fr * 128, vsw = (fr >> 1) & 7;
    const int NKT = SALL / 64;
    WAIT_V(0);
    __syncthreads();
#pragma unroll
    for (int st0 = 0; st0 < 3; ++st0) {
#pragma unroll
        for (int i = 0; i < 2; ++i) { glds16(Kp + (ksrc[i] + st0 * 64 * 128), ldsK + st0 * 32768 + i * 1024); glds16(Vp + (vsrc[i] + st0 * 64), ldsV + st0 * 32768 + i * 1024); }
    }
#define ATT_S(ST, kbuf) { \
        __builtin_amdgcn_s_setprio(1); \
        _Pragma("unroll") for (int ds = 0; ds < 4; ++ds) { \
            h16x8 kf_[4]; \
            _Pragma("unroll") for (int k4 = 0; k4 < 4; ++k4) kf_[k4] = *(const h16x8*)((kbuf) + k4 * 4096 + kfo + (((4 * ds + fq) ^ fr) << 4)); \
            _Pragma("unroll") for (int qi = 0; qi < 2; ++qi) _Pragma("unroll") for (int k4 = 0; k4 < 4; ++k4) \
                ST[qi][k4] = __builtin_amdgcn_mfma_f32_16x16x32_f16(kf_[k4], qf[qi][ds], ds == 0 ? negB4 : ST[qi][k4], 0, 0, 0); } \
        __builtin_amdgcn_s_setprio(0); }
#define ATT_SOFTMAX_PV(ST, vbuf) { \
        b16x8 pf0[2], pf1[2]; \
        _Pragma("unroll") for (int qi = 0; qi < 2; ++qi) { \
            float ps = 0.f; \
            _Pragma("unroll") for (int k4 = 0; k4 < 4; ++k4) _Pragma("unroll") for (int e = 0; e < 4; ++e) { const float pe = __builtin_amdgcn_exp2f(ST[qi][k4][e]); ST[qi][k4][e] = pe; ps += pe; } \
            lrun[qi] += ps; \
            _Pragma("unroll") for (int e = 0; e < 4; ++e) { pf0[qi][e] = (__bf16)ST[qi][0][e]; pf0[qi][4 + e] = (__bf16)ST[qi][1][e]; pf1[qi][e] = (__bf16)ST[qi][2][e]; pf1[qi][4 + e] = (__bf16)ST[qi][3][e]; } } \
        __builtin_amdgcn_s_setprio(1); \
        _Pragma("unroll") for (int dt = 0; dt < 8; ++dt) { \
            const b16x8 v0 = *(const b16x8*)((vbuf) + dt * 2048 + vfo + (((0 + fq) ^ vsw) << 4)); \
            const b16x8 v1 = *(const b16x8*)((vbuf) + dt * 2048 + vfo + (((4 + fq) ^ vsw) << 4)); \
            o[0][dt] = __builtin_amdgcn_mfma_f32_16x16x32_bf16(v0, pf0[0], o[0][dt], 0, 0, 0); \
            o[1][dt] = __builtin_amdgcn_mfma_f32_16x16x32_bf16(v0, pf0[1], o[1][dt], 0, 0, 0); \
            o[0][dt] = __builtin_amdgcn_mfma_f32_16x16x32_bf16(v1, pf1[0], o[0][dt], 0, 0, 0); \
            o[1][dt] = __builtin_amdgcn_mfma_f32_16x16x32_bf16(v1, pf1[1], o[1][dt], 0, 0, 0); } \
        __builtin_amdgcn_s_setprio(0); }
#define ATT_STEP(kt) { \
        if ((kt) + 2 < NKT) { WAIT_V(8); } else if ((kt) + 1 < NKT) { WAIT_V(4); } else { WAIT_V(0); } \
        __builtin_amdgcn_s_barrier(); \
        if ((kt) + 3 < NKT) { const int so = (((kt) + 3) & 3) * 32768; \
            _Pragma("unroll") for (int i = 0; i < 2; ++i) { glds16(Kp + (ksrc[i] + ((kt) + 3) * 64 * 128), ldsK + so + i * 1024); glds16(Vp + (vsrc[i] + ((kt) + 3) * 64), ldsV + so + i * 1024); } } \
        ATT_S(st, smem + ((kt) & 3) * 32768) \
        ATT_SOFTMAX_PV(st, smem + ((kt) & 3) * 32768 + 16384) }
    f32x4 st[2][4];
#pragma unroll 1
    for (int kt = 0; kt < NKT; ++kt) ATT_STEP(kt)
#undef ATT_STEP
#undef ATT_SOFTMAX_PV
#undef ATT_S
    h16* YM = (h16*)(ws + OFF_YMIX);
#pragma unroll
    for (int qi = 0; qi < 2; ++qi) {
        float l = lrun[qi];
        l += __shfl_xor(l, 16); l += __shfl_xor(l, 32);
        const float inv = 1.0f / l;
        const int tok = qt * 256 + wave * 32 + 16 * qi + fr;
        h16* dst = YM + ((size_t)(b * SEQ + tok)) * D + 1024 + hq * 128;
#pragma unroll
        for (int dt = 0; dt < 8; ++dt) store_h4(dst + 16 * dt + 4 * fq, o[qi][dt] * inv);
    }
}

__device__ __forceinline__ void phase_mix(const Params& p, char* smem, int bid, int nblk, int qoff, int probe_n) {
    unsigned* ctl = (unsigned*)(p.ws + OFF_CTL);
    float negB;
    {
        const int lane = threadIdx.x & 63;
        float mq = fmaxf(fabsf(p.in[21][lane]), fabsf(p.in[21][64 + lane])), mk = fmaxf(fabsf(p.in[22][lane]), fabsf(p.in[22][64 + lane]));
#pragma unroll
        for (int o = 1; o < 64; o <<= 1) { mq = fmaxf(mq, __shfl_xor(mq, o)); mk = fmaxf(mk, __shfl_xor(mk, o)); }
        negB = -fminf(128.0f * 0.12751743074602897f * mq * mk, 63.0f);
    }
    volatile LAS int* sitem = (volatile LAS int*)(smem + GEMM_LDS + 16);
    for (;;) {
        __syncthreads();
        if (threadIdx.x == 0) *sitem = (int)atomicAdd(&ctl[CW_QUEUE + qoff], 1u);
        __syncthreads();
        const int item = *sitem;
        if (item >= 128) break;
        scan_item(p, smem, item);
    }
    const int x0 = (int)(xb_xcc_id() & 7u);
    for (int q = 0; q < 8; ++q) {
        const int pair = (x0 + q) & 7;
        for (;;) {
            __syncthreads();
            if (threadIdx.x == 0) *sitem = (int)atomicAdd(&ctl[CW_AQ + qoff + 16 * pair], 1u);
            __syncthreads();
            const int jj = *sitem;
            if (jj >= 32) break;
            const int item = pair * 32 + jj;
            if (PROBE_PHASE == 61) { _Pragma("unroll 1") for (int r = 0; r < probe_n; ++r) attn_item(p, smem, item, negB); }
            else attn_item(p, smem, item, negB);
            if (threadIdx.x == 0) atomicAdd(&ctl[CW_ADONE], 1u);
        }
    }
    for (;;) {
        __syncthreads();
        if (threadIdx.x == 0) {
            int s = -1;
            if (__hip_atomic_load(&ctl[CW_ADONE], __ATOMIC_RELAXED, __HIP_MEMORY_SCOPE_AGENT) < 256u) {
                const unsigned t = atomicAdd(&ctl[CW_POOL], 1u);
                if (t < (unsigned)(POOL_STEPS / 2)) s = (int)t;
            }
            *sitem = s;
        }
        __syncthreads();
        const int s = *sitem;
        if (s < 0) break;
        conv_pool_step(p, smem, s);
    }
}

__device__ __forceinline__ void phase_finish(const Params& p, int bid, int nblk) {
    char* ws = p.ws;
    const int lane = threadIdx.x & 63, wave = threadIdx.x >> 6;
    const h16* Y0 = (const h16*)(ws + OFF_Y0); const h16* Y1 = (const h16*)(ws + OFF_Y1);
    const h16* SR = (const h16*)(ws + OFF_SR); const h16* SV = (const h16*)(ws + OFF_SV); const h16* SG = (const h16*)(ws + OFF_SG);
    const h16* KD0 = (const h16*)(ws + OFF_SKD0); const h16* KD1 = (const h16*)(ws + OFF_SKD1);
    const h16* SKS = (const h16*)(ws + OFF_SKS); const float* k_a = p.in[17];
    h16* YM = (h16*)(ws + OFF_YMIX);
    const float* r_k = p.in[18]; const float* ln_g = p.in[19]; const float* ln_b = p.in[20];
    const int c0 = (lane >> 2) * 64 + (lane & 3) * 16;
    f32x4 ka_[4], rk_[4], lg_[4], lb_[4];
#pragma unroll
    for (int u = 0; u < 4; ++u) { ka_[u] = *(const f32x4*)(k_a + c0 + 4 * u); rk_[u] = *(const f32x4*)(r_k + c0 + 4 * u); lg_[u] = *(const f32x4*)(ln_g + c0 + 4 * u); lb_[u] = *(const f32x4*)(ln_b + c0 + 4 * u); }
    for (int tl = bid * NW + wave; tl < ROWSL; tl += nblk * NW) {
        const int b = tl >> 11, t = tl & 2047;
        const size_t R = (size_t)b * SALL + CTXL + t;
        float y[16], r[16], kb[16], v[16], g[16];
#pragma unroll
        for (int u = 0; u < 4; ++u) {
            const h16x4 a = *(const h16x4*)(Y0 + (size_t)tl * DA + c0 + 4 * u), bb = *(const h16x4*)(Y1 + (size_t)tl * DA + c0 + 4 * u);
            const h16x4 rr = *(const h16x4*)(SR + R * DA + c0 + 4 * u), vv = *(const h16x4*)(SV + R * DA + c0 + 4 * u), gg = *(const h16x4*)(SG + R * DA + c0 + 4 * u);
            const h16x4 k0 = *(const h16x4*)(KD0 + R * DA + c0 + 4 * u), k1 = *(const h16x4*)(KD1 + R * DA + c0 + 4 * u), ksv = *(const h16x4*)(SKS + R * DA + c0 + 4 * u);
            const f32x4 ka4 = ka_[u];
#pragma unroll
            for (int e = 0; e < 4; ++e) { y[4 * u + e] = (float)a[e] + (float)bb[e]; r[4 * u + e] = (float)rr[e]; v[4 * u + e] = (float)vv[e]; g[4 * u + e] = (float)gg[e]; kb[4 * u + e] = (float)ksv[e] * (2.0f + ((float)k0[e] + (float)k1[e] - 2.0f) * ka4[e]); }
        }
        float sm = 0.f, bo = 0.f;
#pragma unroll
        for (int j = 0; j < 16; ++j) { sm += y[j]; bo += r[j] * kb[j] * rk_[j >> 2][j & 3]; }
        sm += __shfl_xor(sm, 1); sm += __shfl_xor(sm, 2);
        bo += __shfl_xor(bo, 1); bo += __shfl_xor(bo, 2);
        const float mu = sm * (1.0f / 64.0f);
        float vs = 0.f;
#pragma unroll
        for (int j = 0; j < 16; ++j) { const float d = y[j] - mu; vs += d * d; }
        vs += __shfl_xor(vs, 1); vs += __shfl_xor(vs, 2);
        const float rstd = rsqrtf(vs * (1.0f / 64.0f) + 64e-5f);
#pragma unroll
        for (int u = 0; u < 4; ++u) {
            f32x4 ov;
#pragma unroll
            for (int e = 0; e < 4; ++e) { const int j = 4 * u + e; const float yn = (y[j] - mu) * rstd * lg_[u][e] + lb_[u][e]; ov[e] = (yn + bo * v[j]) * g[j]; }
            store_h4(YM + (size_t)tl * D + c0 + 4 * u, ov);
        }
    }
}

__device__ __forceinline__ void phase_gemm_res(const Params& p, char* smem, int bid, int nblk, const h16* A, const h16* Bt, const float* base, int layer) {
    const int MT = ROWSL / 256, NTl = D / 256;
    h16* XH = (h16*)(p.ws + OFF_XH);
    auto sched = [&](int i, g8::Unit& u) {
        const int t = bid + i * nblk;
        if (t >= MT * NTl) return false;
        int tm, tn; tile_order(t, MT, NTl, tm, tn);
        u.a = A + (size_t)(tm * 256) * D; u.b = Bt + (size_t)(tn * 256) * D; u.u0 = tm; u.u1 = tn; u.u2 = 0; u.u3 = 0;
        return true;
    };
    gemm_phase8(smem, D, D, D, sched, [&](const g8::Unit& u, const f32x4 (&acc)[2][2][4][2], int wr, int wc, int fr, int fq) {
        const int tm = u.u0, tn = u.u1;
        const int b = (tm * 256) >> 11;
        const float* gt = modv(p, layer, b, 2);
        f32x4 g4[2][2];
#pragma unroll
        for (int bj = 0; bj < 2; ++bj)
#pragma unroll
            for (int n = 0; n < 2; ++n) g4[bj][n] = *(const f32x4*)(gt + tn * 256 + 128 * bj + 32 * wc + 16 * n + 4 * fq);
#pragma unroll
        for (int ai = 0; ai < 2; ++ai)
#pragma unroll
            for (int m0 = 0; m0 < 4; m0 += 2) {
                f32x4 x[2][2][2];
#pragma unroll
                for (int mm = 0; mm < 2; ++mm)
#pragma unroll
                    for (int bj = 0; bj < 2; ++bj)
#pragma unroll
                        for (int n = 0; n < 2; ++n) {
                            const size_t o = (size_t)(tm * 256 + 128 * ai + 64 * wr + 16 * (m0 + mm) + fr) * D + tn * 256 + 128 * bj + 32 * wc + 16 * n + 4 * fq;
                            if (layer == 0) x[mm][bj][n] = *(const f32x4*)(base + o);
                            else { const h16x4 xh = *(const h16x4*)(XH + o); x[mm][bj][n] = (f32x4){(float)xh[0], (float)xh[1], (float)xh[2], (float)xh[3]}; }
                        }
#pragma unroll
                for (int mm = 0; mm < 2; ++mm)
#pragma unroll
                    for (int bj = 0; bj < 2; ++bj)
#pragma unroll
                        for (int n = 0; n < 2; ++n) {
                            const size_t o = (size_t)(tm * 256 + 128 * ai + 64 * wr + 16 * (m0 + mm) + fr) * D + tn * 256 + 128 * bj + 32 * wc + 16 * n + 4 * fq;
                            store_h4(XH + o, x[mm][bj][n] + g4[bj][n] * acc[ai][bj][m0 + mm][n]);
                        }
            }
    });
}

__device__ __forceinline__ void phase_route(const Params& p, char* smem, int bid, int nblk, int layer, int slot) {
    char* ws = p.ws;
    const int lane = threadIdx.x & 63, wave = threadIdx.x >> 6;
    const int fr = lane & 15, g = lane >> 4;
    h16* TOK = (h16*)(ws + OFF_H);
    unsigned* cnt = (unsigned*)(ws + OFF_CTL) + CW_CNT + slot * 1024;
    int* LIST = (int*)(ws + OFF_LIST) + (size_t)slot * 16 * 8192;
    float* GW = (float*)(ws + OFF_GW) + (size_t)slot * 16384;
    const int vb = wave >> 2, w4 = wave & 3;
    const int kq = w4 * 512 + 8 * g;
    const float* gn = p.in[7] + layer * D + kq;
    const float* rb = p.in[26];
    const h16* RWH = (const h16*)(ws + OFF_RWH) + fr * 2048 + kq;
    const h16* RWL = (const h16*)(ws + OFF_RWL) + fr * 2048 + kq;
    float* red = (float*)smem + vb * (4 * 64 * 8 + 64);
    float* ssp = red + 4 * 64 * 8;
    float* fmul = (float*)smem + 2 * (4 * 64 * 8 + 64);
    float* fsh = fmul + 2048;
    for (int u0 = bid * 2; u0 < ROWSL / 16; u0 += nblk * 2) {
        const int unit = u0 + vb;
        const int tl = unit * 16 + fr;
        const int b = tl >> 11;
        const h16* xr = (const h16*)(p.ws + OFF_XH) + (size_t)tl * D + kq;
        __syncthreads();
        {
            const int bb = (u0 * 16) >> 11;
            const float* shb = modv(p, layer, bb, 3); const float* scb = modv(p, layer, bb, 4); const float* gnb = p.in[7] + layer * D;
            const int i4 = threadIdx.x * 4;
            const f32x4 g4 = *(const f32x4*)(gnb + i4), c4 = *(const f32x4*)(scb + i4), h4 = *(const f32x4*)(shb + i4);
            *(f32x4*)(fmul + i4) = g4 * (c4 + 1.0f); *(f32x4*)(fsh + i4) = h4;
        }
        float ss = 0.f;
#pragma unroll
        for (int i = 0; i < 16; ++i) {
            const h16x8 a = *(const h16x8*)(xr + 32 * i);
#pragma unroll
            for (int e = 0; e < 8; ++e) { const float f = (float)a[e]; ss += f * f; }
        }
        ss += __shfl_xor(ss, 16); ss += __shfl_xor(ss, 32);
        __syncthreads();
        if (g == 0) ssp[w4 * 16 + fr] = ss;
        __syncthreads();
        const float tot = ssp[fr] + ssp[16 + fr] + ssp[32 + fr] + ssp[48 + fr];
        const float rstd = rsqrtf(tot * (1.0f / D) + 1e-6f);
        f32x4 am = {0.f, 0.f, 0.f, 0.f}, ac = {0.f, 0.f, 0.f, 0.f};
        h16* trow = TOK + (size_t)tl * D + kq;
        h16x8 px[5], pwh[5], pwl[5];
#define ROUTE_LOAD(slot, it) { const int k_ = 32 * (it); px[slot] = *(const h16x8*)(xr + k_); pwh[slot] = *(const h16x8*)(RWH + k_); pwl[slot] = *(const h16x8*)(RWL + k_); }
        ROUTE_LOAD(0, 0) ROUTE_LOAD(1, 1) ROUTE_LOAD(2, 2) ROUTE_LOAD(3, 3)
#pragma unroll
        for (int i = 0; i < 16; ++i) {
            if (i + 4 < 16) ROUTE_LOAD((i + 4) % 5, i + 4)
            const int cs = i % 5;
            h16x8 yh, yl;
#pragma unroll
            for (int hh = 0; hh < 2; ++hh) {
                const f32x4 xq = {(float)px[cs][4 * hh], (float)px[cs][4 * hh + 1], (float)px[cs][4 * hh + 2], (float)px[cs][4 * hh + 3]};
                const f32x4 y = (xq * rstd) * *(const f32x4*)(fmul + kq + 32 * i + 4 * hh) + *(const f32x4*)(fsh + kq + 32 * i + 4 * hh);
#pragma unroll
                for (int e = 0; e < 4; ++e) { const h16 hv = (h16)y[e]; yh[4 * hh + e] = hv; yl[4 * hh + e] = (h16)((y[e] - (float)hv) * 4096.0f); }
            }
            *(h16x8*)(trow + 32 * i) = yh;
            am = mfma32(pwh[cs], yh, am); ac = mfma32(pwl[cs], yh, ac); ac = mfma32(pwh[cs], yl, ac);
        }
#undef ROUTE_LOAD
        *(f32x4*)(red + (w4 * 64 + lane) * 8) = am; *(f32x4*)(red + (w4 * 64 + lane) * 8 + 4) = ac;
        __syncthreads();
        if (w4 == 0) {
            f32x4 sm = {0.f, 0.f, 0.f, 0.f}, scn = {0.f, 0.f, 0.f, 0.f};
#pragma unroll
            for (int w = 0; w < 4; ++w) { sm += *(const f32x4*)(red + (w * 64 + lane) * 8); scn += *(const f32x4*)(red + (w * 64 + lane) * 8 + 4); }
            float sv[4], sel[4];
#pragma unroll
            for (int e = 0; e < 4; ++e) { sv[e] = sigmoidf_(sm[e] + scn[e] * (1.0f / 4096.0f)); sel[e] = sv[e] + rb[4 * g + e]; }
            float m1 = -1e30f, m2 = -1e30f;
#pragma unroll
            for (int e = 0; e < 4; ++e) { const float v = sel[e]; if (v > m1) { m2 = m1; m1 = v; } else if (v > m2) m2 = v; }
            float bs = m1 + m2; int bg = g;
#pragma unroll
            for (int o = 16; o <= 32; o <<= 1) {
                const float os = __shfl_xor(bs, o); const int og = __shfl_xor(bg, o);
                if (os > bs || (os == bs && og < bg)) { bs = os; bg = og; }
            }
            int e0 = -1, e1 = -1; float w0 = 0.f, w1 = 0.f;
            if (bg == g) {
                int i0 = 0, i1 = 0; float v0 = -1e30f, v1 = -1e30f, s0 = 0.f, s1 = 0.f;
#pragma unroll
                for (int e = 0; e < 4; ++e) { if (sel[e] > v0) { v0 = sel[e]; i0 = e; s0 = sv[e]; } }
#pragma unroll
                for (int e = 0; e < 4; ++e) { if (e != i0 && sel[e] > v1) { v1 = sel[e]; i1 = e; s1 = sv[e]; } }
                const float inv = 1.0f / (s0 + s1);
                e0 = 4 * g + i0; e1 = 4 * g + i1; w0 = s0 * inv; w1 = s1 * inv;
            }
            const unsigned long long lt = (1ull << lane) - 1ull;
            int mycount = 0, rank0 = 0, rank1 = 0;
#pragma unroll
            for (int e = 0; e < 16; ++e) {
                const unsigned long long m0 = __ballot(e0 == e), m1 = __ballot(e1 == e);
                const int c0 = __popcll(m0), c1 = __popcll(m1);
                if (lane == e) mycount = c0 + c1;
                if (e0 == e) rank0 = __popcll(m0 & lt);
                if (e1 == e) rank1 = c0 + __popcll(m1 & lt);
            }
            unsigned base = 0;
            if (lane < 16 && mycount > 0) base = atomicAdd(&cnt[lane * 64], (unsigned)mycount);
            const unsigned b0 = __shfl(base, e0 < 0 ? 0 : e0), b1 = __shfl(base, e1 < 0 ? 0 : e1);
            if (e0 >= 0) {
                LIST[e0 * 8192 + b0 + rank0] = tl * 2;
                GW[tl * 2] = w0;
                LIST[e1 * 8192 + b1 + rank1] = tl * 2 + 1;
                GW[tl * 2 + 1] = w1;
            }
        }
    }
    __syncthreads();
}

__device__ __forceinline__ void phase_moe(const Params& p, char* smem, int layer, int dslot) {
    char* ws = p.ws;
    const int tid = threadIdx.x;
    unsigned* ctl = (unsigned*)(ws + OFF_CTL);
    const unsigned* cntp = ctl + CW_CNT + layer * 1024;
    unsigned* queue = ctl + CW_MQ + layer * 64;
    unsigned* dep = ctl + CW_DEP + dslot * 256;
    const int* LIST = (const int*)(ws + OFF_LIST) + (size_t)layer * 16 * 8192;
    const float* GW = (const float*)(ws + OFF_GW) + (size_t)layer * 16384;
    const h16* TOK = (const h16*)(ws + OFF_H);
    h16* U = (h16*)(ws + OFF_U);
    h16* SLOT = (h16*)(ws + OFF_SLOT);
    volatile LAS int* sitem = (volatile LAS int*)(smem + GEMM_LDS + 16);
    int MT = 0;
    int cn[16];
#pragma unroll
    for (int e = 0; e < 16; ++e) cn[e] = __builtin_amdgcn_readfirstlane((int)cntp[e * 64]);
#pragma unroll
    for (int e = 0; e < 16; ++e) MT += (cn[e] + 255) >> 8;
    const int n1 = MT * 4, n2 = MT * 8;
    (void)queue; (void)sitem;
    const int G = (int)gridDim.x, bidx = (int)blockIdx.x;
    const int r1 = (n1 > G) ? (n1 % G) : 0;
    const int nlight = G - r1;
    const int my2 = (bidx >= r1) ? (n2 - (bidx - r1) + nlight - 1) / nlight : 0;
    auto locate = [&](int m, int& e, int& tm, int& off, int& c) {
        int mb = 0; e = 0; off = 0; c = 0;
        bool found = false;
#pragma unroll
        for (int ee = 0; ee < 16; ++ee) {
            const int cc = cn[ee]; const int mt = (cc + 255) >> 8;
            if (!found) { if (m >= mb + mt) { mb += mt; off += cc; } else { e = ee; c = cc; found = true; } }
        }
        tm = m - mb;
    };
    {
        auto sched = [&](int i, g8::Unit& u) {
            const int item = bidx + i * G;
            if (item >= n1) return false;
            const int m = item >> 2, tn = item & 3;
            int e, tm, off, c; locate(m, e, tm, off, c);
            u.a = nullptr; u.b = (const h16*)(ws + OFF_EXP + layer * EXP_L) + ((size_t)e * 1024 + tn * 256) * 2048;
            u.u0 = e; u.u1 = tm; u.u2 = tn | (m << 8); u.u3 = off; u.u4 = c;
            return true;
        };
        auto rowoff = [&](const g8::Unit& u, int r) {
            const int c = u.u4;
            int idx = u.u1 * 256 + r; idx = idx < c ? idx : c - 1;
            return (unsigned)(LIST[u.u0 * 8192 + idx] >> 1) * (unsigned)(D * 2);
        };
        gemm_phase8g<0>(smem, TOK, 2048, D, sched, rowoff, [&](const g8::Unit& u, const f32x4 (&acc)[2][2][4][2], int wr, int wc, int fr, int fq) {
            const int e = u.u0, tm = u.u1, tn = u.u2 & 255, m = u.u2 >> 8, off = u.u3;
            const int c = u.u4;
#pragma unroll
            for (int ai = 0; ai < 2; ++ai)
#pragma unroll
                for (int mm = 0; mm < 4; ++mm) {
                    const int idx = tm * 256 + 128 * ai + 64 * wr + 16 * mm + fr;
                    if (idx < c) {
#pragma unroll
                        for (int bj = 0; bj < 2; ++bj) {
                            const f32x4 g = acc[ai][bj][mm][0], up = acc[ai][bj][mm][1];
                            f32x4 o;
#pragma unroll
                            for (int q = 0; q < 4; ++q) o[q] = fsilu_(g[q]) * up[q];
                            const int col = 16 * (8 * tn + 4 * bj + wc) + 4 * fq;
                            const h16x4 oh = cvt4(o);
                            __hip_atomic_store((unsigned long long*)(U + (size_t)(off + idx) * DEXP + col), __builtin_bit_cast(unsigned long long, oh), __ATOMIC_RELAXED, __HIP_MEMORY_SCOPE_AGENT);
                        }
                    }
                }
            asm volatile("s_waitcnt vmcnt(0)" ::: "memory");
            if ((threadIdx.x & 63) == 0) __hip_atomic_fetch_add(&dep[m], 1u, __ATOMIC_RELAXED, __HIP_MEMORY_SCOPE_AGENT);
        });
    }
    const int mearly = (n1 > G) ? (G >> 2) : MT;
    const int nearly_all = (mearly * 8 < n2) ? mearly * 8 : n2;
    const int iearly = (bidx >= r1 && nearly_all > bidx - r1) ? (nearly_all - (bidx - r1) + nlight - 1) / nlight : 0;
    auto wait_dep = [&](int m) {
        if ((tid & 63) == 0) {
            unsigned sp = 0;
            while (__hip_atomic_load(&dep[m], __ATOMIC_RELAXED, __HIP_MEMORY_SCOPE_AGENT) < 32u) {
                __builtin_amdgcn_s_sleep(2);
                if (++sp > (1u << 24)) { atomicAdd(&ctl[CW_TMO], 1u); break; }
            }
        }
    };
    auto rowoff2 = [&](const g8::Unit& u, int r) {
        int idx = u.u1 * 256 + r; idx = idx < u.u4 ? idx : u.u4 - 1;
        return (unsigned)(u.u3 + idx) * (unsigned)(DEXP * 2);
    };
    auto epi2 = [&](const g8::Unit& u, const f32x4 (&acc)[2][2][4][2], int wr, int wc, int fr, int fq) {
        const int e = u.u0, tm = u.u1, tn = u.u2, c = u.u4;
        const int* lst = LIST + e * 8192;
        int entry[8]; float gw[8];
#pragma unroll
        for (int q = 0; q < 8; ++q) { int idx = tm * 256 + 128 * (q >> 2) + 64 * wr + 16 * (q & 3) + fr; idx = idx < c ? idx : c - 1; entry[q] = lst[idx]; }
#pragma unroll
        for (int q = 0; q < 8; ++q) gw[q] = GW[entry[q]];
#pragma unroll
        for (int ai = 0; ai < 2; ++ai)
#pragma unroll
            for (int mm = 0; mm < 4; ++mm) {
                const int idx = tm * 256 + 128 * ai + 64 * wr + 16 * mm + fr;
                if (idx < c) {
                    h16* dst = SLOT + (size_t)entry[ai * 4 + mm] * D + tn * 256 + 32 * wc + 4 * fq;
#pragma unroll
                    for (int bj = 0; bj < 2; ++bj)
#pragma unroll
                        for (int n = 0; n < 2; ++n) store_h4(dst + 128 * bj + 16 * n, acc[ai][bj][mm][n] * gw[ai * 4 + mm]);
                }
            }
    };
#pragma unroll 1
    for (int pass = 0; pass < 2; ++pass) {
        const int ibeg = pass ? iearly : 0, iend = pass ? my2 : iearly;
        auto sched2 = [&](int i, g8::Unit& u) {
            const int it = ibeg + i;
            if (it >= iend) return false;
            const int item = (bidx - r1) + it * nlight;
            const int m = item >> 3, tn = item & 7;
            int e, tm, off, c; locate(m, e, tm, off, c);
            wait_dep(m);
            u.a = nullptr; u.b = (const h16*)(ws + OFF_EXP + layer * EXP_L + EGU_BYTES) + ((size_t)e * 2048 + tn * 256) * 512;
            u.u0 = e; u.u1 = tm; u.u2 = tn; u.u3 = off; u.u4 = c;
            return true;
        };
        gemm_phase8g<0>(smem, U, 512, DEXP, sched2, rowoff2, epi2);
    }
    if (layer == 0) {
        __syncthreads();
        if (tid == 0) atomicAdd(&ctl[CW_MDONE], 1u);
        for (;;) {
            __syncthreads();
            if (tid == 0) {
                int s = -1;
                if (__hip_atomic_load(&ctl[CW_MDONE], __ATOMIC_RELAXED, __HIP_MEMORY_SCOPE_AGENT) < (unsigned)G) {
                    const unsigned t = atomicAdd(&ctl[CW_POOL2], 1u);
                    if (t < (unsigned)(POOL2_STEPS / 2)) s = (int)t;
                }
                *sitem = s;
            }
            __syncthreads();
            const int s = *sitem;
            if (s < 0) break;
            conv_pool2_step(p, smem, s);
        }
    }
}

template <bool FINAL>
__device__ __forceinline__ float combine_row(const Params& p, int layer, int tl, f32x4 (&x)[8]) {
    const int lane = threadIdx.x & 63;
    const h16* SLOT = (const h16*)(p.ws + OFF_SLOT);
    const int b = tl >> 11;
    h16* xr = (h16*)(p.ws + OFF_XH) + (size_t)tl * D;
    float* outr = p.out + (size_t)tl * D;
    const float* gt2 = modv(p, layer, b, 5);
    float ss = 0.f;
    h16x4 xh8[8], s08[8], s18[8]; f32x4 g8[8];
#pragma unroll
    for (int i = 0; i < 8; ++i) {
        const int k = i * 256 + lane * 4;
        xh8[i] = *(const h16x4*)(xr + k); g8[i] = *(const f32x4*)(gt2 + k);
        s08[i] = *(const h16x4*)(SLOT + (size_t)(2 * tl) * D + k); s18[i] = *(const h16x4*)(SLOT + (size_t)(2 * tl + 1) * D + k);
    }
#pragma unroll
    for (int i = 0; i < 8; ++i) {
        const int k = i * 256 + lane * 4;
        const h16x4 xh = xh8[i], s0 = s08[i], s1 = s18[i];
        const f32x4 xv = {(float)xh[0], (float)xh[1], (float)xh[2], (float)xh[3]}, g = g8[i];
        f32x4 f;
#pragma unroll
        for (int e = 0; e < 4; ++e) f[e] = (float)s0[e] + (float)s1[e];
        x[i] = xv + g * f;
        if (FINAL) *(f32x4*)(outr + k) = x[i]; else store_h4(xr + k, x[i]);
        ss += x[i][0] * x[i][0] + x[i][1] * x[i][1] + x[i][2] * x[i][2] + x[i][3] * x[i][3];
    }
    return wave_sum(ss);
}
__device__ __forceinline__ void phase_combine_final(const Params& p, int bid, int nblk, int layer) {
    const int wave = threadIdx.x >> 6;
    for (int tl = bid * NW + wave; tl < ROWSL; tl += nblk * NW) { f32x4 x[8]; (void)combine_row<true>(p, layer, tl, x); }
}
__device__ __forceinline__ void phase_combine_fold(const Params& p, char* smem, int bid, int nblk) {
    char* ws = p.ws;
    const int lane = threadIdx.x & 63, wave = threadIdx.x >> 6;
    h16* HF = (h16*)(ws + OFF_H);
    float* HNY = (float*)(ws + OFF_HNY);
    const float* gn = p.in[6] + D;
    float* fac = (float*)smem;
    for (int i = threadIdx.x * 4; i < NB * 2048; i += NT * 4) {
        const int b = i >> 11, k = i & 2047;
        const f32x4 g4 = *(const f32x4*)(gn + k), c4 = *(const f32x4*)(modv(p, 1, b, 1) + k), h4 = *(const f32x4*)(modv(p, 1, b, 0) + k);
        *(f32x4*)(fac + (b * 2) * 2048 + k) = g4 * (c4 + 1.0f); *(f32x4*)(fac + (b * 2 + 1) * 2048 + k) = h4;
    }
    __syncthreads();
    for (int u = bid * NW + wave; u < NB * 1025; u += nblk * NW) {
        const int b = u / 1025, t = u - b * 1025;
        const float* fm = fac + (b * 2) * 2048;
        f32x4 xa[8];
        const float ssa = combine_row<false>(p, 0, b * SEQ + t, xa);
        const float ra = rsqrtf(ssa * (1.0f / D) + 1e-6f);
        const bool paired = (t >= 1 && t <= 1023);
        f32x4 xb[8]; float rb2 = 0.f;
        if (paired) { const float ssb = combine_row<false>(p, 0, b * SEQ + (SEQ - t), xb); rb2 = rsqrtf(ssb * (1.0f / D) + 1e-6f); }
#pragma unroll
        for (int i = 0; i < 8; ++i) {
            const int k = i * 256 + lane * 4;
            const f32x4 m1 = *(const f32x4*)(fm + k), h1 = *(const f32x4*)(fm + 2048 + k);
            const f32x4 ha = (xa[i] * ra) * m1 + h1;
            if (paired) {
                const f32x4 hb = (xb[i] * rb2) * m1 + h1;
                store_h4(HF + (size_t)(b * SEQ + t) * D + k, ha + hb);
                store_h4(HF + (size_t)(b * SEQ + 1024 + t) * D + k, ha - hb);
            } else if (t == 0) {
                store_h4(HF + (size_t)(b * SEQ) * D + k, ha);
                store_h4(HF + (size_t)(b * SEQ + 1024) * D + k, (f32x4){0.f, 0.f, 0.f, 0.f});
            } else {
                *(f32x4*)(HNY + (size_t)b * D + k) = ha;
            }
        }
    }
}

__device__ __forceinline__ void phase_dft_c(const Params& p, char* smem, int bid, int nblk) {
    char* ws = p.ws;
    const h16* DC = (const h16*)(ws + OFF_DC);
    const h16* HF = (const h16*)(ws + OFF_H);
    h16* ZT = (h16*)(ws + OFF_ZT);
    {
        const float* HNY = (const float*)(ws + OFF_HNY);
        float* VNY = (float*)(ws + OFF_VNY);
        const int lane = threadIdx.x & 63, wave = threadIdx.x >> 6;
        f32x4 hv[4]; h16x4 dv[4];
#pragma unroll
        for (int k = 0; k < 4; ++k) {
            int o = bid * NW + wave + k * nblk * NW; o = o < NB * D ? o : NB * D - 1;
            const int b = o >> 11, gg = (o >> 8) & 7, n = o & 255;
            hv[k] = *(const f32x4*)(HNY + (size_t)b * D + gg * 256 + lane * 4); dv[k] = *(const h16x4*)(DC + (size_t)n * 256 + lane * 4);
        }
#pragma unroll
        for (int k = 0; k < 4; ++k) {
            const int o = bid * NW + wave + k * nblk * NW;
            float a = hv[k][0] * (float)dv[k][0] + hv[k][1] * (float)dv[k][1] + hv[k][2] * (float)dv[k][2] + hv[k][3] * (float)dv[k][3];
            a = wave_sum(a);
            if (lane == 0 && o < NB * D) VNY[o] = a * 0.022097086912079608f;
        }
        for (int o = bid * NW + wave + 4 * nblk * NW; o < NB * D; o += nblk * NW) {
            const int b = o >> 11, gg = (o >> 8) & 7, n = o & 255;
            const f32x4 h = *(const f32x4*)(HNY + (size_t)b * D + gg * 256 + lane * 4); const h16x4 d = *(const h16x4*)(DC + (size_t)n * 256 + lane * 4);
            float a = h[0] * (float)d[0] + h[1] * (float)d[1] + h[2] * (float)d[2] + h[3] * (float)d[3];
            a = wave_sum(a);
            if (lane == 0) VNY[o] = a * 0.022097086912079608f;
        }
    }
    {
        auto sched = [&](int i, g8::Unit& u) {
            const int t = bid + i * nblk;
            if (t >= 32 * 8) return false;
            const int bg = t >> 3, tn = t & 7;
            const int b = bg >> 3, g = bg & 7;
            u.a = DC + (size_t)((tn < 4) ? 0 : 256) * 256; u.b = HF + (size_t)(b * SEQ + tn * 256) * D + g * 256; u.u0 = b; u.u1 = g; u.u2 = tn; u.u3 = 0;
            return true;
        };
        gemm_phase8(smem, 256, D, 256, sched, [&](const g8::Unit& u, const f32x4 (&acc)[2][2][4][2], int wr, int wc, int fr, int fq) {
            const int b = u.u0, g = u.u1, tn = u.u2;
            acc8_foreach(acc, wr, wc, fr, fq, [&](int r, int c, f32x4 v) { store_h4(ZT + ((size_t)(b * 2048 + g * 256 + r)) * 2048 + tn * 256 + c, v); });
        });
    }
}
__device__ __forceinline__ void phase_dft_t(const Params& p, char* smem, int bid, int nblk) {
    char* ws = p.ws;
    const h16* DT = (const h16*)(ws + OFF_DT);
    const h16* ZT = (const h16*)(ws + OFF_ZT);
    const float* VNY = (const float*)(ws + OFF_VNY);
    h16* FB = (h16*)(ws + OFF_YMIX);
    auto sched = [&](int i, g8::Unit& u) {
        const int t = bid + i * nblk;
        if (t >= 4 * 64) return false;
        const int b = t >> 6, r8 = t & 63;
        int tm, tn; tile_order(r8, 8, 8, tm, tn);
        u.a = DT + (size_t)(tm * 256) * 2048; u.b = ZT + ((size_t)(b * 2048 + tn * 256)) * 2048; u.u0 = b; u.u1 = tm; u.u2 = tn; u.u3 = 0;
        return true;
    };
    gemm_phase8(smem, 2048, 2048, 2048, sched, [&](const g8::Unit& u, const f32x4 (&acc)[2][2][4][2], int wr, int wc, int fr, int fq) {
        const int b = u.u0, tm = u.u1, tn = u.u2;
        f32x4 ny4[2][2];
#pragma unroll
        for (int bj = 0; bj < 2; ++bj)
#pragma unroll
            for (int n = 0; n < 2; ++n) ny4[bj][n] = *(const f32x4*)(VNY + (size_t)b * D + tn * 256 + 128 * bj + 32 * wc + 16 * n + 4 * fq);
#pragma unroll
        for (int ai = 0; ai < 2; ++ai)
#pragma unroll
            for (int bj = 0; bj < 2; ++bj)
#pragma unroll
                for (int m = 0; m < 4; ++m)
#pragma unroll
                    for (int n = 0; n < 2; ++n) {
                        const int r = 128 * ai + 64 * wr + 16 * m + fr, c = 128 * bj + 32 * wc + 16 * n + 4 * fq;
                        const float sg = (r & 1) ? -1.0f : 1.0f;
                        store_h4(FB + (size_t)(b * SEQ + tm * 256 + r) * D + tn * 256 + c, acc[ai][bj][m][n] + ny4[bj][n] * sg);
                    }
    });
}

__global__ void __launch_bounds__(NT, 2) mk_forward(Params p, int ph_lo, int ph_hi, int probe_k, int probe_n) {
    __shared__ __attribute__((aligned(16))) char smem[GEMM_LDS + 64];
    const int bid = blockIdx.x, nblk = gridDim.x;
    volatile LAS unsigned* bst = (volatile LAS unsigned*)(smem + GEMM_LDS);
    XcdBarrier xb;
    const bool need_bar = (ph_hi - ph_lo) > 1;
    if (need_bar) {
        if (threadIdx.x == 0) { bst[0] = 0u; bst[1] = 0u; }
        __syncthreads();
        xb = xcd_barrier_post((unsigned*)(p.ws + OFF_CTL), bst);
    }
#define PHASE(k, call) if (ph_lo <= (k) && (k) < ph_hi) { \
        if ((k) == PROBE_PHASE) { _Pragma("unroll 1") for (int rep = 0; rep < probe_n; ++rep) { call; if (rep + 1 < probe_n) xcd_barrier(xb); } } \
        else { const int rep = 0; (void)rep; call; } \
        if ((k) + 1 < ph_hi) xcd_barrier(xb); }
    PHASE(0, phase_prologue(p, smem, bid, nblk))
    PHASE(1, phase_norm0(p, smem, bid, nblk))
    PHASE(2, phase_gemm_in(p, smem, bid, nblk))
    PHASE(3, phase_prep(p, smem, bid, nblk))
    PHASE(4, phase_lora(p, smem, bid, nblk))
    PHASE(5, phase_chunkprep(p, smem, bid, nblk))
    PHASE(6, phase_mix(p, smem, bid, nblk, rep * 128, probe_n))
    PHASE(7, { phase_finish(p, bid, nblk); phase_conv_pool_rest(p, smem, bid, nblk); phase_conv_experts(p, smem, bid, nblk, 1); })
    PHASE(8, phase_gemm_res(p, smem, bid, nblk, (const h16*)(p.ws + OFF_YMIX), (const h16*)(p.ws + OFF_WOUT), p.in[0], 0))
    PHASE(9, phase_route(p, smem, bid, nblk, 0, 0 + 2 * rep))
    PHASE(10, phase_moe(p, smem, 0, 0 + 2 * rep))
    PHASE(11, phase_combine_fold(p, smem, bid, nblk))
    PHASE(12, phase_dft_c(p, smem, bid, nblk))
    PHASE(13, phase_dft_t(p, smem, bid, nblk))
    PHASE(14, phase_gemm_res(p, smem, bid, nblk, (const h16*)(p.ws + OFF_YMIX), (const h16*)(p.ws + OFF_FW), p.out, 1))
    PHASE(15, { phase_route(p, smem, bid, nblk, 1, 1 + 2 * rep); phase_conv_pool2_rest(p, smem, bid, nblk); })
    PHASE(16, phase_moe(p, smem, 1, 1 + 2 * rep))
    PHASE(17, phase_combine_final(p, bid, nblk, 1))
#undef PHASE
}

extern "C" void kernel_launch(void* const* d_in, const int* in_sizes, int n_in, void* d_out, int out_size, void* d_ws, size_t ws_size, hipStream_t stream) {
    static int grid = 0;
    if (grid == 0) {
        if (n_in != 30 || ws_size < WS_END) { fprintf(stderr, "kernel_launch: need 30 inputs and %zu bytes of workspace (got %d, %zu)\n", (size_t)WS_END, n_in, ws_size); grid = -1; return; }
        int dev = 0, cus = 0, per_cu = 0;
        hipGetDevice(&dev);
        hipDeviceGetAttribute(&cus, hipDeviceAttributeMultiprocessorCount, dev);
        hipOccupancyMaxActiveBlocksPerMultiprocessor(&per_cu, (const void*)mk_forward, NT, 0);
        if (per_cu < 1) { fprintf(stderr, "kernel_launch: occupancy query returned %d\n", per_cu); grid = -1; return; }
        if (per_cu > 1) per_cu = 1;
        grid = cus * per_cu;
    }
    if (grid < 0) return;
    hipMemsetAsync((char*)d_ws + OFF_CTL, 0, CTL_BYTES, stream);
    Params p{};
    for (int i = 0; i < 30; ++i) p.in[i] = (const float*)d_in[i];
    p.out = (float*)d_out; p.ws = (char*)d_ws;
#if MULTI_LAUNCH
    for (int ph = 0; ph < NPHASE; ++ph) hipLaunchKernelGGL(mk_forward, dim3(grid), dim3(NT), 0, stream, p, ph, ph + 1, -1, 1);
#else
    int lo = 0, hi = NPHASE, pk = PROBE_PHASE, pn = 2;
    void* args[] = {&p, &lo, &hi, &pk, &pn};
    hipError_t e = hipLaunchCooperativeKernel((const void*)mk_forward, dim3(grid), dim3(NT), args, 0, stream);
    if (e != hipSuccess) fprintf(stderr, "cooperative launch failed: %s (grid %d)\n", hipGetErrorString(e), grid);
#endif
}
```
